# Optimizing an MI355X kernel written in HIP

```python
import math
import jax, jax.numpy as jnp
from jax import lax
import numpy as np

D_MODEL = 1024
BATCH = 8
SEQ = 4096
DEPTH = 2

PLE_DIM = 256
GDN_HEADS = 8
GDN_HEAD_DIM = 128
GDN_WIDTH = GDN_HEADS * GDN_HEAD_DIM
GDN_CHUNK = 64
CONV_WIDTH = 4
LRU_WIDTH = D_MODEL
LRU_BLOCKS = 8
LRU_BLOCK_DIM = LRU_WIDTH // LRU_BLOCKS
LRU_C = 8.0
SWA_Q_HEADS = 16
SWA_KV_HEADS = 4
SWA_HEAD_DIM = 64
SWA_GROUP = SWA_Q_HEADS // SWA_KV_HEADS
SWA_Q_WIDTH = SWA_Q_HEADS * SWA_HEAD_DIM
SWA_KV_WIDTH = SWA_KV_HEADS * SWA_HEAD_DIM
WINDOW = 128
REL_BUCKETS = 32
REL_MAX_DISTANCE = 128
N_EXPERTS = 32
TOP_K = 4
D_EXPERT = D_MODEL
SWIGLU_LIMIT = 7.0
SWIGLU_ALPHA = 1.702
EXPERT_BLOCK = 128
N_BRANCHES = 3
IN_SPLITS = (GDN_WIDTH, GDN_WIDTH, GDN_WIDTH, GDN_WIDTH, GDN_HEADS, GDN_HEADS,
             LRU_WIDTH, LRU_WIDTH,
             SWA_Q_WIDTH, SWA_KV_WIDTH, SWA_KV_WIDTH,
             N_BRANCHES * D_MODEL)
IN_COLS = sum(IN_SPLITS)
DEEPNORM_ALPHA = (2.0 * DEPTH) ** 0.25
DEEPNORM_BETA = (8.0 * DEPTH) ** -0.25
LN_EPS = 1e-5
NORM_EPS = 1e-6

kernel_name = "hybrid_gdn_rglru_swa_moe_deepnorm"


def layer_norm(x, g, b):
    x32 = x.astype(jnp.float32)
    mu = jnp.mean(x32, axis=-1, keepdims=True)
    var = jnp.mean(jnp.square(x32 - mu), axis=-1, keepdims=True)
    return ((x32 - mu) * lax.rsqrt(var + LN_EPS) * g + b).astype(x.dtype)


def l2norm(t):
    return t * lax.rsqrt(jnp.sum(jnp.square(t), axis=-1, keepdims=True) + NORM_EPS)


def split_cols(t, sizes):
    offsets = []
    acc = 0
    for s in sizes[:-1]:
        acc += s
        offsets.append(acc)
    return jnp.split(t, offsets, axis=-1)


def causal_dwconv(x, w):
    K, S = w.shape[0], x.shape[1]
    xp = jnp.pad(x, ((0, 0), (K - 1, 0), (0, 0)))
    return sum(xp[:, j:j + S] * w[j] for j in range(K))


def gated_delta_rule_chunked(q, k, v, g, beta):
    B, S, H, dk = q.shape
    dv = v.shape[-1]
    C = GDN_CHUNK
    N = S // C

    def chunks(t):
        return jnp.moveaxis(t.reshape((B, N, C, H) + t.shape[3:]), 3, 1)

    q = chunks(q * (dk ** -0.5))
    k, v, g, beta = chunks(k), chunks(v), chunks(g), chunks(beta)
    G = jnp.cumsum(g, axis=-1)
    idx = jnp.arange(C)
    causal = idx[:, None] >= idx[None, :]
    strict = idx[:, None] > idx[None, :]
    decay = jnp.exp(jnp.where(causal, G[..., :, None] - G[..., None, :], -jnp.inf))
    kb = k * beta[..., None]
    L = jnp.where(strict, jnp.einsum('bhnid,bhnjd->bhnij', kb, k) * decay, 0.0)
    eye = jnp.eye(C, dtype=L.dtype)
    T = lax.linalg.triangular_solve(eye + L, jnp.broadcast_to(eye, L.shape), left_side=True, lower=True)
    u = T @ (v * beta[..., None])
    w = T @ (kb * jnp.exp(G)[..., None])
    intra = jnp.einsum('bhnid,bhnjd->bhnij', q, k) * decay
    q_dec = q * jnp.exp(G)[..., None]
    G_last = G[..., -1:]
    k_dec = k * jnp.exp(G_last - G)[..., None]
    chunk_decay = jnp.exp(G_last[..., 0])
    xs = tuple(jnp.moveaxis(t, 2, 0) for t in (w, u, q_dec, k_dec, intra, chunk_decay))

    def step(state, inp):
        w_n, u_n, qd, kd, a_n, cd = inp
        v_new = u_n - jnp.einsum('bhcd,bhde->bhce', w_n, state)
        o = jnp.einsum('bhcd,bhde->bhce', qd, state) + jnp.einsum('bhij,bhje->bhie', a_n, v_new)
        state = state * cd[..., None, None] + jnp.einsum('bhcd,bhce->bhde', kd, v_new)
        return state, o

    _, o = lax.scan(step, jnp.zeros((B, H, dk, dv), q.dtype), xs)
    return jnp.transpose(o, (1, 0, 3, 2, 4)).reshape(B, S, H, dv)


def gdn_branch(q, k, v, z, a, b, conv_w, a_log, dt_bias, norm_w):
    B, S, _ = q.shape
    qkv = jax.nn.silu(causal_dwconv(jnp.concatenate([q, k, v], axis=-1), conv_w))
    q, k, v = jnp.split(qkv, 3, axis=-1)

    def heads(t):
        return t.reshape(B, S, GDN_HEADS, GDN_HEAD_DIM).astype(jnp.float32)

    qh, kh, vh = l2norm(heads(q)), l2norm(heads(k)), heads(v)
    g = -jnp.exp(a_log.astype(jnp.float32)) * jax.nn.softplus(a.astype(jnp.float32) + dt_bias)
    beta = jax.nn.sigmoid(b.astype(jnp.float32))
    o = gated_delta_rule_chunked(qh, kh, vh, g, beta)
    o = o * lax.rsqrt(jnp.mean(jnp.square(o), axis=-1, keepdims=True) + NORM_EPS) * norm_w * jax.nn.silu(heads(z))
    return o.reshape(B, S, GDN_WIDTH).astype(q.dtype)


def lru_combine(c1, c2):
    a1, b1 = c1
    a2, b2 = c2
    return a1 * a2, a2 * b1 + b2


def lru_branch(xb, gate, conv_w, conv_b, w_a, b_a, w_x, b_x, lam):
    B, S, _ = xb.shape
    xc = (causal_dwconv(xb, conv_w) + conv_b).astype(jnp.float32)
    blocks = xc.reshape(B, S, LRU_BLOCKS, LRU_BLOCK_DIM)
    r = jax.nn.sigmoid(jnp.einsum('bshi,hij->bshj', blocks, w_a).reshape(B, S, LRU_WIDTH) + b_a)
    i = jax.nn.sigmoid(jnp.einsum('bshi,hij->bshj', blocks, w_x).reshape(B, S, LRU_WIDTH) + b_x)
    log_a = -LRU_C * r * jax.nn.softplus(-lam.astype(jnp.float32))
    a = jnp.exp(log_a)
    u = jnp.sqrt(-jnp.expm1(2.0 * log_a)) * (i * xc)
    _, h = lax.associative_scan(lru_combine, (a, u), axis=1)
    return (h * jax.nn.gelu(gate.astype(jnp.float32))).astype(xb.dtype)


def t5_bucket(dist):
    max_exact = REL_BUCKETS // 2
    d = jnp.maximum(dist.astype(jnp.float32), 1.0)
    large = max_exact + (jnp.log(d / max_exact) / math.log(REL_MAX_DISTANCE / max_exact)
                         * (REL_BUCKETS - max_exact)).astype(jnp.int32)
    large = jnp.minimum(large, REL_BUCKETS - 1)
    return jnp.where(dist < max_exact, dist, large)


def swa_branch(q, k, v, sinks, rel_bias):
    B, S, _ = q.shape
    NB = S // WINDOW
    qb = q.reshape(B, NB, WINDOW, SWA_KV_HEADS, SWA_GROUP, SWA_HEAD_DIM)

    def band(t):
        t = t.reshape(B, NB, WINDOW, SWA_KV_HEADS, SWA_HEAD_DIM)
        prev = jnp.pad(t, ((0, 0), (1, 0), (0, 0), (0, 0), (0, 0)))[:, :-1]
        return jnp.concatenate([prev, t], axis=2)

    kb, vb = band(k), band(v)
    scores = jnp.einsum('bnqhgd,bnshd->bnhgqs', qb, kb,
                        preferred_element_type=jnp.float32) * (SWA_HEAD_DIM ** -0.5)
    kj = jnp.arange(2 * WINDOW)[None, :]
    dist = (jnp.arange(WINDOW)[:, None] + WINDOW) - kj
    in_window = (dist >= 0) & (dist < WINDOW)
    bias = rel_bias[t5_bucket(jnp.maximum(dist, 0))].astype(jnp.float32)
    bias = jnp.transpose(bias, (2, 0, 1)).reshape(SWA_KV_HEADS, SWA_GROUP, WINDOW, 2 * WINDOW)
    key_exists = (jnp.arange(NB)[:, None] * WINDOW + kj - WINDOW) >= 0
    mask = in_window[None] & key_exists[:, None, :]
    scores = jnp.where(mask[None, :, None, None], scores + bias, -jnp.inf)
    sink = sinks.astype(jnp.float32).reshape(SWA_KV_HEADS, SWA_GROUP)[None, None, :, :, None, None]
    m = jnp.maximum(jnp.max(scores, axis=-1, keepdims=True), sink)
    pexp = jnp.exp(scores - m)
    probs = pexp / (jnp.sum(pexp, axis=-1, keepdims=True) + jnp.exp(sink - m))
    out = jnp.einsum('bnhgqs,bnshd->bnqhgd', probs.astype(v.dtype), vb)
    return out.reshape(B, S, SWA_Q_WIDTH)


def token_mixer(h, w_in, conv_qkv_w, gdn_a_log, gdn_dt_bias, gdn_norm_w,
                rg_conv_w, rg_conv_b, rg_w_a, rg_b_a, rg_w_x, rg_b_x, rg_lambda,
                attn_sinks, rel_bias, w_o_gdn, w_o_lru, w_o_swa, w_out):
    proj = h @ w_in
    (qa, ka, va, za, aa, ba, xl, gl, qc, kc, vc, gate_logits) = split_cols(proj, IN_SPLITS)
    y_a = gdn_branch(qa, ka, va, za, aa, ba, conv_qkv_w, gdn_a_log, gdn_dt_bias, gdn_norm_w) @ w_o_gdn
    y_b = lru_branch(xl, gl, rg_conv_w, rg_conv_b, rg_w_a, rg_b_a, rg_w_x, rg_b_x, rg_lambda) @ w_o_lru
    y_c = swa_branch(qc, kc, vc, attn_sinks, rel_bias) @ w_o_swa
    g_a, g_b, g_c = jnp.split(jax.nn.sigmoid(gate_logits), N_BRANCHES, axis=-1)
    return (g_a * y_a + g_b * y_b + g_c * y_c) @ w_out


def clamped_swiglu(hgu):
    gate = jnp.minimum(hgu[..., ::2], SWIGLU_LIMIT)
    lin = jnp.clip(hgu[..., 1::2], -SWIGLU_LIMIT, SWIGLU_LIMIT)
    return gate * jax.nn.sigmoid(SWIGLU_ALPHA * gate) * (lin + 1.0)


def moe(h, router_w, router_b, w_gu, b_gu, w_down, b_down):
    B, S, D = h.shape
    T = B * S
    A = T * TOP_K
    xt = h.reshape(T, D)
    logits = (xt @ router_w + router_b).astype(jnp.float32)
    top_vals, top_idx = lax.top_k(logits, TOP_K)
    gates = jax.nn.softmax(top_vals, axis=-1)
    e_flat = top_idx.reshape(A)
    order = jnp.argsort(e_flat)
    sorted_e = e_flat[order]
    counts = jnp.bincount(e_flat, length=N_EXPERTS)
    starts = jnp.cumsum(counts) - counts
    padded = ((counts + EXPERT_BLOCK - 1) // EXPERT_BLOCK) * EXPERT_BLOCK
    pad_ends = jnp.cumsum(padded)
    pad_starts = pad_ends - padded
    dest_sorted = pad_starts[sorted_e] + (jnp.arange(A) - starts[sorted_e])
    P = A + N_EXPERTS * EXPERT_BLOCK
    n_blocks = P // EXPERT_BLOCK
    buf = jnp.zeros((P, D), h.dtype).at[dest_sorted].set(xt[order // TOP_K])
    blk_e = jnp.minimum(jnp.searchsorted(pad_ends, jnp.arange(n_blocks) * EXPERT_BLOCK, side='right'),
                        N_EXPERTS - 1)

    def expert_block(args):
        xb, e = args
        return clamped_swiglu(xb @ w_gu[e] + b_gu[e]) @ w_down[e] + b_down[e]

    out_buf = lax.map(expert_block, (buf.reshape(n_blocks, EXPERT_BLOCK, D), blk_e)).reshape(P, D)
    dest = jnp.zeros((A,), dest_sorted.dtype).at[order].set(dest_sorted)
    y = jnp.einsum('tk,tkd->td', gates.astype(out_buf.dtype), out_buf[dest].reshape(T, TOP_K, D))
    return y.reshape(B, S, D).astype(h.dtype)


def setup_inputs(seed: int = 0) -> dict:
    key = jax.random.key(seed)
    ks = iter(jax.random.split(key, 48))
    f32 = jnp.float32

    def nrm(shape, scale):
        return jax.random.normal(next(ks), shape, f32) * scale

    def gain(shape):
        return 1.0 + nrm(shape, 0.02)

    x = nrm((BATCH, SEQ, D_MODEL), 1.0)
    p = nrm((DEPTH, BATCH, SEQ, PLE_DIM), 1.0)
    w_in = nrm((DEPTH, D_MODEL, IN_COLS), D_MODEL ** -0.5)
    conv_qkv_w = nrm((DEPTH, CONV_WIDTH, 3 * GDN_WIDTH), CONV_WIDTH ** -0.5)
    gdn_a_log = jnp.log(jax.random.uniform(next(ks), (DEPTH, GDN_HEADS), f32, 1.0, 16.0))
    dt = jnp.exp(jax.random.uniform(next(ks), (DEPTH, GDN_HEADS), f32, math.log(1e-3), math.log(1e-1)))
    gdn_dt_bias = dt + jnp.log(-jnp.expm1(-dt))
    gdn_norm_w = gain((DEPTH, GDN_HEAD_DIM))
    rg_conv_w = nrm((DEPTH, CONV_WIDTH, LRU_WIDTH), CONV_WIDTH ** -0.5)
    rg_conv_b = nrm((DEPTH, LRU_WIDTH), 0.02)
    rg_w_a = nrm((DEPTH, LRU_BLOCKS, LRU_BLOCK_DIM, LRU_BLOCK_DIM), LRU_BLOCK_DIM ** -0.5)
    rg_b_a = nrm((DEPTH, LRU_WIDTH), 0.02)
    rg_w_x = nrm((DEPTH, LRU_BLOCKS, LRU_BLOCK_DIM, LRU_BLOCK_DIM), LRU_BLOCK_DIM ** -0.5)
    rg_b_x = nrm((DEPTH, LRU_WIDTH), 0.02)
    s = jax.random.uniform(next(ks), (DEPTH, LRU_WIDTH), f32, 0.9, 0.999) ** (1.0 / LRU_C)
    rg_lambda = jnp.log(s) - jnp.log1p(-s)
    attn_sinks = nrm((DEPTH, SWA_Q_HEADS), 0.5)
    rel_bias = nrm((REL_BUCKETS, SWA_Q_HEADS), 0.5)
    w_o_gdn = nrm((DEPTH, GDN_WIDTH, D_MODEL), GDN_WIDTH ** -0.5)
    w_o_lru = nrm((DEPTH, LRU_WIDTH, D_MODEL), LRU_WIDTH ** -0.5)
    w_o_swa = nrm((DEPTH, SWA_Q_WIDTH, D_MODEL), SWA_Q_WIDTH ** -0.5)
    w_out = nrm((DEPTH, D_MODEL, D_MODEL), D_MODEL ** -0.5 * DEEPNORM_BETA)
    ln1_g = gain((DEPTH, D_MODEL))
    ln1_b = nrm((DEPTH, D_MODEL), 0.02)
    router_w = nrm((DEPTH, D_MODEL, N_EXPERTS), D_MODEL ** -0.5)
    router_b = nrm((DEPTH, N_EXPERTS), 0.01)
    w_gu = nrm((DEPTH, N_EXPERTS, D_MODEL, 2 * D_EXPERT), D_MODEL ** -0.5)
    b_gu = nrm((DEPTH, N_EXPERTS, 2 * D_EXPERT), 0.02)
    w_down = nrm((DEPTH, N_EXPERTS, D_EXPERT, D_MODEL), D_EXPERT ** -0.5 * DEEPNORM_BETA)
    b_down = nrm((DEPTH, N_EXPERTS, D_MODEL), 0.02)
    ln2_g = gain((DEPTH, D_MODEL))
    ln2_b = nrm((DEPTH, D_MODEL), 0.02)
    ple_w_gate = nrm((DEPTH, D_MODEL, D_MODEL), D_MODEL ** -0.5)
    ple_w_proj = nrm((DEPTH, PLE_DIM, D_MODEL), PLE_DIM ** -0.5 * DEEPNORM_BETA)
    ln3_g = gain((DEPTH, D_MODEL))
    ln3_b = nrm((DEPTH, D_MODEL), 0.02)
    return {"x": x, "p": p, "w_in": w_in, "conv_qkv_w": conv_qkv_w, "gdn_a_log": gdn_a_log,
            "gdn_dt_bias": gdn_dt_bias, "gdn_norm_w": gdn_norm_w, "rg_conv_w": rg_conv_w,
            "rg_conv_b": rg_conv_b, "rg_w_a": rg_w_a, "rg_b_a": rg_b_a, "rg_w_x": rg_w_x,
            "rg_b_x": rg_b_x, "rg_lambda": rg_lambda, "attn_sinks": attn_sinks, "rel_bias": rel_bias,
            "w_o_gdn": w_o_gdn, "w_o_lru": w_o_lru, "w_o_swa": w_o_swa, "w_out": w_out,
            "ln1_g": ln1_g, "ln1_b": ln1_b, "router_w": router_w, "router_b": router_b,
            "w_gu": w_gu, "b_gu": b_gu, "w_down": w_down, "b_down": b_down,
            "ln2_g": ln2_g, "ln2_b": ln2_b, "ple_w_gate": ple_w_gate, "ple_w_proj": ple_w_proj,
            "ln3_g": ln3_g, "ln3_b": ln3_b}


def reference(x, p, w_in, conv_qkv_w, gdn_a_log, gdn_dt_bias, gdn_norm_w, rg_conv_w, rg_conv_b,
              rg_w_a, rg_b_a, rg_w_x, rg_b_x, rg_lambda, attn_sinks, rel_bias,
              w_o_gdn, w_o_lru, w_o_swa, w_out, ln1_g, ln1_b, router_w, router_b,
              w_gu, b_gu, w_down, b_down, ln2_g, ln2_b, ple_w_gate, ple_w_proj, ln3_g, ln3_b):
    for i in range(DEPTH):
        y = token_mixer(x, w_in[i], conv_qkv_w[i], gdn_a_log[i], gdn_dt_bias[i], gdn_norm_w[i],
                        rg_conv_w[i], rg_conv_b[i], rg_w_a[i], rg_b_a[i], rg_w_x[i], rg_b_x[i], rg_lambda[i],
                        attn_sinks[i], rel_bias, w_o_gdn[i], w_o_lru[i], w_o_swa[i], w_out[i])
        x = layer_norm(DEEPNORM_ALPHA * x + y, ln1_g[i], ln1_b[i])
        y = moe(x, router_w[i], router_b[i], w_gu[i], b_gu[i], w_down[i], b_down[i])
        x = layer_norm(DEEPNORM_ALPHA * x + y, ln2_g[i], ln2_b[i])
        ple = jax.nn.sigmoid(x @ ple_w_gate[i]) * (p[i] @ ple_w_proj[i])
        x = layer_norm(DEEPNORM_ALPHA * x + ple, ln3_g[i], ln3_b[i])
    return x
```

```cpp
#include <hip/hip_runtime.h>
#include <stdint.h>
#include <string.h>

#ifndef DUPMASK
#define DUPMASK 0u
#endif
#define NREP(k) ((int)((DUPMASK >> (k)) & 1u) + 1)
#ifndef N_LAUNCH_PER_PHASE
#define N_LAUNCH_PER_PHASE 0
#endif

#define DM 1024
#define SEQ 4096
#define NBATCH 8
#define DEPTH 2
#define PLE_DIM 256
#define IN_COLS 10768
#define OFF_A 4096
#define NEXP 32
#define ALPHA 1.4142135623730951f
#define NTOK (NBATCH * SEQ)
#define PROJ_COLS 10752
#define PJ_Q 0
#define PJ_K 1024
#define PJ_V 2048
#define PJ_Z 3072
#define PJ_XL 4096
#define PJ_GL 5120
#define PJ_QC 6144
#define PJ_KC 7168
#define PJ_VC 7424
#define PJ_GATES 7680
#define MOE_ROWS (NTOK * 4 + NEXP * 256)

#define LAS __attribute__((address_space(3)))
#define CAS __attribute__((address_space(4)))
typedef unsigned short bf16_t;
typedef short bf16x8 __attribute__((ext_vector_type(8)));
typedef float f32x4 __attribute__((ext_vector_type(4)));
typedef float f32x2 __attribute__((ext_vector_type(2)));
typedef unsigned u32x4 __attribute__((ext_vector_type(4)));
typedef unsigned u32x2 __attribute__((ext_vector_type(2)));

__device__ __forceinline__ float fexp(float x) { return __builtin_amdgcn_exp2f(1.4426950408889634f * x); }
__device__ __forceinline__ float sigmoidf_(float x) { return __builtin_amdgcn_rcpf(1.0f + __builtin_amdgcn_exp2f(-1.4426950408889634f * x)); }
__device__ __forceinline__ float siluf_(float x) { return x * sigmoidf_(x); }
__device__ __forceinline__ float softplusf_(float x) { return fmaxf(x, 0.f) + log1pf(expf(-fabsf(x))); }
__device__ __forceinline__ float gelu_tanhf_(float x) {
    const float y = 0.7978845608028654f * (x + 0.044715f * x * x * x);
    return x * (1.0f - __builtin_amdgcn_rcpf(1.0f + __builtin_amdgcn_exp2f(2.8853900817779268f * y)));
}
__device__ __forceinline__ float wave_sum(float v) {
#pragma unroll
    for (int o = 32; o > 0; o >>= 1) v += __shfl_xor(v, o);
    return v;
}
__device__ __forceinline__ float wave_max(float v) {
#pragma unroll
    for (int o = 32; o > 0; o >>= 1) v = fmaxf(v, __shfl_xor(v, o));
    return v;
}
__device__ __forceinline__ unsigned f2bf(float f) { unsigned u = __builtin_bit_cast(unsigned, f); return (u + 0x7fffu + ((u >> 16) & 1u)) >> 16; }
__device__ __forceinline__ unsigned pk2(float lo, float hi) { return f2bf(lo) | (f2bf(hi) << 16); }
__device__ __forceinline__ float bf2f(unsigned short b) { return __builtin_bit_cast(float, ((unsigned)b) << 16); }
__device__ __forceinline__ float bflo(unsigned u) { return __builtin_bit_cast(float, u << 16); }
__device__ __forceinline__ float bfhi(unsigned u) { return __builtin_bit_cast(float, u & 0xffff0000u); }

namespace pg8 {
constexpr int BM = 256, BK = 64, HALF = 128, HTB = HALF * BK * 2, STAGE_BYTES = 8 * HTB, NXCD = 8, WGM = 8;
__host__ __device__ __forceinline__ int lds_byte(int r, int c) { const int st = (r >> 4) * 2 + (c >> 5), rr = r & 15, cc = c & 31, ob = rr * 64 + cc * 2; return st * 1024 + (ob ^ (((ob >> 9) & 1) << 5)); }
__host__ __device__ __forceinline__ void stage_rc(int b, int& R, int& C) { const int st = b / 1024, sb = b % 1024, swz = sb ^ (((sb >> 9) & 1) << 5); R = (st >> 1) * 16 + swz / 64; C = (st & 1) * 32 + (swz % 64) / 2; }
__host__ __device__ __forceinline__ int perm32(int rho) { const int n = rho >> 4, i = rho & 15; return 8 * (i >> 2) + 4 * n + (i & 3); }
__device__ __forceinline__ unsigned cvt_pk_bf16(float lo, float hi) { unsigned r; asm volatile("v_cvt_pk_bf16_f32 %0, %1, %2" : "=v"(r) : "v"(lo), "v"(hi)); return r; }

struct Unit { const char* A; const char* B; int row0, col0, e, aux; };

__device__ __forceinline__ bool static_tile(int i, int G, int c, int nM, int nN, int& pm, int& pn) {
    const int nwg = nM * nN; const long L = (long)i * G + c; if (L >= nwg) return false;
    int wgid = (int)L; { const int q = nwg / NXCD, r = nwg % NXCD, xcd = wgid % NXCD, off = wgid / NXCD; wgid = (xcd < r ? xcd * (q + 1) : r * (q + 1) + (xcd - r) * q) + off; }
    const int nig = WGM * nN, gid = wgid / nig, fm = gid * WGM, gsz = (nM - fm) < WGM ? (nM - fm) : WGM;
    pm = fm + ((wgid % nig) % gsz); pn = (wgid % nig) / gsz; return true;
}

template <class Epi, class Sched, bool ALIGN_EPI>
__device__ __forceinline__ void gemm_phase(LAS unsigned char* lds, const int K, const Sched& S, const Epi& E, const int tid) {
    const int wid = __builtin_amdgcn_readfirstlane(tid >> 6), lane = tid & 63, wr = wid >> 2, wc = wid & 3, fr = lane & 15, fq = lane >> 4;
    const int nt = K / BK;
    unsigned voffA[2], voffB[2];
    int gR[2]; unsigned gC[2];
#pragma unroll
    for (int i = 0; i < 2; ++i) { int R, C; stage_rc(tid * 16 + i * 8192, R, C); const int Rb = (R & ~31) + perm32(R & 31);
        voffA[i] = (unsigned)(R * K + C) * 2u; voffB[i] = (unsigned)(Rb * K + C) * 2u; gR[i] = R; gC[i] = (unsigned)C * 2u; }
    unsigned oc[2][2] = {{0u, 0u}, {0u, 0u}}, on[2][2] = {{0u, 0u}, {0u, 0u}};
    const size_t kstep = (size_t)(BK * 2);
    const size_t hstep = (size_t)HALF * K * 2;
    const unsigned ldsw = (unsigned)wid * 1024u;
    const int aoff = lds_byte(wr * 64 + fr, fq * 8), boff = lds_byte(wc * 32 + fr, fq * 8);
#define PG8_SA(b, h) (((b) * 2 + (h)) * HTB)
#define PG8_SB(b, h) ((4 + (b) * 2 + (h)) * HTB)
#define PG8_STAGE(bufoff, gbase, voff) do { _Pragma("unroll") for (int _i = 0; _i < 2; ++_i) \
        __builtin_amdgcn_global_load_lds((const unsigned*)((const char*)(gbase) + (voff)[_i]), (LAS unsigned*)(lds + (bufoff) + ldsw + _i * 8192), 16, 0, 0); } while (0)
#define PG8_STAGE_A(bufoff, dptr, koff, half, usenext) do { if constexpr (Sched::GATHER) { const char* _gb = S.Abase + (koff); \
        if (usenext) PG8_STAGE(bufoff, _gb, on[half]); else PG8_STAGE(bufoff, _gb, oc[half]); } else { PG8_STAGE(bufoff, (dptr) + (half) * hstep, voffA); } } while (0)
#define PG8_GOFF(dst, u, bufi) do { const int _cn = S.cntl[(u).e]; _Pragma("unroll") for (int _h = 0; _h < 2; ++_h) _Pragma("unroll") for (int _i = 0; _i < 2; ++_i) { \
        const int _r = _h * 128 + gR[_i]; const int _tok = ((u).aux + _r < _cn) ? S.tab[(bufi) * 256 + _r] : 0; dst[_h][_i] = (unsigned)_tok * (unsigned)(K * 2) + gC[_i]; } } while (0)
#define PG8_TABDMA(u, bufi) do { if (wid < 4) __builtin_amdgcn_global_load_lds((const unsigned*)(S.list + (size_t)(u).e * NTOK + (u).aux + wid * 64 + lane), (LAS unsigned*)(S.tab + (bufi) * 256 + wid * 64), 4, 0, 0); } while (0)
#define PG8_LDA(dst, b, h) do { _Pragma("unroll") for (int m = 0; m < 4; ++m) _Pragma("unroll") for (int k = 0; k < 2; ++k) dst[m][k] = *(const LAS bf16x8*)(lds + PG8_SA(b, h) + aoff + m * 2048 + k * 1024); } while (0)
#define PG8_LDB(dst, b, h) do { _Pragma("unroll") for (int n = 0; n < 2; ++n) _Pragma("unroll") for (int k = 0; k < 2; ++k) dst[n][k] = *(const LAS bf16x8*)(lds + PG8_SB(b, h) + boff + n * 2048 + k * 1024); } while (0)
#define PG8_MMA(ai, bj, At, Bt) do { __builtin_amdgcn_s_setprio(1); _Pragma("unroll") for (int m = 0; m < 4; ++m) _Pragma("unroll") for (int n = 0; n < 2; ++n) _Pragma("unroll") for (int k = 0; k < 2; ++k) \
        acc[ai][bj][m][n] = __builtin_amdgcn_mfma_f32_16x16x32_bf16(Bt[n][k], At[m][k], acc[ai][bj][m][n], 0, 0, 0); __builtin_amdgcn_s_setprio(0); } while (0)
#define PG8_WAIT_V(n) asm volatile("s_waitcnt vmcnt(" #n ")" ::: "memory")
#define PG8_WAIT_L(n) asm volatile("s_waitcnt lgkmcnt(" #n ")" ::: "memory")
#define PG8_BAR __builtin_amdgcn_s_barrier()
#define PG8_SCHED __builtin_amdgcn_sched_barrier(0)
    Unit cur, nxt; int ui = 0;
    if (!S.next(0, cur)) return;
    f32x4 acc[2][2][4][2];
#pragma unroll
    for (int a = 0; a < 2; ++a)
#pragma unroll
        for (int b = 0; b < 2; ++b)
#pragma unroll
            for (int m = 0; m < 4; ++m)
#pragma unroll
                for (int n = 0; n < 2; ++n) acc[a][b][m][n] = (f32x4){0.f, 0.f, 0.f, 0.f};
    bf16x8 At[4][2], B0[2][2], B1[2][2];
    const char* cA = cur.A; const char* cB = cur.B;
    if constexpr (Sched::GATHER) { PG8_TABDMA(cur, 0); PG8_WAIT_V(0); PG8_BAR; PG8_GOFF(oc, cur, 0); }
    PG8_STAGE(PG8_SB(0, 0), cB, voffB); PG8_STAGE(PG8_SB(0, 1), cB + hstep, voffB); PG8_STAGE_A(PG8_SA(0, 0), cA, 0, 0, false); PG8_STAGE_A(PG8_SA(0, 1), cA, 0, 1, false);
    if (wr == 1) PG8_BAR;
    PG8_WAIT_V(2); PG8_BAR;
    PG8_STAGE(PG8_SB(1, 0), cB + kstep, voffB); PG8_STAGE_A(PG8_SA(1, 0), cA + kstep, kstep, 0, false); PG8_STAGE(PG8_SB(1, 1), cB + hstep + kstep, voffB);
    PG8_WAIT_V(6); PG8_BAR;
    for (;;) {
        const bool has_next = S.next(ui + 1, nxt);
        const char* nA = has_next ? nxt.A : cA; const char* nB = has_next ? nxt.B : cB;
        if constexpr (Sched::GATHER) { if (has_next) PG8_TABDMA(nxt, (ui + 1) & 1); }
        for (int t = 0; t < nt; t += 2) {
            const bool last = (t == nt - 2);
            const char* a1 = cA + (size_t)(t + 1) * kstep;
            const char* a2 = last ? nA : cA + (size_t)(t + 2) * kstep; const char* b2 = last ? nB : cB + (size_t)(t + 2) * kstep;
            const char* a3 = a2 + kstep; const char* b3 = b2 + kstep;
            const size_t k2 = last ? 0 : (size_t)(t + 2) * kstep, k3 = k2 + kstep;
            const bool un = last && has_next;
            if constexpr (Sched::GATHER) { if (un) PG8_GOFF(on, nxt, (ui + 1) & 1); }
            PG8_LDB(B0, 0, 0); PG8_LDB(B1, 0, 1); PG8_SCHED; PG8_LDA(At, 0, 0); PG8_STAGE_A(PG8_SA(1, 1), a1, (size_t)(t + 1) * kstep, 1, false);
            PG8_WAIT_V(8); PG8_WAIT_L(0); PG8_BAR; PG8_MMA(0, 0, At, B0); PG8_MMA(0, 1, At, B1); PG8_BAR; PG8_SCHED;
            PG8_LDA(At, 0, 1); PG8_STAGE(PG8_SB(0, 0), b2, voffB); PG8_STAGE(PG8_SB(0, 1), b2 + hstep, voffB); PG8_STAGE_A(PG8_SA(0, 0), a2, k2, 0, un);
            PG8_WAIT_V(8); PG8_WAIT_L(0); PG8_BAR; PG8_MMA(1, 0, At, B0); PG8_MMA(1, 1, At, B1); PG8_BAR; PG8_SCHED;
            PG8_LDB(B0, 1, 0); PG8_LDB(B1, 1, 1); PG8_SCHED; PG8_LDA(At, 1, 0); PG8_STAGE_A(PG8_SA(0, 1), a2, k2, 1, un);
            PG8_WAIT_V(8); PG8_WAIT_L(0); PG8_BAR; PG8_MMA(0, 0, At, B0); PG8_MMA(0, 1, At, B1); PG8_BAR; PG8_SCHED;
            PG8_LDA(At, 1, 1); PG8_STAGE(PG8_SB(1, 0), b3, voffB); PG8_STAGE(PG8_SB(1, 1), b3 + hstep, voffB); PG8_STAGE_A(PG8_SA(1, 0), a3, k3, 0, un);
            PG8_WAIT_V(8); PG8_WAIT_L(0); PG8_BAR; PG8_MMA(1, 0, At, B0); PG8_MMA(1, 1, At, B1); PG8_BAR; PG8_SCHED;
        }
        if constexpr (ALIGN_EPI) { if (wr == 0) PG8_BAR; }
        E(acc, cur, wr, wc, fr, fq);
        if (!has_next) break;
#pragma unroll
        for (int a = 0; a < 2; ++a)
#pragma unroll
            for (int b = 0; b < 2; ++b)
#pragma unroll
                for (int m = 0; m < 4; ++m)
#pragma unroll
                    for (int n = 0; n < 2; ++n) acc[a][b][m][n] = (f32x4){0.f, 0.f, 0.f, 0.f};
        cur = nxt; cA = nA; cB = nB; ++ui;
        if constexpr (Sched::GATHER) { oc[0][0] = on[0][0]; oc[0][1] = on[0][1]; oc[1][0] = on[1][0]; oc[1][1] = on[1][1]; }
        if constexpr (ALIGN_EPI) { if (wr == 1) PG8_BAR; }
    }
    PG8_WAIT_V(0);
    if constexpr (!ALIGN_EPI) { if (wr == 0) PG8_BAR; }
    PG8_BAR;
#undef PG8_SA
#undef PG8_SB
#undef PG8_STAGE
#undef PG8_STAGE_A
#undef PG8_GOFF
#undef PG8_TABDMA
#undef PG8_LDA
#undef PG8_LDB
#undef PG8_MMA
#undef PG8_WAIT_V
#undef PG8_WAIT_L
#undef PG8_BAR
#undef PG8_SCHED
}

struct DenseSched {
    static constexpr bool GATHER = false;
    const char* A; const char* Bt; int nM, nN, G, c, K;
    const char* Abase = nullptr; const int* list = nullptr; const LAS int* tab = nullptr; const LAS int* cntl = nullptr;
    __device__ __forceinline__ bool next(int i, Unit& u) const {
        int pm, pn; if (!static_tile(i, G, c, nM, nN, pm, pn)) return false;
        u.row0 = pm * BM; u.col0 = pn * BM; u.e = 0; u.aux = 0; u.A = A + (size_t)pm * BM * K * 2; u.B = Bt + (size_t)pn * BM * K * 2; return true;
    }
};
struct BranchSched {
    static constexpr bool GATHER = false;
    const char* A0; const char* A1; const char* A2; const char* W3; int G, c;
    const char* Abase = nullptr; const int* list = nullptr; const LAS int* tab = nullptr; const LAS int* cntl = nullptr;
    __device__ __forceinline__ bool next(int i, Unit& u) const {
        const int br = i % 3; int pm, pn; if (!static_tile(i / 3, G, c, NTOK / BM, DM / BM, pm, pn)) return false;
        u.row0 = pm * BM; u.col0 = pn * BM; u.e = br; u.aux = 0;
        u.A = (br == 0 ? A0 : (br == 1 ? A1 : A2)) + (size_t)pm * BM * DM * 2; u.B = W3 + ((size_t)br * DM + (size_t)pn * BM) * DM * 2; return true;
    }
};
template <bool GATHER_>
struct MoeSchedT {
    static constexpr bool GATHER = GATHER_;
    const char* A; const char* W; const LAS int* tstart; size_t Wstride; int nN, G, c;
    const char* Abase; const int* list; const LAS int* tab; const LAS int* cntl;
    __device__ __forceinline__ bool next(int i, Unit& u) const {
        const int nM = tstart[NEXP]; int pm, pn; if (!static_tile(i, G, c, nM, nN, pm, pn)) return false;
        int e = 0;
#pragma unroll 1
        for (int j = 1; j < NEXP; ++j) e += (tstart[j] <= pm) ? 1 : 0;
        u.row0 = pm * BM; u.col0 = pn * BM; u.e = e; u.aux = (pm - tstart[e]) * BM;
        u.A = A + (size_t)pm * BM * DM * 2; u.B = W + (size_t)e * Wstride + (size_t)pn * BM * DM * 2; return true;
    }
};
typedef MoeSchedT<false> MoeSched;
typedef MoeSchedT<true> MoeGatherSched;

struct EpiBf16 {
    bf16_t* O; int ldc; const float* bias; int bstride;
    __device__ __forceinline__ void operator()(const f32x4 (&acc)[2][2][4][2], const Unit& u, int wr, int wc, int fr, int fq) const {
        const int row0 = u.row0 + wr * 64 + fr, col0 = u.col0 + wc * 32 + 8 * fq;
        f32x4 bv[2][2];
#pragma unroll
        for (int bj = 0; bj < 2; ++bj)
#pragma unroll
            for (int n = 0; n < 2; ++n) bv[bj][n] = bias ? *(const f32x4*)(bias + (size_t)u.e * bstride + col0 + bj * HALF + 4 * n) : (f32x4){0.f, 0.f, 0.f, 0.f};
#pragma unroll
        for (int ai = 0; ai < 2; ++ai)
#pragma unroll
            for (int m = 0; m < 4; ++m) { bf16_t* rowp = O + (size_t)(row0 + ai * HALF + m * 16) * ldc + col0;
#pragma unroll
                for (int bj = 0; bj < 2; ++bj) { const f32x4 v0 = acc[ai][bj][m][0] + bv[bj][0], v1 = acc[ai][bj][m][1] + bv[bj][1];
                    u32x4 w; w.x = cvt_pk_bf16(v0[0], v0[1]); w.y = cvt_pk_bf16(v0[2], v0[3]); w.z = cvt_pk_bf16(v1[0], v1[1]); w.w = cvt_pk_bf16(v1[2], v1[3]);
                    *(u32x4*)(rowp + bj * HALF) = w; } }
    }
};
struct EpiBranch {
    float* MRG; bf16_t* MRGB; const bf16_t* PROJB;
    __device__ __forceinline__ void operator()(const f32x4 (&acc)[2][2][4][2], const Unit& u, int wr, int wc, int fr, int fq) const {
        const int row0 = u.row0 + wr * 64 + fr, col0 = u.col0 + wc * 32 + 8 * fq, br = u.e;
#pragma unroll
        for (int ai = 0; ai < 2; ++ai)
#pragma unroll
            for (int m = 0; m < 4; ++m) { const size_t row = (size_t)(row0 + ai * HALF + m * 16);
#pragma unroll
                for (int bj = 0; bj < 2; ++bj) { const int col = col0 + bj * HALF;
                    const u32x4 gl = *(const u32x4*)(PROJB + row * PROJ_COLS + PJ_GATES + br * DM + col);
                    f32x4 v0, v1;
                    v0[0] = sigmoidf_(bflo(gl.x)) * acc[ai][bj][m][0][0]; v0[1] = sigmoidf_(bfhi(gl.x)) * acc[ai][bj][m][0][1];
                    v0[2] = sigmoidf_(bflo(gl.y)) * acc[ai][bj][m][0][2]; v0[3] = sigmoidf_(bfhi(gl.y)) * acc[ai][bj][m][0][3];
                    v1[0] = sigmoidf_(bflo(gl.z)) * acc[ai][bj][m][1][0]; v1[1] = sigmoidf_(bfhi(gl.z)) * acc[ai][bj][m][1][1];
                    v1[2] = sigmoidf_(bflo(gl.w)) * acc[ai][bj][m][1][2]; v1[3] = sigmoidf_(bfhi(gl.w)) * acc[ai][bj][m][1][3];
                    float* mp = MRG + row * DM + col;
                    if (br != 0) { v0 += *(const f32x4*)mp; v1 += *(const f32x4*)(mp + 4); }
                    if (br != 2) { *(f32x4*)mp = v0; *(f32x4*)(mp + 4) = v1; }
                    else { u32x4 w; w.x = cvt_pk_bf16(v0[0], v0[1]); w.y = cvt_pk_bf16(v0[2], v0[3]); w.z = cvt_pk_bf16(v1[0], v1[1]); w.w = cvt_pk_bf16(v1[2], v1[3]);
                        *(u32x4*)(MRGB + row * DM + col) = w; } } }
    }
};
struct EpiSwiglu {
    bf16_t* H; const float* b_gu;
    __device__ __forceinline__ void operator()(const f32x4 (&acc)[2][2][4][2], const Unit& u, int wr, int wc, int fr, int fq) const {
        const int row0 = u.row0 + wr * 64 + fr, jj0 = wc * 32 + 8 * fq, oc0 = (u.col0 >> 1) + jj0;
        const float* bp = b_gu + (size_t)u.e * 2048 + 2 * oc0;
        float bg[8], bl[8];
#pragma unroll
        for (int j = 0; j < 4; ++j) { const f32x4 b4 = *(const f32x4*)(bp + 4 * j); bg[2 * j] = b4[0]; bl[2 * j] = b4[1]; bg[2 * j + 1] = b4[2]; bl[2 * j + 1] = b4[3]; }
#pragma unroll
        for (int ai = 0; ai < 2; ++ai)
#pragma unroll
            for (int m = 0; m < 4; ++m) { const size_t row = (size_t)(row0 + ai * HALF + m * 16);
                float o[8];
#pragma unroll
                for (int n = 0; n < 2; ++n)
#pragma unroll
                    for (int j = 0; j < 4; ++j) {
                        const float gate = fminf(acc[ai][0][m][n][j] + bg[4 * n + j], 7.0f);
                        const float lin = fminf(fmaxf(acc[ai][1][m][n][j] + bl[4 * n + j], -7.0f), 7.0f);
                        o[4 * n + j] = gate * sigmoidf_(1.702f * gate) * (lin + 1.0f);
                    }
                u32x4 w; w.x = cvt_pk_bf16(o[0], o[1]); w.y = cvt_pk_bf16(o[2], o[3]); w.z = cvt_pk_bf16(o[4], o[5]); w.w = cvt_pk_bf16(o[6], o[7]);
                *(u32x4*)(H + row * DM + oc0) = w; }
    }
};
struct EpiPle {
    bf16_t* O; const bf16_t* PP;
    __device__ __forceinline__ void operator()(const f32x4 (&acc)[2][2][4][2], const Unit& u, int wr, int wc, int fr, int fq) const {
        const int row0 = u.row0 + wr * 64 + fr, col0 = u.col0 + wc * 32 + 8 * fq;
#pragma unroll
        for (int ai = 0; ai < 2; ++ai)
#pragma unroll
            for (int m = 0; m < 4; ++m) { const size_t row = (size_t)(row0 + ai * HALF + m * 16);
#pragma unroll
                for (int bj = 0; bj < 2; ++bj) { const int col = col0 + bj * HALF;
                    const u32x4 pp = *(const u32x4*)(PP + row * DM + col);
                    const f32x4 a0 = acc[ai][bj][m][0], a1 = acc[ai][bj][m][1];
                    u32x4 w;
                    w.x = cvt_pk_bf16(sigmoidf_(a0[0]) * bflo(pp.x), sigmoidf_(a0[1]) * bfhi(pp.x));
                    w.y = cvt_pk_bf16(sigmoidf_(a0[2]) * bflo(pp.y), sigmoidf_(a0[3]) * bfhi(pp.y));
                    w.z = cvt_pk_bf16(sigmoidf_(a1[0]) * bflo(pp.z), sigmoidf_(a1[1]) * bfhi(pp.z));
                    w.w = cvt_pk_bf16(sigmoidf_(a1[2]) * bflo(pp.w), sigmoidf_(a1[3]) * bfhi(pp.w));
                    *(u32x4*)(O + row * DM + col) = w; } }
    }
};
}

constexpr int NWAVES = 8;
constexpr int LDS_BYTES = 163840;
constexpr int LDS_MISC = 155648;
constexpr size_t MiB = 1u << 20;
constexpr size_t WS_CTL = 0;
constexpr size_t WS_W = 1 * MiB, WL_STRIDE = 224 * MiB;
constexpr size_t W_IN = 0, W_O3 = 21 * MiB, W_OUT = 27 * MiB, W_GU = 29 * MiB, W_DN = 157 * MiB, W_PG = 221 * MiB, W_PP = 223 * MiB, W_LRU = 223 * MiB + 512 * 1024;
constexpr size_t WS_PB = WS_W + 2 * WL_STRIDE;
constexpr size_t WS_XB = WS_PB + 32 * MiB;
constexpr size_t WS_XF = WS_XB + 64 * MiB;
constexpr size_t WS_PROJ = WS_XF + 128 * MiB;
constexpr size_t WS_GO = WS_PROJ + 672 * MiB, WS_LO = WS_GO + 64 * MiB, WS_SO = WS_LO + 64 * MiB;
constexpr size_t WS_M = WS_SO + 64 * MiB;
constexpr size_t WS_SMALL = WS_M + 496 * MiB;
constexpr size_t WS_AB = WS_SMALL, WS_GG = WS_AB + 2 * MiB, WS_BT = WS_GG + 1 * MiB, WS_GATES = WS_BT + 1 * MiB, WS_ES = WS_GATES + MiB / 2, WS_LIST = WS_ES + MiB / 2;
constexpr size_t WS_END = WS_LIST + 4 * MiB;
static_assert(WS_END <= 2048 * MiB, "workspace map must fit 2 GiB");
constexpr size_t M_QN = 0, M_KN = 64 * MiB, M_VV = 128 * MiB, M_OO = 192 * MiB;
constexpr size_t M_XC = 0, M_LA = 128 * MiB, M_LU = 256 * MiB;
constexpr size_t M_MRG = 0, M_MRGB = 128 * MiB, M_YY = 192 * MiB;
constexpr size_t M_XS = 0;
constexpr size_t M_PP = 0, M_PLEO = 64 * MiB;
constexpr size_t PJ_H = 0, PJ_OB = 272 * MiB;
constexpr int CW_CNT = 1024;
constexpr int CW_BAR = 4096;

struct MArgs { const float* in[34]; float* out; unsigned char* ws; int ph_lo, ph_hi; };
enum { I_X = 0, I_P, I_WIN, I_CONVQKV, I_ALOG, I_DTB, I_GNW, I_RGCW, I_RGCB, I_RGWA, I_RGBA, I_RGWX, I_RGBX, I_RGLAM, I_SINKS, I_RELB, I_WOG, I_WOL, I_WOS, I_WOUT,
       I_LN1G, I_LN1B, I_RW, I_RB, I_WGU, I_BGU, I_WDN, I_BDN, I_LN2G, I_LN2B, I_PLEG, I_PLEP, I_LN3G, I_LN3B };

template <int MAP>
__device__ __forceinline__ int src_col(int n) {
    if (MAP == 1) return n < 4096 ? n : n + 16;
    if (MAP == 2) { const int pn = n >> 8, half = (n >> 7) & 1, jj = n & 127; return 2 * (pn * 128 + jj) + half; }
    return n;
}
template <int MAP>
__device__ __forceinline__ void transpose_item(const float* W, int K, int ldw, int Nout, bf16_t* WT, LAS float* scr, int item, int lane) {
    const int nblk = Nout / 32, kb = item / nblk, nb = item % nblk, k0 = 64 * kb, n0 = 32 * nb;
    const int sc = src_col<MAP>(n0 + (lane & 31));
    float tmpv[32];
#pragma unroll
    for (int i = 0; i < 32; ++i) tmpv[i] = W[(size_t)(k0 + 2 * i + (lane >> 5)) * ldw + sc];
#pragma unroll
    for (int i = 0; i < 32; ++i) scr[(2 * i + (lane >> 5)) * 33 + (lane & 31)] = tmpv[i];
    asm volatile("s_waitcnt lgkmcnt(0)" ::: "memory");
    const int c = lane & 7;
#pragma unroll
    for (int j = 0; j < 4; ++j) { const int n = (lane >> 3) + 8 * j; const LAS float* s = scr + (8 * c) * 33 + n;
        u32x4 o; o.x = pk2(s[0 * 33], s[1 * 33]); o.y = pk2(s[2 * 33], s[3 * 33]); o.z = pk2(s[4 * 33], s[5 * 33]); o.w = pk2(s[6 * 33], s[7 * 33]);
        *(u32x4*)(WT + (size_t)(n0 + n) * K + k0 + 8 * c) = o; }
    asm volatile("s_waitcnt lgkmcnt(0)" ::: "memory");
}
__device__ __forceinline__ void transpose_item_gu(const float* W, bf16_t* WT, LAS float* scr, int item, int lane) {
    const int kb = item >> 5, jb = item & 31, k0 = 64 * kb, j0 = 32 * jb;
    f32x2 tmpv[32];
#pragma unroll
    for (int i = 0; i < 32; ++i) tmpv[i] = *(const f32x2*)(W + (size_t)(k0 + 2 * i + (lane >> 5)) * 2048 + 2 * (j0 + (lane & 31)));
#pragma unroll
    for (int i = 0; i < 32; ++i) *(LAS f32x2*)(scr + (2 * i + (lane >> 5)) * 66 + 2 * (lane & 31)) = tmpv[i];
    asm volatile("s_waitcnt lgkmcnt(0)" ::: "memory");
    const int c = lane & 7;
#pragma unroll
    for (int half = 0; half < 2; ++half)
#pragma unroll
        for (int jq = 0; jq < 4; ++jq) { const int nl = (lane >> 3) + 8 * jq, j = j0 + nl, n = (j >> 7) * 256 + half * 128 + (j & 127);
            const LAS float* s = scr + (8 * c) * 66 + 2 * nl + half;
            u32x4 o; o.x = pk2(s[0 * 66], s[1 * 66]); o.y = pk2(s[2 * 66], s[3 * 66]); o.z = pk2(s[4 * 66], s[5 * 66]); o.w = pk2(s[6 * 66], s[7 * 66]);
            *(u32x4*)(WT + (size_t)n * 1024 + k0 + 8 * c) = o; }
    asm volatile("s_waitcnt lgkmcnt(0)" ::: "memory");
}
template <int MAP>
__device__ __forceinline__ void transpose_seg(const float* W, int K, int ldw, int Nout, bf16_t* WT, LAS float* scr, int gw, int NGW, int lane) {
    const int nitems = (K / 64) * (Nout / 32);
    for (int it = gw; it < nitems; it += NGW) transpose_item<MAP>(W, K, ldw, Nout, WT, scr, it, lane);
}
__device__ __forceinline__ void cvt_rows(const float* src, bf16_t* dst, size_t n, int G) {
    for (size_t i = (size_t)blockIdx.x * 512 + threadIdx.x; i < n / 8; i += (size_t)G * 512) {
        const f32x4 v0 = *(const f32x4*)(src + i * 8), v1 = *(const f32x4*)(src + i * 8 + 4);
        u32x4 o; o.x = pk2(v0[0], v0[1]); o.y = pk2(v0[2], v0[3]); o.z = pk2(v1[0], v1[1]); o.w = pk2(v1[2], v1[3]);
        *(u32x4*)(dst + i * 8) = o;
    }
}
template <int NE4>
__device__ __forceinline__ void stage_smallw(const float* W, int ld, int col0, LAS unsigned char* dst, int tid) {
    for (int i = tid; i < 1024 * NE4; i += 512) { const int k = i / NE4, e4 = i % NE4; const int m = (k >> 8) * 4 + (k & 3), ln = (k & 255) >> 2;
        *(LAS f32x4*)(dst + ((e4 * 16 + m) * 64 + ln) * 16) = *(const f32x4*)(W + (size_t)k * ld + col0 + 4 * e4); }
}
template <int NE4>
__device__ __forceinline__ void small_project(const f32x4 (&v)[4], const LAS unsigned char* wsm, float (&acc)[4 * NE4], int lane) {
#pragma unroll
    for (int e = 0; e < 4 * NE4; ++e) acc[e] = 0.f;
#pragma unroll
    for (int j = 0; j < 4; ++j)
#pragma unroll
        for (int q = 0; q < 4; ++q) { const float xv = v[j][q];
#pragma unroll
            for (int e4 = 0; e4 < NE4; ++e4) { const f32x4 w4 = *(const LAS f32x4*)(wsm + ((e4 * 16 + 4 * j + q) * 64 + lane) * 16);
                acc[4 * e4 + 0] = fmaf(xv, w4[0], acc[4 * e4 + 0]); acc[4 * e4 + 1] = fmaf(xv, w4[1], acc[4 * e4 + 1]);
                acc[4 * e4 + 2] = fmaf(xv, w4[2], acc[4 * e4 + 2]); acc[4 * e4 + 3] = fmaf(xv, w4[3], acc[4 * e4 + 3]); } }
}
__device__ __forceinline__ float reduce_scatter32(const float (&acc)[32], int lane) {
    float a16[16], a8[8], a4[4], a2[2];
    const bool b5 = lane & 32, b4 = lane & 16, b3 = lane & 8, b2 = lane & 4, b1 = lane & 2;
#pragma unroll
    for (int i = 0; i < 16; ++i) { const float keep = b5 ? acc[i + 16] : acc[i], give = b5 ? acc[i] : acc[i + 16]; a16[i] = keep + __shfl_xor(give, 32); }
#pragma unroll
    for (int i = 0; i < 8; ++i) { const float keep = b4 ? a16[i + 8] : a16[i], give = b4 ? a16[i] : a16[i + 8]; a8[i] = keep + __shfl_xor(give, 16); }
#pragma unroll
    for (int i = 0; i < 4; ++i) { const float keep = b3 ? a8[i + 4] : a8[i], give = b3 ? a8[i] : a8[i + 4]; a4[i] = keep + __shfl_xor(give, 8); }
#pragma unroll
    for (int i = 0; i < 2; ++i) { const float keep = b2 ? a4[i + 2] : a4[i], give = b2 ? a4[i] : a4[i + 2]; a2[i] = keep + __shfl_xor(give, 4); }
    const float keep = b1 ? a2[1] : a2[0], give = b1 ? a2[0] : a2[1];
    float v = keep + __shfl_xor(give, 2);
    v += __shfl_xor(v, 1);
    return v;
}
__device__ __forceinline__ float reduce_scatter16(const float (&acc)[16], int lane) {
    float a8[8], a4[4], a2[2];
    const bool b5 = lane & 32, b4 = lane & 16, b3 = lane & 8, b2 = lane & 4;
#pragma unroll
    for (int i = 0; i < 8; ++i) { const float keep = b5 ? acc[i + 8] : acc[i], give = b5 ? acc[i] : acc[i + 8]; a8[i] = keep + __shfl_xor(give, 32); }
#pragma unroll
    for (int i = 0; i < 4; ++i) { const float keep = b4 ? a8[i + 4] : a8[i], give = b4 ? a8[i] : a8[i + 4]; a4[i] = keep + __shfl_xor(give, 16); }
#pragma unroll
    for (int i = 0; i < 2; ++i) { const float keep = b3 ? a4[i + 2] : a4[i], give = b3 ? a4[i] : a4[i + 2]; a2[i] = keep + __shfl_xor(give, 8); }
    const float keep = b2 ? a2[1] : a2[0], give = b2 ? a2[0] : a2[1];
    float v = keep + __shfl_xor(give, 4);
    v += __shfl_xor(v, 2); v += __shfl_xor(v, 1);
    return v;
}
__device__ __forceinline__ void ab_project(const f32x4 (&v)[4], const LAS unsigned char* wsm, float* ABrow, int lane) {
    float acc[16];
    small_project<4>(v, wsm, acc, lane);
    const float s = reduce_scatter16(acc, lane);
    if ((lane & 3) == 0) ABrow[lane >> 2] = s;
}
__device__ __forceinline__ void ln_inplace(f32x4 (&v)[4], const float* g, const float* b, int lane) {
    float s = 0.f;
#pragma unroll
    for (int j = 0; j < 4; ++j) s += (v[j][0] + v[j][1]) + (v[j][2] + v[j][3]);
    const float mu = wave_sum(s) * (1.0f / DM);
    float s2 = 0.f;
#pragma unroll
    for (int j = 0; j < 4; ++j) { v[j] = v[j] - mu; s2 += (v[j][0] * v[j][0] + v[j][1] * v[j][1]) + (v[j][2] * v[j][2] + v[j][3] * v[j][3]); }
    const float rstd = rsqrtf(wave_sum(s2) * (1.0f / DM) + 1e-5f);
#pragma unroll
    for (int j = 0; j < 4; ++j) { const f32x4 g4 = *(const f32x4*)(g + 256 * j + 4 * lane), b4 = *(const f32x4*)(b + 256 * j + 4 * lane); v[j] = v[j] * rstd * g4 + b4; }
}
__device__ __forceinline__ void store_row(const f32x4 (&v)[4], float* xf, bf16_t* xb, int lane) {
#pragma unroll
    for (int j = 0; j < 4; ++j) { if (xf) *(f32x4*)(xf + 256 * j + 4 * lane) = v[j];
        u32x2 o; o.x = pk2(v[j][0], v[j][1]); o.y = pk2(v[j][2], v[j][3]); *(u32x2*)(xb + 256 * j + 4 * lane) = o; }
}
__device__ __forceinline__ f32x4 ld_bf4(const bf16_t* p) { const u32x2 y2 = *(const u32x2*)p; return (f32x4){bflo(y2.x), bfhi(y2.x), bflo(y2.y), bfhi(y2.y)}; }
__device__ __forceinline__ int t5_bucket(int dist) {
    if (dist < 16) return dist;
    int l = 16 + (int)(logf((float)dist / 16.0f) / logf(8.0f) * 16.0f);
    return l < 31 ? l : 31;
}


typedef float f32x16 __attribute__((ext_vector_type(16)));
typedef __bf16 bf16x2_t __attribute__((ext_vector_type(2)));
__device__ __forceinline__ unsigned cvtpk(float lo, float hi) { const f32x2 v = {lo, hi}; const bf16x2_t b = __builtin_convertvector(v, bf16x2_t); return __builtin_bit_cast(unsigned, b); }
__device__ __forceinline__ bf16x8 pack8(const f32x16& c, const int s) {
    u32x4 p; p.x = cvtpk(c[8 * s + 0], c[8 * s + 1]); p.y = cvtpk(c[8 * s + 2], c[8 * s + 3]); p.z = cvtpk(c[8 * s + 4], c[8 * s + 5]); p.w = cvtpk(c[8 * s + 6], c[8 * s + 7]);
    return __builtin_bit_cast(bf16x8, p);
}
#define MFMA32(a, b, c) __builtin_amdgcn_mfma_f32_32x32x16_bf16((a), (b), (c), 0, 0, 0)
constexpr size_t G_WN = 0, G_QN = 64 * MiB, G_AN = 128 * MiB, G_KT = 160 * MiB, G_UN = 224 * MiB, G_GC = 352 * MiB, G_OO = 353 * MiB, G_VT = 417 * MiB, G_EG = 449 * MiB;
constexpr int GA_LDS = 19456;
constexpr int GA_TSTR = 272;
constexpr int GA_USTR = 144;
constexpr int GA_G = 18304, GA_B = 18560, GA_RK = 18816, GA_RQ = 19072;

__device__ __forceinline__ void gdn_stage_raw(const bf16_t* src  , int seqpos0, LAS unsigned char* wl, int lane) {
    if (seqpos0 > 0) {
#pragma unroll
        for (int u = 0; u < 3; ++u) __builtin_amdgcn_global_load_lds((const unsigned*)(src + (ptrdiff_t)(u - 3) * PROJ_COLS), (LAS unsigned*)(wl + u * GA_TSTR), 4, 0, 0);
    } else {
#pragma unroll
        for (int u = 0; u < 3; ++u) *(LAS unsigned*)(wl + u * GA_TSTR + 4 * lane) = 0u;
    }
#pragma unroll 8
    for (int p = 0; p < 64; ++p) __builtin_amdgcn_global_load_lds((const unsigned*)(src + (size_t)p * PROJ_COLS), (LAS unsigned*)(wl + (p + 3) * GA_TSTR), 4, 0, 0);
}
template <int UNR, class F>
__device__ __forceinline__ void gdn_conv_stream(LAS unsigned char* wl, const float* cw  , int lane, F&& emit) {
    f32x2 w[4];
#pragma unroll
    for (int j = 0; j < 4; ++j) w[j] = *(const f32x2*)(cw + j * 3072);
    asm volatile("s_waitcnt vmcnt(0)" ::: "memory");
    unsigned r0 = *(LAS unsigned*)(wl + 0 * GA_TSTR + 4 * lane), r1 = *(LAS unsigned*)(wl + 1 * GA_TSTR + 4 * lane), r2 = *(LAS unsigned*)(wl + 2 * GA_TSTR + 4 * lane);
#pragma unroll 1
    for (int pb_ = 0; pb_ < 64 / UNR; ++pb_) {
        unsigned cu[UNR];
#pragma unroll
        for (int u = 0; u < UNR; ++u) cu[u] = *(LAS unsigned*)(wl + (UNR * pb_ + u + 3) * GA_TSTR + 4 * lane);
#pragma unroll
        for (int u = 0; u < UNR; ++u) {
            const unsigned r3 = cu[u];
            float y0 = w[0][0] * bflo(r0); y0 = fmaf(w[1][0], bflo(r1), y0); y0 = fmaf(w[2][0], bflo(r2), y0); y0 = fmaf(w[3][0], bflo(r3), y0);
            float y1 = w[0][1] * bfhi(r0); y1 = fmaf(w[1][1], bfhi(r1), y1); y1 = fmaf(w[2][1], bfhi(r2), y1); y1 = fmaf(w[3][1], bfhi(r3), y1);
            r0 = r1; r1 = r2; r2 = r3;
            emit(pb_, u, siluf_(y0), siluf_(y1));
        }
    }
}

__device__ __forceinline__ void gdn_a_item(const __attribute__((address_space(4))) MArgs& a, unsigned char* ws, const int L, LAS unsigned char* wl, const int item, const int lane, const int vt_slot) {
    const int n = item & 63, h = (item >> 6) & 7, b = item >> 9;
    const size_t t0 = (size_t)b * SEQ + (size_t)n * 64;
    const int r = lane & 31, hh = lane >> 5;
    const bf16_t* PROJB = (const bf16_t*)(ws + WS_PROJ);
    unsigned char* RM = ws + WS_M;
    LAS float* Gs = (LAS float*)(wl + GA_G); LAS float* Bs = (LAS float*)(wl + GA_B); LAS float* Rk = (LAS float*)(wl + GA_RK); LAS float* Rq = (LAS float*)(wl + GA_RQ);
    float Gtok, Glast;
    auto row_ss = [&]() { float ss = 0.f;
#pragma unroll
        for (int c8 = 0; c8 < 16; ++c8) { const u32x4 w = *(const LAS u32x4*)(wl + lane * GA_TSTR + 16 * c8);
            ss = fmaf(bflo(w.x), bflo(w.x), ss); ss = fmaf(bfhi(w.x), bfhi(w.x), ss); ss = fmaf(bflo(w.y), bflo(w.y), ss); ss = fmaf(bfhi(w.y), bfhi(w.y), ss);
            ss = fmaf(bflo(w.z), bflo(w.z), ss); ss = fmaf(bfhi(w.z), bfhi(w.z), ss); ss = fmaf(bflo(w.w), bflo(w.w), ss); ss = fmaf(bfhi(w.w), bfhi(w.w), ss); }
        return ss; };
    {
        const float* AB = (const float*)(ws + WS_AB);
        const float av = AB[(t0 + lane) * 16 + h], bv = AB[(t0 + lane) * 16 + 8 + h];
        float G = -expf(a.in[I_ALOG][L * 8 + h]) * softplusf_(av + a.in[I_DTB][L * 8 + h]);
#pragma unroll
        for (int o = 1; o < 64; o <<= 1) { const float y = __shfl_up(G, o); if (lane >= o) G += y; }
        Gs[lane] = G; Bs[lane] = sigmoidf_(bv);
        Gtok = G; Glast = __builtin_bit_cast(float, __builtin_amdgcn_readlane(__builtin_bit_cast(int, G), 63));
    }
    const float* cwL = a.in[I_CONVQKV] + (size_t)L * 4 * 3072 + h * 128 + 2 * lane;
    const bf16_t* srcL = PROJB + t0 * PROJ_COLS + h * 128 + 2 * lane;
    gdn_stage_raw(srcL + PJ_V, n, wl, lane);
    bf16_t* VT = (bf16_t*)(RM + G_VT) + (size_t)vt_slot * 8192;
    {
        float vb0[8], vb1[8];
        gdn_conv_stream<8>(wl, cwL + 2048, lane, [&](int pb_, int u, float y0, float y1) {
            const int p = 8 * pb_ + u;
            vb0[u] = y0; vb1[u] = y1;
            if (u == 7) {
                u32x4 o0; o0.x = cvtpk(vb0[0], vb0[1]); o0.y = cvtpk(vb0[2], vb0[3]); o0.z = cvtpk(vb0[4], vb0[5]); o0.w = cvtpk(vb0[6], vb0[7]);
                u32x4 o1; o1.x = cvtpk(vb1[0], vb1[1]); o1.y = cvtpk(vb1[2], vb1[3]); o1.z = cvtpk(vb1[4], vb1[5]); o1.w = cvtpk(vb1[6], vb1[7]);
                *(u32x4*)(VT + (size_t)(2 * lane) * 64 + (p & ~7)) = o0; *(u32x4*)(VT + (size_t)(2 * lane + 1) * 64 + (p & ~7)) = o1;
            }
        });
    }
    asm volatile("s_waitcnt lgkmcnt(0)" ::: "memory");
    gdn_stage_raw(srcL + PJ_K, n, wl, lane);
    {
        bf16_t* KTN = (bf16_t*)(RM + G_KT) + (size_t)item * 8192;
        float kb0[4], kb1[4];
        const int d0 = 2 * lane, mtp = d0 >> 5, rr = d0 & 31;
        gdn_conv_stream<4>(wl, cwL + 1024, lane, [&](int pb_, int u, float y0, float y1) {
            const int p = 4 * pb_ + u;
            *(LAS unsigned*)(wl + p * GA_TSTR + 4 * lane) = cvtpk(y0, y1);
            kb0[u] = y0; kb1[u] = y1;
            if (u == 3) {
                const int ks = p >> 4, q4 = (p & 15) >> 2, h_ = q4 & 1, jh = q4 >> 1;
                const size_t off = ((size_t)((mtp * 4 + ks) * 64 + h_ * 32 + rr)) * 8 + jh * 4;
                u32x2 o0; o0.x = cvtpk(kb0[0], kb0[1]); o0.y = cvtpk(kb0[2], kb0[3]);
                u32x2 o1; o1.x = cvtpk(kb1[0], kb1[1]); o1.y = cvtpk(kb1[2], kb1[3]);
                *(u32x2*)(KTN + off) = o0; *(u32x2*)(KTN + off + 8) = o1;
            }
        });
    }
    const float rnk = rsqrtf(row_ss() + 1e-6f);
    Rk[lane] = rnk;
    bf16x8 kf[2][8];
#pragma unroll
    for (int mt = 0; mt < 2; ++mt)
#pragma unroll
        for (int s = 0; s < 8; ++s) kf[mt][s] = *(const LAS bf16x8*)(wl + (32 * mt + r) * GA_TSTR + (16 * s + 8 * hh) * 2);
    asm volatile("s_waitcnt lgkmcnt(0)" ::: "memory");
    gdn_stage_raw(srcL + PJ_Q, n, wl, lane);
    gdn_conv_stream<4>(wl, cwL, lane, [&](int pb_, int u, float y0, float y1) {
        *(LAS unsigned*)(wl + (4 * pb_ + u) * GA_TSTR + 4 * lane) = cvtpk(y0, y1);
    });
    const float rnq = rsqrtf(row_ss() + 1e-6f) * 0.08838834764831845f;
    Rq[lane] = rnq;
    {
        float* EG = (float*)(RM + G_EG) + (size_t)item * 192;
        EG[lane] = fexp(Gtok) * rnq; EG[64 + lane] = fexp(Glast - Gtok) * rnk;
        if (lane == 0) EG[128] = fexp(Glast);
    }
    {
        bf16_t* ANf = (bf16_t*)(RM + G_AN) + (size_t)item * 4096;
#pragma unroll
        for (int it = 0; it < 2; ++it)
#pragma unroll
            for (int jt = 0; jt <= it; ++jt) {
                f32x16 c = {0.f, 0.f, 0.f, 0.f, 0.f, 0.f, 0.f, 0.f, 0.f, 0.f, 0.f, 0.f, 0.f, 0.f, 0.f, 0.f};
#pragma unroll
                for (int s = 0; s < 8; ++s) { const bf16x8 qf = *(const LAS bf16x8*)(wl + (32 * it + r) * GA_TSTR + (16 * s + 8 * hh) * 2); c = MFMA32(kf[jt][s], qf, c); }
                const int i = 32 * it + r; const float Gi = Gs[i], Rqi = Rq[i];
#pragma unroll
                for (int g4 = 0; g4 < 4; ++g4) { const f32x4 Gj = *(const LAS f32x4*)(Gs + 32 * jt + 8 * g4 + 4 * hh), Rkj = *(const LAS f32x4*)(Rk + 32 * jt + 8 * g4 + 4 * hh);
#pragma unroll
                    for (int q = 0; q < 4; ++q) { const int j = 32 * jt + 8 * g4 + 4 * hh + q; c[4 * g4 + q] = (i >= j) ? c[4 * g4 + q] * (Rqi * Rkj[q] * fexp(Gi - Gj[q])) : 0.f; } }
#pragma unroll
                for (int sp = 0; sp < 2; ++sp) *(bf16x8*)((unsigned char*)ANf + (unsigned)(lane * 16) + (it * 4 + 2 * jt + sp) * 1024) = pack8(c, sp);
            }
    }
    {
        f32x16 ck[3];
#pragma unroll
        for (int tix = 0; tix < 3; ++tix) {
            const int it = tix == 0 ? 0 : 1, jt = tix == 2 ? 1 : 0;
            f32x16 c = {0.f, 0.f, 0.f, 0.f, 0.f, 0.f, 0.f, 0.f, 0.f, 0.f, 0.f, 0.f, 0.f, 0.f, 0.f, 0.f};
#pragma unroll
            for (int s = 0; s < 8; ++s) c = MFMA32(kf[it][s], kf[jt][s], c);
            const int j = 32 * jt + r; const float Gj = Gs[j], Rkj = Rk[j];
#pragma unroll
            for (int g4 = 0; g4 < 4; ++g4) { const f32x4 Gi = *(const LAS f32x4*)(Gs + 32 * it + 8 * g4 + 4 * hh), Bi = *(const LAS f32x4*)(Bs + 32 * it + 8 * g4 + 4 * hh), Rki = *(const LAS f32x4*)(Rk + 32 * it + 8 * g4 + 4 * hh);
#pragma unroll
                for (int q = 0; q < 4; ++q) { const int i = 32 * it + 8 * g4 + 4 * hh + q; c[4 * g4 + q] = (i > j) ? (Bi[q] * Rki[q] * Rkj) * c[4 * g4 + q] * fexp(Gi[q] - Gj) : 0.f; } }
            ck[tix] = c;
        }
        {
            bf16_t* QNt = (bf16_t*)(RM + G_QN) + (size_t)item * 8192;
    #pragma unroll
            for (int mt = 0; mt < 2; ++mt)
    #pragma unroll
                for (int ks = 0; ks < 8; ++ks) {
                    const LAS unsigned char* rowp = wl + (32 * mt + r) * GA_TSTR + (32 * (ks >> 1) + 16 * (ks & 1) + 4 * hh) * 2;
                    const u32x2 lo = *(const LAS u32x2*)rowp, hi = *(const LAS u32x2*)(rowp + 16);
                    u32x4 o; o.x = lo.x; o.y = lo.y; o.z = hi.x; o.w = hi.y;
                    *(u32x4*)((unsigned char*)QNt + (unsigned)(lane * 16) + (mt * 8 + ks) * 1024) = o;
                }
        }
        asm volatile("s_waitcnt lgkmcnt(0)" ::: "memory");
#pragma unroll
        for (int tix = 0; tix < 3; ++tix) {
            const int it = tix == 0 ? 0 : 1, jt = tix == 2 ? 1 : 0; const int j = 32 * jt + r;
#pragma unroll
            for (int g4 = 0; g4 < 4; ++g4) *(LAS f32x4*)(wl + (j * 64 + 32 * it + 8 * g4 + 4 * hh) * 4) = (f32x4){ck[tix][4 * g4], ck[tix][4 * g4 + 1], ck[tix][4 * g4 + 2], ck[tix][4 * g4 + 3]};
        }
    }
    float t[64];
#pragma unroll
    for (int j = 0; j < 64; ++j) t[j] = 0.f;
    {
        const unsigned ltbase = (unsigned)(size_t)wl;
#pragma unroll
        for (int j = 63; j >= 0; --j) {
            float acc = (lane == j) ? 1.f : 0.f;
            unsigned addr = ltbase + j * 256;
            if (j + 2 < 64) asm volatile("" : "+v"(addr) : "v"(t[(j + 2) & 63]));
#pragma unroll
            for (int i0 = (j + 1) & ~3; i0 < 64; i0 += 4) { const f32x4 l4 = *(const LAS f32x4*)(size_t)(addr + i0 * 4);
                acc = fmaf(-t[i0], l4[0], acc); acc = fmaf(-t[i0 + 1], l4[1], acc); acc = fmaf(-t[i0 + 2], l4[2], acc); acc = fmaf(-t[i0 + 3], l4[3], acc); }
            t[j] = acc;
        }
    }
    bf16x8 vf[4][4];
    {
        unsigned voff = (unsigned)((32 * 0 + r) * 64 + 8 * hh);
        asm volatile("" : "+v"(voff) : "v"(t[0]));
#pragma unroll
        for (int nt = 0; nt < 4; ++nt)
#pragma unroll
            for (int s = 0; s < 4; ++s) vf[nt][s] = *(const bf16x8*)((const unsigned char*)VT + voff * 2u + nt * 4096 + s * 32);
    }
    asm volatile("s_waitcnt lgkmcnt(0)" ::: "memory");
    float bj[64];
#pragma unroll
    for (int j4 = 0; j4 < 16; ++j4) { const f32x4 b4 = *(const LAS f32x4*)(Bs + 4 * j4); bj[4 * j4] = b4[0]; bj[4 * j4 + 1] = b4[1]; bj[4 * j4 + 2] = b4[2]; bj[4 * j4 + 3] = b4[3]; }
#pragma unroll
    for (int j = 0; j < 64; ++j) t[j] *= bj[j];
#pragma unroll
    for (int j8 = 0; j8 < 8; ++j8) { u32x4 o; o.x = cvtpk(t[8 * j8], t[8 * j8 + 1]); o.y = cvtpk(t[8 * j8 + 2], t[8 * j8 + 3]); o.z = cvtpk(t[8 * j8 + 4], t[8 * j8 + 5]); o.w = cvtpk(t[8 * j8 + 6], t[8 * j8 + 7]);
        *(LAS u32x4*)(wl + lane * GA_USTR + 16 * j8) = o; }
    {
        bf16_t* UN = (bf16_t*)(RM + G_UN) + (size_t)item * 8192;
#pragma unroll
        for (int nt = 0; nt < 4; ++nt)
#pragma unroll
            for (int mt = 0; mt < 2; ++mt) {
                f32x16 c = {0.f, 0.f, 0.f, 0.f, 0.f, 0.f, 0.f, 0.f, 0.f, 0.f, 0.f, 0.f, 0.f, 0.f, 0.f, 0.f};
#pragma unroll
                for (int s = 0; s < (mt == 0 ? 2 : 4); ++s) { const bf16x8 af = *(const LAS bf16x8*)(wl + (32 * mt + r) * GA_USTR + (16 * s + 8 * hh) * 2); c = MFMA32(af, vf[nt][s], c); }
#pragma unroll
                for (int sp = 0; sp < 2; ++sp) *(bf16x8*)((unsigned char*)UN + (unsigned)(lane * 16) + ((nt * 2 + mt) * 2 + sp) * 1024) = pack8(c, sp);
            }
    }
    asm volatile("s_waitcnt lgkmcnt(0)" ::: "memory");
#pragma unroll
    for (int j4 = 0; j4 < 16; ++j4) { const f32x4 g4v = *(const LAS f32x4*)(Gs + 4 * j4), rk4 = *(const LAS f32x4*)(Rk + 4 * j4);
        t[4 * j4] *= fexp(g4v[0]) * rk4[0]; t[4 * j4 + 1] *= fexp(g4v[1]) * rk4[1]; t[4 * j4 + 2] *= fexp(g4v[2]) * rk4[2]; t[4 * j4 + 3] *= fexp(g4v[3]) * rk4[3]; }
#pragma unroll
    for (int j8 = 0; j8 < 8; ++j8) { u32x4 o; o.x = cvtpk(t[8 * j8], t[8 * j8 + 1]); o.y = cvtpk(t[8 * j8 + 2], t[8 * j8 + 3]); o.z = cvtpk(t[8 * j8 + 4], t[8 * j8 + 5]); o.w = cvtpk(t[8 * j8 + 6], t[8 * j8 + 7]);
        *(LAS u32x4*)(wl + lane * GA_USTR + 16 * j8) = o; }
    {
        const bf16_t* KTN = (const bf16_t*)(RM + G_KT) + (size_t)item * 8192;
        bf16_t* WN = (bf16_t*)(RM + G_WN) + (size_t)item * 8192;
#pragma unroll
        for (int it = 0; it < 2; ++it) {
            bf16x8 tw[4];
#pragma unroll
            for (int s = 0; s < (it == 0 ? 2 : 4); ++s) { const LAS unsigned char* rowp = wl + (32 * it + r) * GA_USTR + (16 * s + 4 * hh) * 2;
                const u32x2 lo = *(const LAS u32x2*)rowp, hi = *(const LAS u32x2*)(rowp + 16); u32x4 o; o.x = lo.x; o.y = lo.y; o.z = hi.x; o.w = hi.y; tw[s] = __builtin_bit_cast(bf16x8, o); }
#pragma unroll
            for (int dt = 0; dt < 4; ++dt) {
                f32x16 c = {0.f, 0.f, 0.f, 0.f, 0.f, 0.f, 0.f, 0.f, 0.f, 0.f, 0.f, 0.f, 0.f, 0.f, 0.f, 0.f};
#pragma unroll
                for (int s = 0; s < (it == 0 ? 2 : 4); ++s) { const bf16x8 kt = *(const bf16x8*)((const unsigned char*)KTN + (unsigned)(lane * 16) + (dt * 4 + s) * 1024); c = MFMA32(kt, tw[s], c); }
#pragma unroll
                for (int q = 0; q < 16; ++q) c[q] = -c[q];
#pragma unroll
                for (int sp = 0; sp < 2; ++sp) *(bf16x8*)((unsigned char*)WN + (unsigned)(lane * 16) + (it * 8 + 2 * dt + sp) * 1024) = pack8(c, sp);
            }
        }
    }
    asm volatile("s_waitcnt lgkmcnt(0)" ::: "memory");
}

constexpr int GB_BUF = 58112;
__device__ __forceinline__ void gdn_b_scan(unsigned char* ws, LAS unsigned char* lds, const int bh, const int tid) {
    const int lane = tid & 63, wave = __builtin_amdgcn_readfirstlane(tid >> 6), r = lane & 31, hh = lane >> 5;
    unsigned char* RM = ws + WS_M;
    const int b = bh >> 3, h = bh & 7;
    const size_t item0 = (size_t)bh * 64;
    bf16_t* OO = (bf16_t*)(RM + G_OO);
    auto dma_chunk = [&](const size_t item, LAS unsigned char* buf) {
#pragma unroll
        for (int k = 0; k < 7; ++k) {
            const int pi = wave * 7 + k;
            const unsigned char* g;
            if (pi < 16) g = RM + G_WN + item * 16384 + (size_t)pi * 1024;
            else if (pi < 32) g = RM + G_QN + item * 16384 + (size_t)(pi - 16) * 1024;
            else if (pi < 40) g = RM + G_AN + item * 8192 + (size_t)(pi - 32) * 1024;
            else g = RM + G_KT + item * 16384 + (size_t)(pi - 40) * 1024;
            __builtin_amdgcn_global_load_lds((const unsigned*)(g + lane * 16), (LAS unsigned*)(buf + pi * 1024), 16, 0, 0);
        }
        if (wave >= 5) __builtin_amdgcn_global_load_lds((const unsigned*)(RM + G_EG + item * 768 + (size_t)(wave - 5) * 256 + lane * 4), (LAS unsigned*)(buf + 57344 + (wave - 5) * 256), 4, 0, 0);
    };
    f32x16 S[4];
#pragma unroll
    for (int dt = 0; dt < 4; ++dt)
#pragma unroll
        for (int q = 0; q < 16; ++q) S[dt][q] = 0.f;
    dma_chunk(item0, lds);
    bf16x8 Un[2][2];
    if (wave < 4) {
        const unsigned char* UN0 = RM + G_UN + item0 * 16384 + (size_t)wave * 4096 + lane * 16;
#pragma unroll
        for (int mt = 0; mt < 2; ++mt)
#pragma unroll
            for (int sp = 0; sp < 2; ++sp) Un[mt][sp] = *(const bf16x8*)(UN0 + (mt * 2 + sp) * 1024);
    }
    asm volatile("s_waitcnt vmcnt(0)" ::: "memory");
    __syncthreads();
#pragma unroll 1
    for (int n = 0; n < 64; ++n) {
        const size_t item = item0 + n;
        LAS unsigned char* buf = lds + (n & 1) * GB_BUF;
        f32x16 Vn[2], O[2];
        if (wave < 4) {
#pragma unroll
            for (int mt = 0; mt < 2; ++mt)
#pragma unroll
                for (int sp = 0; sp < 2; ++sp) { const u32x4 w = __builtin_bit_cast(u32x4, Un[mt][sp]);
                    Vn[mt][8 * sp + 0] = bflo(w.x); Vn[mt][8 * sp + 1] = bfhi(w.x); Vn[mt][8 * sp + 2] = bflo(w.y); Vn[mt][8 * sp + 3] = bfhi(w.y);
                    Vn[mt][8 * sp + 4] = bflo(w.z); Vn[mt][8 * sp + 5] = bfhi(w.z); Vn[mt][8 * sp + 6] = bflo(w.w); Vn[mt][8 * sp + 7] = bfhi(w.w); }
#pragma unroll
            for (int mt = 0; mt < 2; ++mt)
#pragma unroll
                for (int q = 0; q < 16; ++q) O[mt][q] = 0.f;
            if (n + 1 < 64) {
                const unsigned char* UN = RM + G_UN + (size_t)(item + 1) * 16384 + (size_t)wave * 4096 + lane * 16;
#pragma unroll
                for (int mt = 0; mt < 2; ++mt)
#pragma unroll
                    for (int sp = 0; sp < 2; ++sp) Un[mt][sp] = *(const bf16x8*)(UN + (mt * 2 + sp) * 1024);
            }
        }
        asm volatile("" ::: "memory");
        if (n + 1 < 64) dma_chunk(item + 1, lds + ((n + 1) & 1) * GB_BUF);
        asm volatile("" ::: "memory");
        if (wave < 4) {
            const int sl = wave;
            const LAS float* EGs = (const LAS float*)(buf + 57344);
            bf16x8 Sb[8];
#pragma unroll
            for (int dt = 0; dt < 4; ++dt) { Sb[2 * dt] = pack8(S[dt], 0); Sb[2 * dt + 1] = pack8(S[dt], 1); }
#pragma unroll
            for (int mt = 0; mt < 2; ++mt)
#pragma unroll
                for (int ks = 0; ks < 8; ++ks) {
                    const bf16x8 wf = *(const LAS bf16x8*)(buf + ((mt * 8 + ks) * 64 + lane) * 16);
                    const bf16x8 qf = *(const LAS bf16x8*)(buf + 16384 + ((mt * 8 + ks) * 64 + lane) * 16);
                    Vn[mt] = MFMA32(wf, Sb[ks], Vn[mt]);
                    O[mt] = MFMA32(qf, Sb[ks], O[mt]);
                }
#pragma unroll
            for (int mt = 0; mt < 2; ++mt)
#pragma unroll
                for (int g4 = 0; g4 < 4; ++g4) { const f32x4 E4 = *(const LAS f32x4*)(EGs + 32 * mt + 8 * g4 + 4 * hh);
#pragma unroll
                    for (int q = 0; q < 4; ++q) O[mt][4 * g4 + q] *= E4[q]; }
            bf16x8 Vb[4];
#pragma unroll
            for (int mt = 0; mt < 2; ++mt) { Vb[2 * mt] = pack8(Vn[mt], 0); Vb[2 * mt + 1] = pack8(Vn[mt], 1); }
#pragma unroll
            for (int mt = 0; mt < 2; ++mt)
#pragma unroll
                for (int ks = 0; ks < (mt == 0 ? 2 : 4); ++ks) {
                    const bf16x8 af = *(const LAS bf16x8*)(buf + 32768 + ((mt * 4 + ks) * 64 + lane) * 16);
                    O[mt] = MFMA32(af, Vb[ks], O[mt]);
                }
            {
                bf16_t* orow = OO + ((size_t)b * SEQ + (size_t)n * 64) * DM + h * 128 + sl * 32 + r;
#pragma unroll
                for (int mt = 0; mt < 2; ++mt)
#pragma unroll
                    for (int q = 0; q < 16; ++q) { const int pos = 32 * mt + (q & 3) + 8 * (q >> 2) + 4 * hh; orow[(size_t)pos * DM] = (bf16_t)f2bf(O[mt][q]); }
            }
#pragma unroll
            for (int mt = 0; mt < 2; ++mt)
#pragma unroll
                for (int g4 = 0; g4 < 4; ++g4) { const f32x4 L4 = *(const LAS f32x4*)(EGs + 64 + 32 * mt + 8 * g4 + 4 * hh);
#pragma unroll
                    for (int q = 0; q < 4; ++q) Vn[mt][4 * g4 + q] *= L4[q]; }
#pragma unroll
            for (int mt = 0; mt < 2; ++mt) { Vb[2 * mt] = pack8(Vn[mt], 0); Vb[2 * mt + 1] = pack8(Vn[mt], 1); }
            const float cd = EGs[128];
#pragma unroll
            for (int dt = 0; dt < 4; ++dt)
#pragma unroll
                for (int q = 0; q < 16; ++q) S[dt][q] *= cd;
#pragma unroll
            for (int ks = 0; ks < 4; ++ks)
#pragma unroll
                for (int dt = 0; dt < 4; ++dt) { const bf16x8 kt = *(const LAS bf16x8*)(buf + 40960 + ((dt * 4 + ks) * 64 + lane) * 16); S[dt] = MFMA32(kt, Vb[ks], S[dt]); }
            asm volatile("s_waitcnt vmcnt(32) lgkmcnt(0)" ::: "memory");
        } else {
            asm volatile("s_waitcnt vmcnt(0) lgkmcnt(0)" ::: "memory");
        }
        __syncthreads();
    }
}

constexpr int SW_KSTR = 144, SW_VSTR = 528, SW_K = 0, SW_V = 36864, SW_TB = 70656;
__device__ __forceinline__ void swa_phase(const CAS MArgs& a, unsigned char* ws, const int L, LAS unsigned char* lds, const int tid, const int bid, const int G) {
    const int lane = tid & 63, wave = __builtin_amdgcn_readfirstlane(tid >> 6), r = lane & 31, hh = lane >> 5;
    const bf16_t* PROJB = (const bf16_t*)(ws + WS_PROJ);
    bf16_t* SOB = (bf16_t*)(ws + WS_SO);
    LAS float* tb = (LAS float*)(lds + SW_TB);
    for (int idx = tid; idx < 2048; idx += 512) { const int hq = idx >> 7, dist = idx & 127; tb[idx] = a.in[I_RELB][t5_bucket(dist) * 16 + hq] * 1.4426950408889634f; }
    __syncthreads();
#pragma unroll 1
    for (int item = bid; item < NBATCH * 32 * 4; item += G) {
        const int kvh = item & 3, nb = (item >> 2) & 31, b = item >> 7;
        const size_t tq0 = (size_t)b * SEQ + (size_t)nb * 128;
        {
            const int key = tid >> 1, half = tid & 1;
            const bool exists = (nb > 0) || (key >= 128);
            u32x4 kv[4], vv[4];
#pragma unroll
            for (int i = 0; i < 4; ++i) { kv[i] = (u32x4){0u, 0u, 0u, 0u}; vv[i] = kv[i]; }
            if (exists) {
                const bf16_t* rowp = PROJB + (tq0 - 128 + key) * PROJ_COLS + kvh * 64 + half * 32;
#pragma unroll
                for (int i = 0; i < 4; ++i) { kv[i] = *(const u32x4*)(rowp + PJ_KC + 8 * i); vv[i] = *(const u32x4*)(rowp + PJ_VC + 8 * i); }
            }
#pragma unroll
            for (int i = 0; i < 4; ++i) *(LAS u32x4*)(lds + SW_K + key * SW_KSTR + half * 64 + 16 * i) = kv[i];
#pragma unroll
            for (int i = 0; i < 4; ++i) {
                const unsigned w4[4] = {vv[i].x, vv[i].y, vv[i].z, vv[i].w};
#pragma unroll
                for (int q = 0; q < 4; ++q) { const int d = half * 32 + 8 * i + 2 * q;
                    *(LAS unsigned short*)(lds + SW_V + d * SW_VSTR + key * 2) = (unsigned short)(w4[q] & 0xffffu);
                    *(LAS unsigned short*)(lds + SW_V + (d + 1) * SW_VSTR + key * 2) = (unsigned short)(w4[q] >> 16); }
            }
        }
        __syncthreads();
        {
            const int g = wave >> 1, qh = wave & 1, hq = kvh * 4 + g;
            const float sink2 = a.in[I_SINKS][L * 16 + hq] * 1.4426950408889634f;
#pragma unroll 1
            for (int qt = 0; qt < 2; ++qt) {
                const int i0 = 64 * qh + 32 * qt, kt0 = i0 >> 5;
                const size_t token = tq0 + i0 + r;
                bf16x8 qf[4];
#pragma unroll
                for (int s = 0; s < 4; ++s) qf[s] = *(const bf16x8*)(PROJB + token * PROJ_COLS + PJ_QC + hq * 64 + 16 * s + 8 * hh);
                f32x16 c[5];
#pragma unroll
                for (int k5 = 0; k5 < 5; ++k5) {
#pragma unroll
                    for (int q = 0; q < 16; ++q) c[k5][q] = 0.f;
#pragma unroll
                    for (int s = 0; s < 4; ++s) { const bf16x8 kf = *(const LAS bf16x8*)(lds + SW_K + (32 * (kt0 + k5) + r) * SW_KSTR + (16 * s + 8 * hh) * 2); c[k5] = MFMA32(kf, qf[s], c[k5]); }
                }
                float m = sink2;
#pragma unroll
                for (int k5 = 0; k5 < 5; ++k5)
#pragma unroll
                    for (int q = 0; q < 16; ++q) {
                        const int cr = (q & 3) + 8 * (q >> 2) + 4 * hh;
                        const int dist = 128 + r - 32 * k5 - cr;
                        bool valid = true;
                        if (k5 == 0) valid = dist <= 127;
                        if (k5 == 4) valid = dist >= 0;
                        if (nb == 0) valid = valid && (32 * (kt0 + k5) + cr >= 128);
                        const float sc = valid ? fmaf(c[k5][q], 0.125f * 1.4426950408889634f, tb[hq * 128 + (dist & 127)]) : -3.0e38f;
                        c[k5][q] = sc; m = fmaxf(m, sc);
                    }
                m = fmaxf(m, __shfl_xor(m, 32));
                float sum = 0.f;
#pragma unroll
                for (int k5 = 0; k5 < 5; ++k5)
#pragma unroll
                    for (int q = 0; q < 16; ++q) { const float p = __builtin_amdgcn_exp2f(c[k5][q] - m); c[k5][q] = p; sum += p; }
                sum += __shfl_xor(sum, 32);
                const float inv = 1.0f / (sum + __builtin_amdgcn_exp2f(sink2 - m));
                f32x16 o[2];
#pragma unroll
                for (int dt = 0; dt < 2; ++dt)
#pragma unroll
                    for (int q = 0; q < 16; ++q) o[dt][q] = 0.f;
#pragma unroll
                for (int k5 = 0; k5 < 5; ++k5)
#pragma unroll
                    for (int sp = 0; sp < 2; ++sp) {
                        const bf16x8 pf = pack8(c[k5], sp);
#pragma unroll
                        for (int dt = 0; dt < 2; ++dt) {
                            const LAS unsigned char* vp = lds + SW_V + (32 * dt + r) * SW_VSTR + (32 * (kt0 + k5) + 16 * sp + 4 * hh) * 2;
                            const u32x2 lo = *(const LAS u32x2*)vp, hi = *(const LAS u32x2*)(vp + 16);
                            u32x4 v4; v4.x = lo.x; v4.y = lo.y; v4.z = hi.x; v4.w = hi.y;
                            o[dt] = MFMA32(__builtin_bit_cast(bf16x8, v4), pf, o[dt]);
                        }
                    }
                bf16_t* orow = SOB + token * DM + hq * 64 + 4 * hh;
#pragma unroll
                for (int dt = 0; dt < 2; ++dt)
#pragma unroll
                    for (int g4 = 0; g4 < 4; ++g4) { u32x2 w; w.x = cvtpk(o[dt][4 * g4] * inv, o[dt][4 * g4 + 1] * inv); w.y = cvtpk(o[dt][4 * g4 + 2] * inv, o[dt][4 * g4 + 3] * inv);
                        *(u32x2*)(orow + 32 * dt + 8 * g4) = w; }
            }
        }
        __syncthreads();
    }
}

constexpr int LR_XSTR = 132;
constexpr int LR_X = 0, LR_W = 67584, LR_WSTR = 272, LR_AGG = 137216;
constexpr size_t LRM_AGG = 452 * MiB, LRM_CIN = 454 * MiB;
__device__ __forceinline__ void lru_l1(const CAS MArgs& a, unsigned char* ws, const int L, LAS unsigned char* lds, const int tid, const int bid, const int G) {
    const int lane = tid & 63, wave = __builtin_amdgcn_readfirstlane(tid >> 6), r = lane & 31, hh = lane >> 5;
    const bf16_t* PROJB = (const bf16_t*)(ws + WS_PROJ);
    unsigned char* RM = ws + WS_M;
    LAS float* xc = (LAS float*)(lds + LR_X);
    LAS float* agg = (LAS float*)(lds + LR_AGG);
    const int blk = bid & 7;
    int wblk = -1;
#pragma unroll 1
    for (int it = bid; it < NBATCH * 8 * 32; it += G) {
        const int ib = it & 7, bc = it >> 3, b = bc >> 5, chunk = bc & 31;
        const size_t t0 = (size_t)b * SEQ + (size_t)chunk * 128;
        if (ib != wblk) {
            const bf16_t* W = (const bf16_t*)(ws + WS_W + (size_t)L * WL_STRIDE + W_LRU) + (size_t)ib * 256 * 128;
            for (int i = tid; i < 256 * 16; i += 512) { const int n = i >> 4, seg = i & 15; *(LAS u32x4*)(lds + LR_W + n * LR_WSTR + seg * 16) = *(const u32x4*)(W + n * 128 + seg * 8); }
            wblk = ib;
        }
        {
            const int c2 = 2 * lane, tok0 = 16 * wave;
            const float* cw = a.in[I_RGCW] + (size_t)L * 4 * 1024 + ib * 128 + c2;
            const f32x2 w0 = *(const f32x2*)cw, w1 = *(const f32x2*)(cw + 1024), w2 = *(const f32x2*)(cw + 2048), w3 = *(const f32x2*)(cw + 3072);
            const f32x2 cb = *(const f32x2*)(a.in[I_RGCB] + L * 1024 + ib * 128 + c2);
            const bf16_t* src = PROJB + (t0 + tok0) * PROJ_COLS + PJ_XL + ib * 128 + c2;
            unsigned raw[19];
#pragma unroll
            for (int u = 0; u < 19; ++u) { const int tok = tok0 - 3 + u; raw[u] = (chunk * 128 + tok >= 0) ? *(const unsigned*)(src + (ptrdiff_t)(u - 3) * PROJ_COLS) : 0u; }
#pragma unroll
            for (int u = 0; u < 16; ++u) {
                float y0 = cb[0], y1 = cb[1];
                y0 = fmaf(w0[0], bflo(raw[u]), y0); y0 = fmaf(w1[0], bflo(raw[u + 1]), y0); y0 = fmaf(w2[0], bflo(raw[u + 2]), y0); y0 = fmaf(w3[0], bflo(raw[u + 3]), y0);
                y1 = fmaf(w0[1], bfhi(raw[u]), y1); y1 = fmaf(w1[1], bfhi(raw[u + 1]), y1); y1 = fmaf(w2[1], bfhi(raw[u + 2]), y1); y1 = fmaf(w3[1], bfhi(raw[u + 3]), y1);
                *(LAS f32x2*)(xc + (tok0 + u) * LR_XSTR + c2) = (f32x2){y0, y1};
            }
        }
        __syncthreads();
        const int mt = wave >> 1, ch0 = 64 * (wave & 1);
        f32x16 acc[4];
#pragma unroll
        for (int nt = 0; nt < 4; ++nt)
#pragma unroll
            for (int q = 0; q < 16; ++q) acc[nt][q] = 0.f;
#pragma unroll
        for (int s = 0; s < 8; ++s) {
            const LAS float* ap = xc + (32 * mt + r) * LR_XSTR + 16 * s + 8 * hh;
            const f32x4 x0 = *(const LAS f32x4*)ap, x1 = *(const LAS f32x4*)(ap + 4);
            u32x4 af; af.x = cvtpk(x0[0], x0[1]); af.y = cvtpk(x0[2], x0[3]); af.z = cvtpk(x1[0], x1[1]); af.w = cvtpk(x1[2], x1[3]);
#pragma unroll
            for (int nt = 0; nt < 4; ++nt) {
                const int n = (nt >> 1) * 128 + ch0 + 32 * (nt & 1) + r;
                const bf16x8 bfrag = *(const LAS bf16x8*)(lds + LR_W + n * LR_WSTR + (16 * s + 8 * hh) * 2);
                acc[nt] = MFMA32(__builtin_bit_cast(bf16x8, af), bfrag, acc[nt]);
            }
        }
        float hl[2][16], pc[2][16], Pt[2], Ht[2];
#pragma unroll
        for (int ct = 0; ct < 2; ++ct) {
            const int ch = ch0 + 32 * ct + r, cg = L * 1024 + ib * 128 + ch;
            const float ba = a.in[I_RGBA][cg], bx = a.in[I_RGBX][cg], sp = 8.0f * softplusf_(-a.in[I_RGLAM][cg]);
            float P4[4], H4[4];
#pragma unroll
            for (int g4 = 0; g4 < 4; ++g4) {
                float p = 1.f, h = 0.f;
#pragma unroll
                for (int q = 0; q < 4; ++q) {
                    const int tok = 32 * mt + 8 * g4 + 4 * hh + q;
                    const float rr = sigmoidf_(acc[ct][4 * g4 + q] + ba), ig = sigmoidf_(acc[2 + ct][4 * g4 + q] + bx);
                    const float av = fexp(-sp * rr);
                    const float uv = sqrtf(fmaxf(fmaf(-av, av, 1.0f), 0.f)) * ig * xc[tok * LR_XSTR + ch];
                    p *= av; h = fmaf(av, h, uv);
                    pc[ct][4 * g4 + q] = p; hl[ct][4 * g4 + q] = h;
                }
                P4[g4] = p; H4[g4] = h;
            }
            float c = 0.f, P = 1.f, cin[4], ppre[4];
#pragma unroll
            for (int g4 = 0; g4 < 4; ++g4) {
                const float oP = __shfl_xor(P4[g4], 32), oH = __shfl_xor(H4[g4], 32);
                const float eP = hh ? oP : P4[g4], eH = hh ? oH : H4[g4];
                const float dP = hh ? P4[g4] : oP, dH = hh ? H4[g4] : oH;
                const float c1 = fmaf(eP, c, eH), P1 = P * eP;
                cin[g4] = hh ? c1 : c; ppre[g4] = hh ? P1 : P;
                c = fmaf(dP, c1, dH); P = P1 * dP;
            }
#pragma unroll
            for (int g4 = 0; g4 < 4; ++g4)
#pragma unroll
                for (int q = 0; q < 4; ++q) { hl[ct][4 * g4 + q] = fmaf(pc[ct][4 * g4 + q], cin[g4], hl[ct][4 * g4 + q]); pc[ct][4 * g4 + q] *= ppre[g4]; }
            Pt[ct] = P; Ht[ct] = c;
            if (hh == 0) *(LAS f32x2*)(agg + (mt * 128 + ch) * 2) = (f32x2){P, c};
        }
        __syncthreads();
        bf16_t* HL = (bf16_t*)(ws + WS_XF); bf16_t* PC = (bf16_t*)(ws + WS_LO);
#pragma unroll
        for (int ct = 0; ct < 2; ++ct) {
            const int ch = ch0 + 32 * ct + r;
            float cT = 0.f, PT = 1.f;
            for (int m2 = 0; m2 < mt; ++m2) { const f32x2 ag = *(const LAS f32x2*)(agg + (m2 * 128 + ch) * 2); cT = fmaf(ag[0], cT, ag[1]); PT *= ag[0]; }
            if (mt == 3 && hh == 0) {
                const float ci = fmaf(Pt[ct], cT, Ht[ct]), Pi = PT * Pt[ct];
                *(f32x2*)((float*)(RM + LRM_AGG) + ((size_t)(b * 32 + chunk) * 1024 + ib * 128 + ch) * 2) = (f32x2){Pi, ci};
            }
            const size_t obase = (t0 + 32 * mt) * DM + ib * 128 + ch;
#pragma unroll
            for (int q16 = 0; q16 < 16; ++q16) {
                const int tok = (q16 & 3) + 8 * (q16 >> 2) + 4 * hh;
                HL[obase + (size_t)tok * DM] = (bf16_t)f2bf(fmaf(pc[ct][q16], cT, hl[ct][q16]));
                PC[obase + (size_t)tok * DM] = (bf16_t)f2bf(pc[ct][q16] * PT);
            }
        }
        __syncthreads();
    }
}

#define XB_TMO      128
#define XB_XCNT(j)  (256  + 64 * (j))
#define XB_XSUB(j)  (1280 + 64 * (j))
#define XB_XGEN(j)  (2304 + 64 * (j))
#define XB_TOP      3328
#define XB_TOPGEN   3392
#define XCD_BAR_WORDS 3456
#define XB_SPIN_CAP (1u << 18)
__device__ __forceinline__ unsigned xb_ld(unsigned* p)              { return __hip_atomic_load(p, __ATOMIC_RELAXED, __HIP_MEMORY_SCOPE_AGENT); }
__device__ __forceinline__ unsigned xb_add(unsigned* p, unsigned v) { return __hip_atomic_fetch_add(p, v, __ATOMIC_RELAXED, __HIP_MEMORY_SCOPE_AGENT); }
__device__ __forceinline__ unsigned xb_xcc_id() { return (unsigned)__builtin_amdgcn_s_getreg((3 << 11) | 20) & 0xFu; }
#define XB_SPIN(cond, bar) do { unsigned _sp = 0; while (cond) { __builtin_amdgcn_s_sleep(1); \
    if ((++_sp & 255u) == 0u) { if (xb_ld(&(bar)[XB_TMO])) break; if (_sp > XB_SPIN_CAP) { atomicAdd(&(bar)[XB_TMO], 1u); break; } } } } while (0)
struct XcdBarrier { unsigned* bar; unsigned x; volatile LAS unsigned* st; };
__device__ __forceinline__ XcdBarrier xcd_barrier_post(unsigned* bar, volatile LAS unsigned* st) {
    XcdBarrier b; b.bar = bar; b.x = xb_xcc_id(); b.st = st;
    if (threadIdx.x == 0) (void)xb_add(&bar[XB_XCNT(b.x)], 1u);
    return b;
}
__device__ __forceinline__ void xcd_barrier_complete(unsigned* bar, unsigned x, unsigned& nloc, unsigned& nx) {
    const unsigned G = gridDim.x * gridDim.y * gridDim.z;
    unsigned sum, cnt, mine, sp = 0u;
    for (;;) {
        sum = 0u; cnt = 0u; mine = 0u;
#pragma unroll
        for (unsigned j = 0; j < 16; ++j) { const unsigned c = xb_ld(&bar[XB_XCNT(j)]); sum += c; cnt += (c > 0u) ? 1u : 0u; mine = (j == x) ? c : mine; }
        if (sum == G) break;
        __builtin_amdgcn_s_sleep(1);
        if ((++sp & 255u) == 0u) { if (xb_ld(&bar[XB_TMO])) break; if (sp > XB_SPIN_CAP) { atomicAdd(&bar[XB_TMO], 1u); break; } }
    }
    nloc = mine > 0u ? mine : 1u; nx = cnt > 0u ? cnt : 1u;
}
__device__ __forceinline__ void xcd_barrier(const XcdBarrier& b) {
    asm volatile("s_waitcnt vmcnt(0)" ::: "memory");
    __syncthreads();
    if (threadIdx.x == 0) {
        unsigned* bar = b.bar;
        __builtin_amdgcn_s_waitcnt(0);
        unsigned nloc = b.st[0], nx = b.st[1];
        if (nloc == 0u) { xcd_barrier_complete(bar, b.x, nloc, nx); b.st[0] = nloc; b.st[1] = nx; }
        const unsigned old = xb_add(&bar[XB_XSUB(b.x)], 1u);
        const unsigned gen = old / nloc;
        if (old + 1u == (gen + 1u) * nloc) {
            __builtin_amdgcn_fence(__ATOMIC_RELEASE, "agent");
            asm volatile("s_waitcnt vmcnt(0)" ::: "memory");
            const unsigned og = xb_add(&bar[XB_TOP], 1u);
            const unsigned tg = og / nx;
            if (og + 1u == (tg + 1u) * nx) xb_add(&bar[XB_TOPGEN], 1u);
            else XB_SPIN(xb_ld(&bar[XB_TOPGEN]) == tg, bar);
            __builtin_amdgcn_fence(__ATOMIC_ACQUIRE, "agent");
            xb_add(&bar[XB_XGEN(b.x)], 1u);
            asm volatile("s_waitcnt vmcnt(0)" ::: "memory");
        } else {
            XB_SPIN(xb_ld(&bar[XB_XGEN(b.x)]) == gen, bar);
            __builtin_amdgcn_fence(__ATOMIC_ACQUIRE, "agent");
            asm volatile("s_waitcnt vmcnt(0)" ::: "memory");
        }
    }
    __syncthreads();
}


__device__ __forceinline__ int launder_s(int x) { asm volatile("" : "+s"(x)); return x; }
enum { K_INPROJ = 0, K_GDNPREP, K_GDNREC, K_GDNPOST, K_LRUCONV, K_LRUGATE, K_LRUSCAN, K_SWA, K_BRANCH, K_WOUT, K_LN1, K_SCATTER, K_MOE1, K_MOE2, K_LN2, K_PLEP, K_PLEG, K_LN3, NPL };
constexpr int NPHASES = 1 + DEPTH * NPL;

__global__ void __launch_bounds__(NWAVES * 64, 2) mega(MArgs a_raw) {
    extern __shared__ __attribute__((aligned(16))) unsigned char lds_raw[];
    LAS unsigned char* lds0 = (LAS unsigned char*)lds_raw;
    const int wave0 = __builtin_amdgcn_readfirstlane((int)threadIdx.x >> 6);
    volatile LAS unsigned* MISC = (volatile LAS unsigned*)(lds0 + LDS_MISC);
#define PH_PTRS(Lv) \
    const CAS MArgs* ap_ = (const CAS MArgs*)__builtin_amdgcn_kernarg_segment_ptr(); asm volatile("" : "+s"(ap_)); const CAS MArgs& a = *ap_; \
    unsigned char* ws = a.ws; int L = (Lv); unsigned z_ = 0u; int wave_ = wave0; unsigned ldsb_ = 0u; asm volatile("" : "+s"(ws), "+s"(L), "+s"(wave_), "+s"(ldsb_)); asm volatile("" : "+v"(z_)); \
    const int lane_ = (int)__builtin_amdgcn_mbcnt_hi(~0u, __builtin_amdgcn_mbcnt_lo(~0u, z_)); \
    LAS unsigned char* lds = lds0 + ldsb_; LAS int* tstart = (LAS int*)(lds + LDS_MISC + 256); (void)tstart; \
    int bid_ = blockIdx.x, G_ = gridDim.x; asm volatile("" : "+s"(bid_), "+s"(G_)); \
    const int lane = lane_, wave = wave_, tid = wave * 64 + lane, bid = bid_, G = G_, NGW = G_ * NWAVES, gw = bid * NWAVES + wave; (void)lane; (void)wave; (void)tid; (void)bid; (void)gw; (void)G; (void)NGW; \
    unsigned* ctl = (unsigned*)(ws + WS_CTL); (void)ctl; \
    bf16_t* XB = (bf16_t*)(ws + WS_XB); float* XF = (float*)(ws + WS_XF); bf16_t* PROJB = (bf16_t*)(ws + WS_PROJ); (void)XB; (void)XF; (void)PROJB; \
    bf16_t* GOB = (bf16_t*)(ws + WS_GO); bf16_t* LOB = (bf16_t*)(ws + WS_LO); bf16_t* SOB = (bf16_t*)(ws + WS_SO); (void)GOB; (void)LOB; (void)SOB; \
    unsigned char* RM = ws + WS_M; (void)RM; \
    float* AB = (float*)(ws + WS_AB); float* GG = (float*)(ws + WS_GG); float* BT = (float*)(ws + WS_BT); (void)AB; (void)GG; (void)BT; \
    float* GATES = (float*)(ws + WS_GATES); int* ES = (int*)(ws + WS_ES); int* LIST = (int*)(ws + WS_LIST); (void)GATES; (void)ES; (void)LIST; \
    unsigned char* wl = ws + WS_W + (size_t)L * WL_STRIDE; (void)wl; \
    unsigned* cnt = ctl + CW_CNT + 64 * L; (void)cnt;
    const int lo = a_raw.ph_lo, hi = a_raw.ph_hi;
#if !N_LAUNCH_PER_PHASE
    if (threadIdx.x < 4) MISC[threadIdx.x] = 0u;
    __syncthreads();
    XcdBarrier bar = xcd_barrier_post((unsigned*)(a_raw.ws + WS_CTL) + CW_BAR, MISC);
#ifndef BARDUP
#define BARDUP 1
#endif
#define GRID_BAR(ph) do { if ((ph) + 1 < hi) { for (int bi_ = 0; bi_ < BARDUP; ++bi_) xcd_barrier(bar); } } while (0)
#else
#define GRID_BAR(ph) do { } while (0)
#endif
#define IN(ph) (launder_s(lo) <= (ph) && (ph) < launder_s(hi))

    if (IN(0)) {
        for (int rep_ = 0; rep_ < ((DUPMASK >> 30) & 1) + 1; ++rep_) {
        PH_PTRS(0)
        LAS float* scr = (LAS float*)(lds + wave * 17408);
        for (int Lc = 0; Lc < DEPTH; ++Lc) {
            L = Lc; wl = ws + WS_W + (size_t)L * WL_STRIDE;
            transpose_seg<1>(a.in[I_WIN] + (size_t)L * DM * IN_COLS, DM, IN_COLS, PROJ_COLS, (bf16_t*)(wl + W_IN), scr, gw, NGW, lane);
            transpose_seg<0>(a.in[I_WOG] + (size_t)L * DM * DM, DM, DM, DM, (bf16_t*)(wl + W_O3), scr, gw, NGW, lane);
            transpose_seg<0>(a.in[I_WOL] + (size_t)L * DM * DM, DM, DM, DM, (bf16_t*)(wl + W_O3) + (size_t)DM * DM, scr, gw, NGW, lane);
            transpose_seg<0>(a.in[I_WOS] + (size_t)L * DM * DM, DM, DM, DM, (bf16_t*)(wl + W_O3) + (size_t)2 * DM * DM, scr, gw, NGW, lane);
            transpose_seg<0>(a.in[I_WOUT] + (size_t)L * DM * DM, DM, DM, DM, (bf16_t*)(wl + W_OUT), scr, gw, NGW, lane);
            transpose_seg<0>(a.in[I_PLEG] + (size_t)L * DM * DM, DM, DM, DM, (bf16_t*)(wl + W_PG), scr, gw, NGW, lane);
            transpose_seg<0>(a.in[I_PLEP] + (size_t)L * PLE_DIM * DM, PLE_DIM, DM, DM, (bf16_t*)(wl + W_PP), scr, gw, NGW, lane);
            for (int it = gw; it < NEXP * 512; it += NGW) { const int e = it >> 9;
                transpose_item_gu(a.in[I_WGU] + ((size_t)L * NEXP + e) * DM * 2048, (bf16_t*)(wl + W_GU) + (size_t)e * 2048 * DM, scr, it & 511, lane); }
            for (int it = gw; it < NEXP * 512; it += NGW) { const int e = it >> 9;
                transpose_item<0>(a.in[I_WDN] + ((size_t)L * NEXP + e) * DM * DM, DM, DM, DM, (bf16_t*)(wl + W_DN) + (size_t)e * DM * DM, scr, it & 511, lane); }
            for (int blk = 0; blk < 8; ++blk) {
                transpose_seg<0>(a.in[I_RGWA] + ((size_t)L * 8 + blk) * 128 * 128, 128, 128, 128, (bf16_t*)(wl + W_LRU) + (size_t)blk * 256 * 128, scr, gw, NGW, lane);
                transpose_seg<0>(a.in[I_RGWX] + ((size_t)L * 8 + blk) * 128 * 128, 128, 128, 128, (bf16_t*)(wl + W_LRU) + (size_t)blk * 256 * 128 + 128 * 128, scr, gw, NGW, lane);
            }
        }
        cvt_rows(a.in[I_P], (bf16_t*)(ws + WS_PB), (size_t)DEPTH * NTOK * PLE_DIM, G);
        __syncthreads();
        stage_smallw<4>(a.in[I_WIN], IN_COLS, OFF_A, lds, tid);
        __syncthreads();
        for (int t0 = gw * 4; t0 < NTOK; t0 += NGW * 4) {
            f32x4 vv[4][4];
#pragma unroll
            for (int u = 0; u < 4; ++u)
#pragma unroll
                for (int j = 0; j < 4; ++j) vv[u][j] = *(const f32x4*)(a.in[I_X] + (size_t)(t0 + u) * DM + 256 * j + 4 * lane);
#pragma unroll
            for (int u = 0; u < 4; ++u) { store_row(vv[u], nullptr, XB + (size_t)(t0 + u) * DM, lane); ab_project(vv[u], lds, AB + (size_t)(t0 + u) * 16, lane); }
        }
        }
        GRID_BAR(0);
    }

    for (int Lloop = 0; Lloop < DEPTH; ++Lloop) {
        const int pb = 1 + Lloop * NPL;

        if (IN(pb + K_INPROJ)) {
            for (int rep_ = 0; rep_ < NREP(K_INPROJ); ++rep_) {
            PH_PTRS(Lloop)
            pg8::DenseSched S{(const char*)XB, (const char*)(wl + W_IN), NTOK / 256, PROJ_COLS / 256, G, bid, DM};
            pg8::EpiBf16 E{PROJB, PROJ_COLS, nullptr, 0};
            pg8::gemm_phase<pg8::EpiBf16, pg8::DenseSched, true>(lds, DM, S, E, tid);
            }
            GRID_BAR(pb + K_INPROJ);
        }
        if (IN(pb + K_GDNPREP)) {
            for (int rep_ = 0; rep_ < NREP(K_GDNPREP); ++rep_) {
            PH_PTRS(Lloop)
            LAS unsigned char* wlds = lds + wave * GA_LDS;
#pragma unroll 1
            for (int it = gw; it < NBATCH * 8 * 64; it += NGW) {
                int ln = lane; unsigned char* wsi = ws; unsigned wli = (unsigned)(size_t)wlds; asm volatile("" : "+s"(wsi), "+s"(wli)); asm volatile("" : "+v"(ln));
                gdn_a_item(a, wsi, L, (LAS unsigned char*)(size_t)wli, it, ln, gw);
            }
            }
            GRID_BAR(pb + K_GDNPREP);
        }
        if (IN(pb + K_GDNREC)) {
            for (int rep_ = 0; rep_ < NREP(K_GDNREC); ++rep_) {
            PH_PTRS(Lloop)
            if (G > NBATCH * 8 + 8) {
                if (bid < NBATCH * 8) gdn_b_scan(ws, lds, bid, tid);
                else { swa_phase(a, ws, L, lds, tid, bid - NBATCH * 8, G - NBATCH * 8); __syncthreads(); lru_l1(a, ws, L, lds, tid, bid - NBATCH * 8, G - NBATCH * 8); }
            } else {
                for (int bh = bid; bh < NBATCH * 8; bh += G) { gdn_b_scan(ws, lds, bh, tid); __syncthreads(); }
                swa_phase(a, ws, L, lds, tid, bid, G); __syncthreads(); lru_l1(a, ws, L, lds, tid, bid, G);
            }
            }
            GRID_BAR(pb + K_GDNREC);
        }
        if (IN(pb + K_GDNPOST)) {
            for (int rep_ = 0; rep_ < NREP(K_GDNPOST); ++rep_) {
            PH_PTRS(Lloop)
            {
                const f32x2* AGG = (const f32x2*)(RM + LRM_AGG); float* CIN = (float*)(RM + LRM_CIN);
                for (int i = bid * 512 + tid; i < NBATCH * DM; i += G * 512) {
                    const int b = i >> 10, c = i & 1023;
                    float carry = 0.f;
#pragma unroll 8
                    for (int ch = 0; ch < 32; ++ch) { const size_t o = (size_t)(b * 32 + ch) * 1024 + c; const f32x2 ag = AGG[o]; CIN[o] = carry; carry = fmaf(ag[0], carry, ag[1]); }
                }
            }
            const bf16_t* OO = (const bf16_t*)(RM + G_OO);
            float nw[16];
            { const float* nwp = a.in[I_GNW] + L * 128 + (lane & 7) * 16;
#pragma unroll
              for (int q = 0; q < 4; ++q) { const f32x4 w4 = *(const f32x4*)(nwp + 4 * q); nw[4 * q] = w4[0]; nw[4 * q + 1] = w4[1]; nw[4 * q + 2] = w4[2]; nw[4 * q + 3] = w4[3]; } }
            for (int t0 = gw * 4; t0 < NTOK; t0 += NGW * 4) {
                u32x4 ov[4][2], zv[4][2];
#pragma unroll
                for (int u = 0; u < 4; ++u) { const size_t t = (size_t)(t0 + u);
                    ov[u][0] = *(const u32x4*)(OO + t * DM + 16 * lane); ov[u][1] = *(const u32x4*)(OO + t * DM + 16 * lane + 8);
                    zv[u][0] = *(const u32x4*)(PROJB + t * PROJ_COLS + PJ_Z + 16 * lane); zv[u][1] = *(const u32x4*)(PROJB + t * PROJ_COLS + PJ_Z + 16 * lane + 8); }
#pragma unroll
                for (int u = 0; u < 4; ++u) {
                    const unsigned ow[8] = {ov[u][0].x, ov[u][0].y, ov[u][0].z, ov[u][0].w, ov[u][1].x, ov[u][1].y, ov[u][1].z, ov[u][1].w};
                    const unsigned zw[8] = {zv[u][0].x, zv[u][0].y, zv[u][0].z, zv[u][0].w, zv[u][1].x, zv[u][1].y, zv[u][1].z, zv[u][1].w};
                    float ss = 0.f;
#pragma unroll
                    for (int q = 0; q < 8; ++q) { ss = fmaf(bflo(ow[q]), bflo(ow[q]), ss); ss = fmaf(bfhi(ow[q]), bfhi(ow[q]), ss); }
                    ss += __shfl_xor(ss, 1); ss += __shfl_xor(ss, 2); ss += __shfl_xor(ss, 4);
                    const float rr = rsqrtf(ss * (1.0f / 128.0f) + 1e-6f);
                    unsigned res[8];
#pragma unroll
                    for (int q = 0; q < 8; ++q) res[q] = pk2(bflo(ow[q]) * rr * nw[2 * q] * siluf_(bflo(zw[q])), bfhi(ow[q]) * rr * nw[2 * q + 1] * siluf_(bfhi(zw[q])));
                    bf16_t* gp = GOB + (size_t)(t0 + u) * DM + 16 * lane;
                    *(u32x4*)gp = (u32x4){res[0], res[1], res[2], res[3]}; *(u32x4*)(gp + 8) = (u32x4){res[4], res[5], res[6], res[7]};
                }
            }
            }
            GRID_BAR(pb + K_GDNPOST);
        }
        if (IN(pb + K_LRUSCAN)) {
            for (int rep_ = 0; rep_ < NREP(K_LRUSCAN); ++rep_) {
            PH_PTRS(Lloop)
            const bf16_t* HL = (const bf16_t*)(ws + WS_XF); const bf16_t* PC = (const bf16_t*)(ws + WS_LO); const float* CIN = (const float*)(RM + LRM_CIN);
            for (size_t i = (size_t)bid * 512 + tid; i < (size_t)NTOK * 128; i += (size_t)G * 512) {
                const size_t t = i >> 7; const int c8 = (int)(i & 127) * 8;
                const int b = (int)(t >> 12), chunk = (int)((t & (SEQ - 1)) >> 7);
                const u32x4 h4 = *(const u32x4*)(HL + t * DM + c8), p4 = *(const u32x4*)(PC + t * DM + c8), g4 = *(const u32x4*)(PROJB + t * PROJ_COLS + PJ_GL + c8);
                const float* cp = CIN + (size_t)(b * 32 + chunk) * 1024 + c8;
                const f32x4 c0 = *(const f32x4*)cp, c1 = *(const f32x4*)(cp + 4);
                const unsigned hw[4] = {h4.x, h4.y, h4.z, h4.w}, pw[4] = {p4.x, p4.y, p4.z, p4.w}, gw4[4] = {g4.x, g4.y, g4.z, g4.w};
                const float cc[8] = {c0[0], c0[1], c0[2], c0[3], c1[0], c1[1], c1[2], c1[3]};
                unsigned ow[4];
#pragma unroll
                for (int q = 0; q < 4; ++q) {
                    const float v0 = fmaf(bflo(pw[q]), cc[2 * q], bflo(hw[q])) * gelu_tanhf_(bflo(gw4[q]));
                    const float v1 = fmaf(bfhi(pw[q]), cc[2 * q + 1], bfhi(hw[q])) * gelu_tanhf_(bfhi(gw4[q]));
                    ow[q] = pk2(v0, v1);
                }
                *(u32x4*)(LOB + t * DM + c8) = (u32x4){ow[0], ow[1], ow[2], ow[3]};
            }
            }
            GRID_BAR(pb + K_LRUSCAN);
        }
        if (IN(pb + K_BRANCH)) {
            for (int rep_ = 0; rep_ < NREP(K_BRANCH); ++rep_) {
            PH_PTRS(Lloop)
            pg8::BranchSched S{(const char*)GOB, (const char*)LOB, (const char*)SOB, (const char*)(wl + W_O3), G, bid};
            pg8::EpiBranch E{(float*)(RM + M_MRG), (bf16_t*)(RM + M_MRGB), PROJB};
            pg8::gemm_phase<pg8::EpiBranch, pg8::BranchSched, true>(lds, DM, S, E, tid);
            }
            GRID_BAR(pb + K_BRANCH);
        }
        if (IN(pb + K_WOUT)) {
            for (int rep_ = 0; rep_ < NREP(K_WOUT); ++rep_) {
            PH_PTRS(Lloop)
            pg8::DenseSched S{(const char*)(RM + M_MRGB), (const char*)(wl + W_OUT), NTOK / 256, DM / 256, G, bid, DM};
            pg8::EpiBf16 E{(bf16_t*)(RM + M_YY), DM, nullptr, 0};
            pg8::gemm_phase<pg8::EpiBf16, pg8::DenseSched, true>(lds, DM, S, E, tid);
            }
            GRID_BAR(pb + K_WOUT);
        }
        if (IN(pb + K_LN1)) {
            for (int rep_ = 0; rep_ < NREP(K_LN1); ++rep_) {
            PH_PTRS(Lloop)
            const bf16_t* YY = (const bf16_t*)(RM + M_YY);
            stage_smallw<8>(a.in[I_RW] + (size_t)L * DM * NEXP, NEXP, 0, lds, tid);
            const float rbv = a.in[I_RB][L * NEXP + (lane >> 1)];
            __syncthreads();
            for (int t0 = gw * 4; t0 < NTOK; t0 += NGW * 4) {
                f32x4 vv[4][4];
#pragma unroll
                for (int u = 0; u < 4; ++u)
#pragma unroll
                    for (int j = 0; j < 4; ++j) vv[u][j] = ld_bf4(XB + (size_t)(t0 + u) * DM + 256 * j + 4 * lane) * ALPHA + ld_bf4(YY + (size_t)(t0 + u) * DM + 256 * j + 4 * lane);
#pragma unroll
                for (int u = 0; u < 4; ++u) {
                const int t = t0 + u; f32x4 (&v)[4] = vv[u];
                ln_inplace(v, a.in[I_LN1G] + L * DM, a.in[I_LN1B] + L * DM, lane);
                store_row(v, nullptr, XB + (size_t)t * DM, lane);
                float acc[NEXP];
                small_project<8>(v, lds, acc, lane);
                float mine = reduce_scatter32(acc, lane);
                mine = (lane & 1) ? -INFINITY : mine + rbv;
                float tv[4]; int ti[4];
#pragma unroll
                for (int k = 0; k < 4; ++k) {
                    const float mx = wave_max(mine);
                    const unsigned long long bal = __ballot(mine == mx);
                    const int idx = __ffsll((long long)bal) - 1;
                    tv[k] = mx; ti[k] = idx >> 1;
                    if (lane == idx) mine = -INFINITY;
                }
                if (lane == 0 && rep_ == 0) {
                    const float e1 = expf(tv[1] - tv[0]), e2 = expf(tv[2] - tv[0]), e3 = expf(tv[3] - tv[0]);
                    const float inv = 1.0f / (1.0f + e1 + e2 + e3);
                    *(f32x4*)(GATES + (size_t)t * 4) = (f32x4){inv, e1 * inv, e2 * inv, e3 * inv};
#pragma unroll
                    for (int k = 0; k < 4; ++k) { const int slot = (int)atomicAdd(&cnt[ti[k]], 1u); ES[t * 4 + k] = ti[k] | (slot << 5); LIST[(size_t)ti[k] * NTOK + slot] = t; }
                }
                }
            }
            }
            GRID_BAR(pb + K_LN1);
        }
        if (IN(pb + K_MOE1) || IN(pb + K_MOE2) || IN(pb + K_LN2)) {
            PH_PTRS(Lloop)
            __syncthreads();
            if (tid == 0) { int accu = 0; for (int e = 0; e < NEXP; ++e) { const int ce = (int)__hip_atomic_load(&cnt[e], __ATOMIC_RELAXED, __HIP_MEMORY_SCOPE_AGENT); tstart[e] = accu; tstart[64 + e] = ce; accu += (ce + 255) >> 8; } tstart[NEXP] = accu; }
            __syncthreads();
        }
        if (IN(pb + K_MOE1)) {
            for (int rep_ = 0; rep_ < NREP(K_MOE1); ++rep_) {
            PH_PTRS(Lloop)
            pg8::MoeGatherSched S{(const char*)XB, (const char*)(wl + W_GU), tstart, (size_t)2048 * DM * 2, 8, G, bid, (const char*)XB, LIST, tstart + 128, tstart + 64};
            pg8::EpiSwiglu E{(bf16_t*)(ws + WS_PROJ + PJ_H), a.in[I_BGU] + (size_t)L * NEXP * 2048};
            pg8::gemm_phase<pg8::EpiSwiglu, pg8::MoeGatherSched, true>(lds, DM, S, E, tid);
            }
            GRID_BAR(pb + K_MOE1);
        }
        if (IN(pb + K_MOE2)) {
            for (int rep_ = 0; rep_ < NREP(K_MOE2); ++rep_) {
            PH_PTRS(Lloop)
            pg8::MoeSched S{(const char*)(ws + WS_PROJ + PJ_H), (const char*)(wl + W_DN), tstart, (size_t)DM * DM * 2, 4, G, bid, nullptr, nullptr, nullptr, nullptr};
            pg8::EpiBf16 E{(bf16_t*)(ws + WS_PROJ + PJ_OB), DM, a.in[I_BDN] + (size_t)L * NEXP * DM, DM};
            pg8::gemm_phase<pg8::EpiBf16, pg8::MoeSched, true>(lds, DM, S, E, tid);
            {
                PH_PTRS(Lloop)
                pg8::DenseSched S2{(const char*)(ws + WS_PB) + (size_t)L * NTOK * PLE_DIM * 2, (const char*)(wl + W_PP), NTOK / 256, DM / 256, G, bid, PLE_DIM};
                pg8::EpiBf16 E2{(bf16_t*)(RM + M_PP), DM, nullptr, 0};
                pg8::gemm_phase<pg8::EpiBf16, pg8::DenseSched, true>(lds, PLE_DIM, S2, E2, tid);
            }
            }
            GRID_BAR(pb + K_MOE2);
        }
        if (IN(pb + K_LN2)) {
            for (int rep_ = 0; rep_ < NREP(K_LN2); ++rep_) {
            PH_PTRS(Lloop)
            const bf16_t* OB = (const bf16_t*)(ws + WS_PROJ + PJ_OB);
            for (int t0 = gw * 2; t0 < NTOK; t0 += NGW * 2) {
                f32x4 vv[2][4]; u32x2 yy[2][4][4]; f32x4 gk4[2];
#pragma unroll
                for (int u = 0; u < 2; ++u) {
                    const int t = t0 + u;
                    gk4[u] = *(const f32x4*)(GATES + (size_t)t * 4);
#pragma unroll
                    for (int k = 0; k < 4; ++k) { const int es = ES[t * 4 + k]; const size_t row = (size_t)tstart[es & 31] * 256 + (es >> 5);
#pragma unroll
                        for (int j = 0; j < 4; ++j) yy[u][k][j] = *(const u32x2*)(OB + row * DM + 256 * j + 4 * lane); }
#pragma unroll
                    for (int j = 0; j < 4; ++j) vv[u][j] = ld_bf4(XB + (size_t)t * DM + 256 * j + 4 * lane) * ALPHA;
                }
#pragma unroll
                for (int u = 0; u < 2; ++u) {
                    const int t = t0 + u; f32x4 (&v)[4] = vv[u];
#pragma unroll
                    for (int k = 0; k < 4; ++k)
#pragma unroll
                        for (int j = 0; j < 4; ++j) { const u32x2 y2 = yy[u][k][j]; v[j] += (f32x4){bflo(y2.x), bfhi(y2.x), bflo(y2.y), bfhi(y2.y)} * gk4[u][k]; }
                    ln_inplace(v, a.in[I_LN2G] + L * DM, a.in[I_LN2B] + L * DM, lane);
                    store_row(v, nullptr, XB + (size_t)t * DM, lane);
                }
            }
            }
            GRID_BAR(pb + K_LN2);
        }
        if (IN(pb + K_PLEG)) {
            for (int rep_ = 0; rep_ < NREP(K_PLEG); ++rep_) {
            PH_PTRS(Lloop)
            pg8::DenseSched S{(const char*)XB, (const char*)(wl + W_PG), NTOK / 256, DM / 256, G, bid, DM};
            pg8::EpiPle E{(bf16_t*)(RM + M_PLEO), (const bf16_t*)(RM + M_PP)};
            pg8::gemm_phase<pg8::EpiPle, pg8::DenseSched, true>(lds, DM, S, E, tid);
            }
            GRID_BAR(pb + K_PLEG);
        }
        if (IN(pb + K_LN3)) {
            for (int rep_ = 0; rep_ < NREP(K_LN3); ++rep_) {
            PH_PTRS(Lloop)
            const bf16_t* PLEO = (const bf16_t*)(RM + M_PLEO);
            if (L + 1 < DEPTH) { stage_smallw<4>(a.in[I_WIN] + (size_t)(L + 1) * DM * IN_COLS, IN_COLS, OFF_A, lds, tid); __syncthreads(); }
            for (int t0 = gw * 4; t0 < NTOK; t0 += NGW * 4) {
                f32x4 vv[4][4];
#pragma unroll
                for (int u = 0; u < 4; ++u)
#pragma unroll
                    for (int j = 0; j < 4; ++j) vv[u][j] = ld_bf4(XB + (size_t)(t0 + u) * DM + 256 * j + 4 * lane) * ALPHA + ld_bf4(PLEO + (size_t)(t0 + u) * DM + 256 * j + 4 * lane);
#pragma unroll
                for (int u = 0; u < 4; ++u) {
                    const int t = t0 + u; f32x4 (&v)[4] = vv[u];
                    ln_inplace(v, a.in[I_LN3G] + L * DM, a.in[I_LN3B] + L * DM, lane);
                    store_row(v, (L + 1 < DEPTH) ? nullptr : a.out + (size_t)t * DM, XB + (size_t)t * DM, lane);
                    if (L + 1 < DEPTH) ab_project(v, lds, AB + (size_t)t * 16, lane);
                }
            }
            }
            GRID_BAR(pb + K_LN3);
        }
    }
#undef IN
#undef GRID_BAR
}

extern "C" void kernel_launch(void* const* d_in, const int* in_sizes, int n_in, void* d_out, int out_size, void* d_ws, size_t ws_size, hipStream_t stream) {
    static int grid = 0;
    if (grid == 0) {
        int dev = 0, cus = 0;
        if (hipGetDevice(&dev) != hipSuccess || hipDeviceGetAttribute(&cus, hipDeviceAttributeMultiprocessorCount, dev) != hipSuccess) cus = 256;
        (void)hipFuncSetAttribute((const void*)mega, hipFuncAttributeMaxDynamicSharedMemorySize, LDS_BYTES);
        grid = cus > 0 ? cus : 256;
    }
    if (n_in < 34 || ws_size < WS_END) return;
    (void)in_sizes; (void)out_size;
    (void)hipMemsetAsync((char*)d_ws + WS_CTL, 0, 1 * MiB, stream);
    MArgs a; memset(&a, 0, sizeof a);
    for (int i = 0; i < 34; ++i) a.in[i] = (const float*)d_in[i];
    a.out = (float*)d_out; a.ws = (unsigned char*)d_ws;
#if N_LAUNCH_PER_PHASE
    unsigned char* ws = (unsigned char*)d_ws;
    for (int ph = 0; ph < NPHASES; ++ph) {
        const int L = (ph - 1) / NPL, k = (ph - 1) % NPL;
        a.ph_lo = ph; a.ph_hi = ph + 1; hipLaunchKernelGGL(mega, dim3(grid), dim3(NWAVES * 64), LDS_BYTES, stream, a);
    }
#else
    a.ph_lo = 0; a.ph_hi = NPHASES; hipLaunchKernelGGL(mega, dim3(grid), dim3(NWAVES * 64), LDS_BYTES, stream, a);
#endif
}
```

```cpp
#include <hip/hip_runtime.h>
#include <stdint.h>
#include <string.h>

#ifndef DUPMASK
#define DUPMASK 0u
#endif
#define NREP(k) ((int)((DUPMASK >> (k)) & 1u) + 1)
#ifndef N_LAUNCH_PER_PHASE
#define N_LAUNCH_PER_PHASE 0
#endif

#define DM 1024
#define SEQ 4096
#define NBATCH 8
#define DEPTH 2
#define PLE_DIM 256
#define IN_COLS 10768
#define OFF_A 4096
#define NEXP 32
#define ALPHA 1.4142135623730951f
#define NTOK (NBATCH * SEQ)
#define PROJ_COLS 10752
#define PJ_Q 0
#define PJ_K 1024
#define PJ_V 2048
#define PJ_Z 3072
#define PJ_XL 4096
#define PJ_GL 5120
#define PJ_QC 6144
#define PJ_KC 7168
#define PJ_VC 7424
#define PJ_GATES 7680
#define MOE_ROWS (NTOK * 4 + NEXP * 256)

#define LAS __attribute__((address_space(3)))
#define CAS __attribute__((address_space(4)))
typedef unsigned short bf16_t;
typedef short bf16x8 __attribute__((ext_vector_type(8)));
typedef float f32x4 __attribute__((ext_vector_type(4)));
typedef float f32x2 __attribute__((ext_vector_type(2)));
typedef unsigned u32x4 __attribute__((ext_vector_type(4)));
typedef unsigned u32x2 __attribute__((ext_vector_type(2)));

__device__ __forceinline__ float fexp(float x) { return __builtin_amdgcn_exp2f(1.4426950408889634f * x); }
__device__ __forceinline__ float sigmoidf_(float x) { return __builtin_amdgcn_rcpf(1.0f + __builtin_amdgcn_exp2f(-1.4426950408889634f * x)); }
__device__ __forceinline__ float siluf_(float x) { return x * sigmoidf_(x); }
__device__ __forceinline__ float softplusf_(float x) { return fmaxf(x, 0.f) + log1pf(expf(-fabsf(x))); }
__device__ __forceinline__ float gelu_tanhf_(float x) {
    const float y = 0.7978845608028654f * (x + 0.044715f * x * x * x);
    return x * (1.0f - __builtin_amdgcn_rcpf(1.0f + __builtin_amdgcn_exp2f(2.8853900817779268f * y)));
}
__device__ __forceinline__ float wave_sum(float v) {
#pragma unroll
    for (int o = 32; o > 0; o >>= 1) v += __shfl_xor(v, o);
    return v;
}
__device__ __forceinline__ float wave_max(float v) {
#pragma unroll
    for (int o = 32; o > 0; o >>= 1) v = fmaxf(v, __shfl_xor(v, o));
    return v;
}
typedef __bf16 bf16x2_t __attribute__((ext_vector_type(2)));
__device__ __forceinline__ unsigned cvtpk(float lo, float hi) { const f32x2 v = {lo, hi}; const bf16x2_t b = __builtin_convertvector(v, bf16x2_t); return __builtin_bit_cast(unsigned, b); }
__device__ __forceinline__ unsigned f2bf(float f) { return cvtpk(f, f) & 0xffffu; }
__device__ __forceinline__ unsigned pk2(float lo, float hi) { return cvtpk(lo, hi); }
__device__ __forceinline__ float bf2f(unsigned short b) { return __builtin_bit_cast(float, ((unsigned)b) << 16); }
__device__ __forceinline__ float bflo(unsigned u) { return __builtin_bit_cast(float, u << 16); }
__device__ __forceinline__ float bfhi(unsigned u) { return __builtin_bit_cast(float, u & 0xffff0000u); }

namespace pg8 {
constexpr int BM = 256, BK = 64, HALF = 128, HTB = HALF * BK * 2, STAGE_BYTES = 8 * HTB, NXCD = 8, WGM = 8;
__host__ __device__ __forceinline__ int lds_byte(int r, int c) { const int st = (r >> 4) * 2 + (c >> 5), rr = r & 15, cc = c & 31, ob = rr * 64 + cc * 2; return st * 1024 + (ob ^ (((ob >> 9) & 1) << 5)); }
__host__ __device__ __forceinline__ void stage_rc(int b, int& R, int& C) { const int st = b / 1024, sb = b % 1024, swz = sb ^ (((sb >> 9) & 1) << 5); R = (st >> 1) * 16 + swz / 64; C = (st & 1) * 32 + (swz % 64) / 2; }
__host__ __device__ __forceinline__ int perm32(int rho) { const int n = rho >> 4, i = rho & 15; return 8 * (i >> 2) + 4 * n + (i & 3); }
__device__ __forceinline__ unsigned cvt_pk_bf16(float lo, float hi) { unsigned r; asm volatile("v_cvt_pk_bf16_f32 %0, %1, %2" : "=v"(r) : "v"(lo), "v"(hi)); return r; }

struct Unit { const char* A; const char* B; int row0, col0, e, aux; };

__device__ __forceinline__ bool static_tile(int i, int G, int c, int nM, int nN, int& pm, int& pn) {
    const int nwg = nM * nN; const long L = (long)i * G + c; if (L >= nwg) return false;
    int wgid = (int)L; { const int q = nwg / NXCD, r = nwg % NXCD, xcd = wgid % NXCD, off = wgid / NXCD; wgid = (xcd < r ? xcd * (q + 1) : r * (q + 1) + (xcd - r) * q) + off; }
    const int nig = WGM * nN, gid = wgid / nig, fm = gid * WGM, gsz = (nM - fm) < WGM ? (nM - fm) : WGM;
    pm = fm + ((wgid % nig) % gsz); pn = (wgid % nig) / gsz; return true;
}

template <class Epi, class Sched, bool ALIGN_EPI>
__device__ __forceinline__ void gemm_phase(LAS unsigned char* lds, const int K, const Sched& S, const Epi& E, const int tid) {
    const int wid = __builtin_amdgcn_readfirstlane(tid >> 6), lane = tid & 63, wr = wid >> 2, wc = wid & 3, fr = lane & 15, fq = lane >> 4;
    const int nt = K / BK;
    unsigned voffA[2], voffB[2];
    int gR[2]; unsigned gC[2];
#pragma unroll
    for (int i = 0; i < 2; ++i) { int R, C; stage_rc(tid * 16 + i * 8192, R, C); const int Rb = (R & ~31) + perm32(R & 31);
        voffA[i] = (unsigned)(R * K + C) * 2u; voffB[i] = (unsigned)(Rb * K + C) * 2u; gR[i] = R; gC[i] = (unsigned)C * 2u; }
    unsigned oc[2][2] = {{0u, 0u}, {0u, 0u}}, on[2][2] = {{0u, 0u}, {0u, 0u}};
    const size_t kstep = (size_t)(BK * 2);
    const size_t hstep = (size_t)HALF * K * 2;
    const unsigned ldsw = (unsigned)wid * 1024u;
    const int aoff = lds_byte(wr * 64 + fr, fq * 8), boff = lds_byte(wc * 32 + fr, fq * 8);
#define PG8_SA(b, h) (((b) * 2 + (h)) * HTB)
#define PG8_SB(b, h) ((4 + (b) * 2 + (h)) * HTB)
#define PG8_STAGE(bufoff, gbase, voff) do { _Pragma("unroll") for (int _i = 0; _i < 2; ++_i) \
        __builtin_amdgcn_global_load_lds((const unsigned*)((const char*)(gbase) + (voff)[_i]), (LAS unsigned*)(lds + (bufoff) + ldsw + _i * 8192), 16, 0, 0); } while (0)
#define PG8_STAGE_A(bufoff, dptr, koff, half, usenext) do { if constexpr (Sched::GATHER) { const char* _gb = S.Abase + (koff); \
        if (usenext) PG8_STAGE(bufoff, _gb, on[half]); else PG8_STAGE(bufoff, _gb, oc[half]); } else { PG8_STAGE(bufoff, (dptr) + (half) * hstep, voffA); } } while (0)
#define PG8_GOFF(dst, u, bufi) do { const int _cn = S.cntl[(u).e]; _Pragma("unroll") for (int _h = 0; _h < 2; ++_h) _Pragma("unroll") for (int _i = 0; _i < 2; ++_i) { \
        const int _r = _h * 128 + gR[_i]; const int _tok = ((u).aux + _r < _cn) ? S.tab[(bufi) * 256 + _r] : 0; dst[_h][_i] = (unsigned)_tok * (unsigned)(K * 2) + gC[_i]; } } while (0)
#define PG8_TABDMA(u, bufi) do { if (wid < 4) __builtin_amdgcn_global_load_lds((const unsigned*)(S.list + (size_t)(u).e * NTOK + (u).aux + wid * 64 + lane), (LAS unsigned*)(S.tab + (bufi) * 256 + wid * 64), 4, 0, 0); } while (0)
#define PG8_LDA(dst, b, h) do { _Pragma("unroll") for (int m = 0; m < 4; ++m) _Pragma("unroll") for (int k = 0; k < 2; ++k) dst[m][k] = *(const LAS bf16x8*)(lds + PG8_SA(b, h) + aoff + m * 2048 + k * 1024); } while (0)
#define PG8_LDB(dst, b, h) do { _Pragma("unroll") for (int n = 0; n < 2; ++n) _Pragma("unroll") for (int k = 0; k < 2; ++k) dst[n][k] = *(const LAS bf16x8*)(lds + PG8_SB(b, h) + boff + n * 2048 + k * 1024); } while (0)
#define PG8_MMA(ai, bj, At, Bt) do { __builtin_amdgcn_s_setprio(1); _Pragma("unroll") for (int m = 0; m < 4; ++m) _Pragma("unroll") for (int n = 0; n < 2; ++n) _Pragma("unroll") for (int k = 0; k < 2; ++k) \
        acc[ai][bj][m][n] = __builtin_amdgcn_mfma_f32_16x16x32_bf16(Bt[n][k], At[m][k], acc[ai][bj][m][n], 0, 0, 0); __builtin_amdgcn_s_setprio(0); } while (0)
#define PG8_WAIT_V(n) asm volatile("s_waitcnt vmcnt(" #n ")" ::: "memory")
#define PG8_WAIT_L(n) asm volatile("s_waitcnt lgkmcnt(" #n ")" ::: "memory")
#define PG8_BAR __builtin_amdgcn_s_barrier()
#define PG8_SCHED __builtin_amdgcn_sched_barrier(0)
    Unit cur, nxt; int ui = 0;
    if (!S.next(0, cur)) return;
    f32x4 acc[2][2][4][2];
#pragma unroll
    for (int a = 0; a < 2; ++a)
#pragma unroll
        for (int b = 0; b < 2; ++b)
#pragma unroll
            for (int m = 0; m < 4; ++m)
#pragma unroll
                for (int n = 0; n < 2; ++n) acc[a][b][m][n] = (f32x4){0.f, 0.f, 0.f, 0.f};
    bf16x8 At[4][2], B0[2][2], B1[2][2];
    const char* cA = cur.A; const char* cB = cur.B;
    if constexpr (Sched::GATHER) { PG8_TABDMA(cur, 0); PG8_WAIT_V(0); PG8_BAR; PG8_GOFF(oc, cur, 0); }
    PG8_STAGE(PG8_SB(0, 0), cB, voffB); PG8_STAGE(PG8_SB(0, 1), cB + hstep, voffB); PG8_STAGE_A(PG8_SA(0, 0), cA, 0, 0, false); PG8_STAGE_A(PG8_SA(0, 1), cA, 0, 1, false);
    if (wr == 1) PG8_BAR;
    PG8_WAIT_V(2); PG8_BAR;
    PG8_STAGE(PG8_SB(1, 0), cB + kstep, voffB); PG8_STAGE_A(PG8_SA(1, 0), cA + kstep, kstep, 0, false); PG8_STAGE(PG8_SB(1, 1), cB + hstep + kstep, voffB);
    PG8_WAIT_V(6); PG8_BAR;
    for (;;) {
        const bool has_next = S.next(ui + 1, nxt);
        const char* nA = has_next ? nxt.A : cA; const char* nB = has_next ? nxt.B : cB;
        if constexpr (Sched::GATHER) { if (has_next) PG8_TABDMA(nxt, (ui + 1) & 1); }
        for (int t = 0; t < nt; t += 2) {
            const bool last = (t == nt - 2);
            const char* a1 = cA + (size_t)(t + 1) * kstep;
            const char* a2 = last ? nA : cA + (size_t)(t + 2) * kstep; const char* b2 = last ? nB : cB + (size_t)(t + 2) * kstep;
            const char* a3 = a2 + kstep; const char* b3 = b2 + kstep;
            const size_t k2 = last ? 0 : (size_t)(t + 2) * kstep, k3 = k2 + kstep;
            const bool un = last && has_next;
            if constexpr (Sched::GATHER) { if (un) PG8_GOFF(on, nxt, (ui + 1) & 1); }
            PG8_LDB(B0, 0, 0); PG8_LDB(B1, 0, 1); PG8_SCHED; PG8_LDA(At, 0, 0); PG8_STAGE_A(PG8_SA(1, 1), a1, (size_t)(t + 1) * kstep, 1, false);
            PG8_WAIT_V(8); PG8_WAIT_L(0); PG8_BAR; PG8_MMA(0, 0, At, B0); PG8_MMA(0, 1, At, B1); PG8_BAR; PG8_SCHED;
            PG8_LDA(At, 0, 1); PG8_STAGE(PG8_SB(0, 0), b2, voffB); PG8_STAGE(PG8_SB(0, 1), b2 + hstep, voffB); PG8_STAGE_A(PG8_SA(0, 0), a2, k2, 0, un);
            PG8_WAIT_V(8); PG8_WAIT_L(0); PG8_BAR; PG8_MMA(1, 0, At, B0); PG8_MMA(1, 1, At, B1); PG8_BAR; PG8_SCHED;
            PG8_LDB(B0, 1, 0); PG8_LDB(B1, 1, 1); PG8_SCHED; PG8_LDA(At, 1, 0); PG8_STAGE_A(PG8_SA(0, 1), a2, k2, 1, un);
            PG8_WAIT_V(8); PG8_WAIT_L(0); PG8_BAR; PG8_MMA(0, 0, At, B0); PG8_MMA(0, 1, At, B1); PG8_BAR; PG8_SCHED;
            PG8_LDA(At, 1, 1); PG8_STAGE(PG8_SB(1, 0), b3, voffB); PG8_STAGE(PG8_SB(1, 1), b3 + hstep, voffB); PG8_STAGE_A(PG8_SA(1, 0), a3, k3, 0, un);
            PG8_WAIT_V(8); PG8_WAIT_L(0); PG8_BAR; PG8_MMA(1, 0, At, B0); PG8_MMA(1, 1, At, B1); PG8_BAR; PG8_SCHED;
        }
        if constexpr (ALIGN_EPI) { if (wr == 0) PG8_BAR; }
        E(acc, cur, wr, wc, fr, fq);
        if (!has_next) break;
#pragma unroll
        for (int a = 0; a < 2; ++a)
#pragma unroll
            for (int b = 0; b < 2; ++b)
#pragma unroll
                for (int m = 0; m < 4; ++m)
#pragma unroll
                    for (int n = 0; n < 2; ++n) acc[a][b][m][n] = (f32x4){0.f, 0.f, 0.f, 0.f};
        cur = nxt; cA = nA; cB = nB; ++ui;
        if constexpr (Sched::GATHER) { oc[0][0] = on[0][0]; oc[0][1] = on[0][1]; oc[1][0] = on[1][0]; oc[1][1] = on[1][1]; }
        if constexpr (ALIGN_EPI) { if (wr == 1) PG8_BAR; }
    }
    PG8_WAIT_V(0);
    if constexpr (!ALIGN_EPI) { if (wr == 0) PG8_BAR; }
    PG8_BAR;
#undef PG8_SA
#undef PG8_SB
#undef PG8_STAGE
#undef PG8_STAGE_A
#undef PG8_GOFF
#undef PG8_TABDMA
#undef PG8_LDA
#undef PG8_LDB
#undef PG8_MMA
#undef PG8_WAIT_V
#undef PG8_WAIT_L
#undef PG8_BAR
#undef PG8_SCHED
}

struct DenseSched {
    static constexpr bool GATHER = false;
    const char* A; const char* Bt; int nM, nN, G, c, K;
    const char* Abase = nullptr; const int* list = nullptr; const LAS int* tab = nullptr; const LAS int* cntl = nullptr;
    __device__ __forceinline__ bool next(int i, Unit& u) const {
        int pm, pn; if (!static_tile(i, G, c, nM, nN, pm, pn)) return false;
        u.row0 = pm * BM; u.col0 = pn * BM; u.e = 0; u.aux = 0; u.A = A + (size_t)pm * BM * K * 2; u.B = Bt + (size_t)pn * BM * K * 2; return true;
    }
};
struct BranchSched {
    static constexpr bool GATHER = false;
    const char* A0; const char* A1; const char* A2; const char* W3; int G, c;
    const char* Abase = nullptr; const int* list = nullptr; const LAS int* tab = nullptr; const LAS int* cntl = nullptr;
    __device__ __forceinline__ bool next(int i, Unit& u) const {
        const int br = i % 3; int pm, pn; if (!static_tile(i / 3, G, c, NTOK / BM, DM / BM, pm, pn)) return false;
        u.row0 = pm * BM; u.col0 = pn * BM; u.e = br; u.aux = 0;
        u.A = (br == 0 ? A0 : (br == 1 ? A1 : A2)) + (size_t)pm * BM * DM * 2; u.B = W3 + ((size_t)br * DM + (size_t)pn * BM) * DM * 2; return true;
    }
};
template <bool GATHER_>
struct MoeSchedT {
    static constexpr bool GATHER = GATHER_;
    const char* A; const char* W; const LAS int* tstart; size_t Wstride; int nN, G, c;
    const char* Abase; const int* list; const LAS int* tab; const LAS int* cntl;
    __device__ __forceinline__ bool next(int i, Unit& u) const {
        const int nM = tstart[NEXP]; int pm, pn; if (!static_tile(i, G, c, nM, nN, pm, pn)) return false;
        int e = 0;
#pragma unroll 1
        for (int j = 1; j < NEXP; ++j) e += (tstart[j] <= pm) ? 1 : 0;
        u.row0 = pm * BM; u.col0 = pn * BM; u.e = e; u.aux = (pm - tstart[e]) * BM;
        u.A = A + (size_t)pm * BM * DM * 2; u.B = W + (size_t)e * Wstride + (size_t)pn * BM * DM * 2; return true;
    }
};
typedef MoeSchedT<false> MoeSched;
typedef MoeSchedT<true> MoeGatherSched;

struct EpiBf16 {
    bf16_t* O; int ldc; const float* bias; int bstride;
    __device__ __forceinline__ void operator()(const f32x4 (&acc)[2][2][4][2], const Unit& u, int wr, int wc, int fr, int fq) const {
        const int row0 = u.row0 + wr * 64 + fr, col0 = u.col0 + wc * 32 + 8 * fq;
        f32x4 bv[2][2];
#pragma unroll
        for (int bj = 0; bj < 2; ++bj)
#pragma unroll
            for (int n = 0; n < 2; ++n) bv[bj][n] = bias ? *(const f32x4*)(bias + (size_t)u.e * bstride + col0 + bj * HALF + 4 * n) : (f32x4){0.f, 0.f, 0.f, 0.f};
#pragma unroll
        for (int ai = 0; ai < 2; ++ai)
#pragma unroll
            for (int m = 0; m < 4; ++m) { bf16_t* rowp = O + (size_t)(row0 + ai * HALF + m * 16) * ldc + col0;
#pragma unroll
                for (int bj = 0; bj < 2; ++bj) { const f32x4 v0 = acc[ai][bj][m][0] + bv[bj][0], v1 = acc[ai][bj][m][1] + bv[bj][1];
                    u32x4 w; w.x = cvt_pk_bf16(v0[0], v0[1]); w.y = cvt_pk_bf16(v0[2], v0[3]); w.z = cvt_pk_bf16(v1[0], v1[1]); w.w = cvt_pk_bf16(v1[2], v1[3]);
                    *(u32x4*)(rowp + bj * HALF) = w; } }
    }
};
struct EpiBranch {
    float* MRG; bf16_t* MRGB; const bf16_t* PROJB;
    __device__ __forceinline__ void operator()(const f32x4 (&acc)[2][2][4][2], const Unit& u, int wr, int wc, int fr, int fq) const {
        const int row0 = u.row0 + wr * 64 + fr, col0 = u.col0 + wc * 32 + 8 * fq, br = u.e;
#pragma unroll
        for (int ai = 0; ai < 2; ++ai)
#pragma unroll
            for (int m = 0; m < 4; ++m) { const size_t row = (size_t)(row0 + ai * HALF + m * 16);
#pragma unroll
                for (int bj = 0; bj < 2; ++bj) { const int col = col0 + bj * HALF;
                    const u32x4 gl = *(const u32x4*)(PROJB + row * PROJ_COLS + PJ_GATES + br * DM + col);
                    f32x4 v0, v1;
                    v0[0] = sigmoidf_(bflo(gl.x)) * acc[ai][bj][m][0][0]; v0[1] = sigmoidf_(bfhi(gl.x)) * acc[ai][bj][m][0][1];
                    v0[2] = sigmoidf_(bflo(gl.y)) * acc[ai][bj][m][0][2]; v0[3] = sigmoidf_(bfhi(gl.y)) * acc[ai][bj][m][0][3];
                    v1[0] = sigmoidf_(bflo(gl.z)) * acc[ai][bj][m][1][0]; v1[1] = sigmoidf_(bfhi(gl.z)) * acc[ai][bj][m][1][1];
                    v1[2] = sigmoidf_(bflo(gl.w)) * acc[ai][bj][m][1][2]; v1[3] = sigmoidf_(bfhi(gl.w)) * acc[ai][bj][m][1][3];
                    float* mp = MRG + row * DM + col;
                    if (br != 0) { v0 += *(const f32x4*)mp; v1 += *(const f32x4*)(mp + 4); }
                    if (br != 2) { *(f32x4*)mp = v0; *(f32x4*)(mp + 4) = v1; }
                    else { u32x4 w; w.x = cvt_pk_bf16(v0[0], v0[1]); w.y = cvt_pk_bf16(v0[2], v0[3]); w.z = cvt_pk_bf16(v1[0], v1[1]); w.w = cvt_pk_bf16(v1[2], v1[3]);
                        *(u32x4*)(MRGB + row * DM + col) = w; } } }
    }
};
struct EpiSwiglu {
    bf16_t* H; const float* b_gu;
    __device__ __forceinline__ void operator()(const f32x4 (&acc)[2][2][4][2], const Unit& u, int wr, int wc, int fr, int fq) const {
        const int row0 = u.row0 + wr * 64 + fr, jj0 = wc * 32 + 8 * fq, oc0 = (u.col0 >> 1) + jj0;
        const float* bp = b_gu + (size_t)u.e * 2048 + 2 * oc0;
        float bg[8], bl[8];
#pragma unroll
        for (int j = 0; j < 4; ++j) { const f32x4 b4 = *(const f32x4*)(bp + 4 * j); bg[2 * j] = b4[0]; bl[2 * j] = b4[1]; bg[2 * j + 1] = b4[2]; bl[2 * j + 1] = b4[3]; }
#pragma unroll
        for (int ai = 0; ai < 2; ++ai)
#pragma unroll
            for (int m = 0; m < 4; ++m) { const size_t row = (size_t)(row0 + ai * HALF + m * 16);
                float o[8];
#pragma unroll
                for (int n = 0; n < 2; ++n)
#pragma unroll
                    for (int j = 0; j < 4; ++j) {
                        const float gate = fminf(acc[ai][0][m][n][j] + bg[4 * n + j], 7.0f);
                        const float lin = fminf(fmaxf(acc[ai][1][m][n][j] + bl[4 * n + j], -7.0f), 7.0f);
                        o[4 * n + j] = gate * sigmoidf_(1.702f * gate) * (lin + 1.0f);
                    }
                u32x4 w; w.x = cvt_pk_bf16(o[0], o[1]); w.y = cvt_pk_bf16(o[2], o[3]); w.z = cvt_pk_bf16(o[4], o[5]); w.w = cvt_pk_bf16(o[6], o[7]);
                *(u32x4*)(H + row * DM + oc0) = w; }
    }
};
struct EpiPle {
    bf16_t* O; const bf16_t* PP;
    __device__ __forceinline__ void operator()(const f32x4 (&acc)[2][2][4][2], const Unit& u, int wr, int wc, int fr, int fq) const {
        const int row0 = u.row0 + wr * 64 + fr, col0 = u.col0 + wc * 32 + 8 * fq;
#pragma unroll
        for (int ai = 0; ai < 2; ++ai)
#pragma unroll
            for (int m = 0; m < 4; ++m) { const size_t row = (size_t)(row0 + ai * HALF + m * 16);
#pragma unroll
                for (int bj = 0; bj < 2; ++bj) { const int col = col0 + bj * HALF;
                    const u32x4 pp = *(const u32x4*)(PP + row * DM + col);
                    const f32x4 a0 = acc[ai][bj][m][0], a1 = acc[ai][bj][m][1];
                    u32x4 w;
                    w.x = cvt_pk_bf16(sigmoidf_(a0[0]) * bflo(pp.x), sigmoidf_(a0[1]) * bfhi(pp.x));
                    w.y = cvt_pk_bf16(sigmoidf_(a0[2]) * bflo(pp.y), sigmoidf_(a0[3]) * bfhi(pp.y));
                    w.z = cvt_pk_bf16(sigmoidf_(a1[0]) * bflo(pp.z), sigmoidf_(a1[1]) * bfhi(pp.z));
                    w.w = cvt_pk_bf16(sigmoidf_(a1[2]) * bflo(pp.w), sigmoidf_(a1[3]) * bfhi(pp.w));
                    *(u32x4*)(O + row * DM + col) = w; } }
    }
};
}

constexpr int NWAVES = 8;
constexpr int LDS_BYTES = 163840;
constexpr int LDS_MISC = 155648;
constexpr size_t MiB = 1u << 20;
constexpr size_t WS_CTL = 0;
constexpr size_t WS_W = 1 * MiB, WL_STRIDE = 224 * MiB;
constexpr size_t W_IN = 0, W_O3 = 21 * MiB, W_OUT = 27 * MiB, W_GU = 29 * MiB, W_DN = 157 * MiB, W_PG = 221 * MiB, W_PP = 223 * MiB, W_LRU = 223 * MiB + 512 * 1024;
constexpr size_t WS_PB = WS_W + 2 * WL_STRIDE;
constexpr size_t WS_XB = WS_PB + 32 * MiB;
constexpr size_t WS_XF = WS_XB + 64 * MiB;
constexpr size_t WS_PROJ = WS_XF + 128 * MiB;
constexpr size_t WS_GO = WS_PROJ + 672 * MiB, WS_LO = WS_GO + 64 * MiB, WS_SO = WS_LO + 64 * MiB;
constexpr size_t WS_M = WS_SO + 64 * MiB;
constexpr size_t WS_SMALL = WS_M + 496 * MiB;
constexpr size_t WS_AB = WS_SMALL, WS_GG = WS_AB + 2 * MiB, WS_BT = WS_GG + 1 * MiB, WS_GATES = WS_BT + 1 * MiB, WS_ES = WS_GATES + MiB / 2, WS_LIST = WS_ES + MiB / 2;
constexpr size_t WS_END = WS_LIST + 4 * MiB;
static_assert(WS_END <= 2048 * MiB, "workspace map must fit 2 GiB");
constexpr size_t M_QN = 0, M_KN = 64 * MiB, M_VV = 128 * MiB, M_OO = 192 * MiB;
constexpr size_t M_XC = 0, M_LA = 128 * MiB, M_LU = 256 * MiB;
constexpr size_t M_MRG = 0, M_MRGB = 128 * MiB, M_YY = 192 * MiB;
constexpr size_t M_XS = 0;
constexpr size_t M_PP = 0, M_PLEO = 64 * MiB;
constexpr size_t PJ_H = 0, PJ_OB = 272 * MiB;
constexpr int CW_CNT = 1024;
constexpr int CW_BAR = 4096;

struct MArgs { const float* in[34]; float* out; unsigned char* ws; int ph_lo, ph_hi; };
enum { I_X = 0, I_P, I_WIN, I_CONVQKV, I_ALOG, I_DTB, I_GNW, I_RGCW, I_RGCB, I_RGWA, I_RGBA, I_RGWX, I_RGBX, I_RGLAM, I_SINKS, I_RELB, I_WOG, I_WOL, I_WOS, I_WOUT,
       I_LN1G, I_LN1B, I_RW, I_RB, I_WGU, I_BGU, I_WDN, I_BDN, I_LN2G, I_LN2B, I_PLEG, I_PLEP, I_LN3G, I_LN3B };

template <int MAP>
__device__ __forceinline__ int src_col(int n) {
    if (MAP == 1) return n < 4096 ? n : n + 16;
    if (MAP == 2) { const int pn = n >> 8, half = (n >> 7) & 1, jj = n & 127; return 2 * (pn * 128 + jj) + half; }
    return n;
}
template <int MAP>
__device__ __forceinline__ void transpose_item(const float* W, int K, int ldw, int Nout, bf16_t* WT, LAS float* scr, int item, int lane) {
    const int nblk = Nout / 32, kb = item / nblk, nb = item % nblk, k0 = 64 * kb, n0 = 32 * nb;
    const int sc = src_col<MAP>(n0 + (lane & 31));
    float tmpv[32];
#pragma unroll
    for (int i = 0; i < 32; ++i) tmpv[i] = W[(size_t)(k0 + 2 * i + (lane >> 5)) * ldw + sc];
#pragma unroll
    for (int i = 0; i < 32; ++i) scr[(2 * i + (lane >> 5)) * 33 + (lane & 31)] = tmpv[i];
    asm volatile("s_waitcnt lgkmcnt(0)" ::: "memory");
    const int c = lane & 7;
#pragma unroll
    for (int j = 0; j < 4; ++j) { const int n = (lane >> 3) + 8 * j; const LAS float* s = scr + (8 * c) * 33 + n;
        u32x4 o; o.x = pk2(s[0 * 33], s[1 * 33]); o.y = pk2(s[2 * 33], s[3 * 33]); o.z = pk2(s[4 * 33], s[5 * 33]); o.w = pk2(s[6 * 33], s[7 * 33]);
        *(u32x4*)(WT + (size_t)(n0 + n) * K + k0 + 8 * c) = o; }
    asm volatile("s_waitcnt lgkmcnt(0)" ::: "memory");
}
__device__ __forceinline__ void transpose_item_gu(const float* W, bf16_t* WT, LAS float* scr, int item, int lane) {
    const int kb = item >> 5, jb = item & 31, k0 = 64 * kb, j0 = 32 * jb;
    f32x2 tmpv[32];
#pragma unroll
    for (int i = 0; i < 32; ++i) tmpv[i] = *(const f32x2*)(W + (size_t)(k0 + 2 * i + (lane >> 5)) * 2048 + 2 * (j0 + (lane & 31)));
#pragma unroll
    for (int i = 0; i < 32; ++i) *(LAS f32x2*)(scr + (2 * i + (lane >> 5)) * 66 + 2 * (lane & 31)) = tmpv[i];
    asm volatile("s_waitcnt lgkmcnt(0)" ::: "memory");
    const int c = lane & 7;
#pragma unroll
    for (int half = 0; half < 2; ++half)
#pragma unroll
        for (int jq = 0; jq < 4; ++jq) { const int nl = (lane >> 3) + 8 * jq, j = j0 + nl, n = (j >> 7) * 256 + half * 128 + (j & 127);
            const LAS float* s = scr + (8 * c) * 66 + 2 * nl + half;
            u32x4 o; o.x = pk2(s[0 * 66], s[1 * 66]); o.y = pk2(s[2 * 66], s[3 * 66]); o.z = pk2(s[4 * 66], s[5 * 66]); o.w = pk2(s[6 * 66], s[7 * 66]);
            *(u32x4*)(WT + (size_t)n * 1024 + k0 + 8 * c) = o; }
    asm volatile("s_waitcnt lgkmcnt(0)" ::: "memory");
}
template <int MAP>
__device__ __forceinline__ void transpose_seg(const float* W, int K, int ldw, int Nout, bf16_t* WT, LAS float* scr, int gw, int NGW, int lane) {
    const int nitems = (K / 64) * (Nout / 32);
    for (int it = gw; it < nitems; it += NGW) transpose_item<MAP>(W, K, ldw, Nout, WT, scr, it, lane);
}
__device__ __forceinline__ void cvt_rows(const float* src, bf16_t* dst, size_t n, int G) {
    for (size_t i = (size_t)blockIdx.x * 512 + threadIdx.x; i < n / 8; i += (size_t)G * 512) {
        const f32x4 v0 = *(const f32x4*)(src + i * 8), v1 = *(const f32x4*)(src + i * 8 + 4);
        u32x4 o; o.x = pk2(v0[0], v0[1]); o.y = pk2(v0[2], v0[3]); o.z = pk2(v1[0], v1[1]); o.w = pk2(v1[2], v1[3]);
        *(u32x4*)(dst + i * 8) = o;
    }
}
template <int NE4>
__device__ __forceinline__ void stage_smallw(const float* W, int ld, int col0, LAS unsigned char* dst, int tid) {
    for (int i = tid; i < 1024 * NE4; i += 512) { const int k = i / NE4, e4 = i % NE4; const int m = (k >> 8) * 4 + (k & 3), ln = (k & 255) >> 2;
        *(LAS f32x4*)(dst + ((e4 * 16 + m) * 64 + ln) * 16) = *(const f32x4*)(W + (size_t)k * ld + col0 + 4 * e4); }
}
template <int NE4>
__device__ __forceinline__ void small_project(const f32x4 (&v)[4], const LAS unsigned char* wsm, float (&acc)[4 * NE4], int lane) {
#pragma unroll
    for (int e = 0; e < 4 * NE4; ++e) acc[e] = 0.f;
#pragma unroll
    for (int j = 0; j < 4; ++j)
#pragma unroll
        for (int q = 0; q < 4; ++q) { const float xv = v[j][q];
#pragma unroll
            for (int e4 = 0; e4 < NE4; ++e4) { const f32x4 w4 = *(const LAS f32x4*)(wsm + ((e4 * 16 + 4 * j + q) * 64 + lane) * 16);
                acc[4 * e4 + 0] = fmaf(xv, w4[0], acc[4 * e4 + 0]); acc[4 * e4 + 1] = fmaf(xv, w4[1], acc[4 * e4 + 1]);
                acc[4 * e4 + 2] = fmaf(xv, w4[2], acc[4 * e4 + 2]); acc[4 * e4 + 3] = fmaf(xv, w4[3], acc[4 * e4 + 3]); } }
}
__device__ __forceinline__ float reduce_scatter32(const float (&acc)[32], int lane) {
    float a16[16], a8[8], a4[4], a2[2];
    const bool b5 = lane & 32, b4 = lane & 16, b3 = lane & 8, b2 = lane & 4, b1 = lane & 2;
#pragma unroll
    for (int i = 0; i < 16; ++i) { const float keep = b5 ? acc[i + 16] : acc[i], give = b5 ? acc[i] : acc[i + 16]; a16[i] = keep + __shfl_xor(give, 32); }
#pragma unroll
    for (int i = 0; i < 8; ++i) { const float keep = b4 ? a16[i + 8] : a16[i], give = b4 ? a16[i] : a16[i + 8]; a8[i] = keep + __shfl_xor(give, 16); }
#pragma unroll
    for (int i = 0; i < 4; ++i) { const float keep = b3 ? a8[i + 4] : a8[i], give = b3 ? a8[i] : a8[i + 4]; a4[i] = keep + __shfl_xor(give, 8); }
#pragma unroll
    for (int i = 0; i < 2; ++i) { const float keep = b2 ? a4[i + 2] : a4[i], give = b2 ? a4[i] : a4[i + 2]; a2[i] = keep + __shfl_xor(give, 4); }
    const float keep = b1 ? a2[1] : a2[0], give = b1 ? a2[0] : a2[1];
    float v = keep + __shfl_xor(give, 2);
    v += __shfl_xor(v, 1);
    return v;
}
__device__ __forceinline__ float reduce_scatter16(const float (&acc)[16], int lane) {
    float a8[8], a4[4], a2[2];
    const bool b5 = lane & 32, b4 = lane & 16, b3 = lane & 8, b2 = lane & 4;
#pragma unroll
    for (int i = 0; i < 8; ++i) { const float keep = b5 ? acc[i + 8] : acc[i], give = b5 ? acc[i] : acc[i + 8]; a8[i] = keep + __shfl_xor(give, 32); }
#pragma unroll
    for (int i = 0; i < 4; ++i) { const float keep = b4 ? a8[i + 4] : a8[i], give = b4 ? a8[i] : a8[i + 4]; a4[i] = keep + __shfl_xor(give, 16); }
#pragma unroll
    for (int i = 0; i < 2; ++i) { const float keep = b3 ? a4[i + 2] : a4[i], give = b3 ? a4[i] : a4[i + 2]; a2[i] = keep + __shfl_xor(give, 8); }
    const float keep = b2 ? a2[1] : a2[0], give = b2 ? a2[0] : a2[1];
    float v = keep + __shfl_xor(give, 4);
    v += __shfl_xor(v, 2); v += __shfl_xor(v, 1);
    return v;
}
__device__ __forceinline__ void ab_project(const f32x4 (&v)[4], const LAS unsigned char* wsm, float* ABrow, int lane) {
    float acc[16];
    small_project<4>(v, wsm, acc, lane);
    const float s = reduce_scatter16(acc, lane);
    if ((lane & 3) == 0) ABrow[lane >> 2] = s;
}
__device__ __forceinline__ void ln_inplace(f32x4 (&v)[4], const float* g, const float* b, int lane) {
    float s = 0.f;
#pragma unroll
    for (int j = 0; j < 4; ++j) s += (v[j][0] + v[j][1]) + (v[j][2] + v[j][3]);
    const float mu = wave_sum(s) * (1.0f / DM);
    float s2 = 0.f;
#pragma unroll
    for (int j = 0; j < 4; ++j) { v[j] = v[j] - mu; s2 += (v[j][0] * v[j][0] + v[j][1] * v[j][1]) + (v[j][2] * v[j][2] + v[j][3] * v[j][3]); }
    const float rstd = rsqrtf(wave_sum(s2) * (1.0f / DM) + 1e-5f);
#pragma unroll
    for (int j = 0; j < 4; ++j) { const f32x4 g4 = *(const f32x4*)(g + 256 * j + 4 * lane), b4 = *(const f32x4*)(b + 256 * j + 4 * lane); v[j] = v[j] * rstd * g4 + b4; }
}
__device__ __forceinline__ void store_row(const f32x4 (&v)[4], float* xf, bf16_t* xb, int lane) {
#pragma unroll
    for (int j = 0; j < 4; ++j) { if (xf) *(f32x4*)(xf + 256 * j + 4 * lane) = v[j];
        u32x2 o; o.x = pk2(v[j][0], v[j][1]); o.y = pk2(v[j][2], v[j][3]); *(u32x2*)(xb + 256 * j + 4 * lane) = o; }
}
__device__ __forceinline__ f32x4 ld_bf4(const bf16_t* p) { const u32x2 y2 = *(const u32x2*)p; return (f32x4){bflo(y2.x), bfhi(y2.x), bflo(y2.y), bfhi(y2.y)}; }
__device__ __forceinline__ int t5_bucket(int dist) {
    if (dist < 16) return dist;
    int l = 16 + (int)(logf((float)dist / 16.0f) / logf(8.0f) * 16.0f);
    return l < 31 ? l : 31;
}


typedef float f32x16 __attribute__((ext_vector_type(16)));
__device__ __forceinline__ bf16x8 pack8(const f32x16& c, const int s) {
    u32x4 p; p.x = cvtpk(c[8 * s + 0], c[8 * s + 1]); p.y = cvtpk(c[8 * s + 2], c[8 * s + 3]); p.z = cvtpk(c[8 * s + 4], c[8 * s + 5]); p.w = cvtpk(c[8 * s + 6], c[8 * s + 7]);
    return __builtin_bit_cast(bf16x8, p);
}
#define MFMA32(a, b, c) __builtin_amdgcn_mfma_f32_32x32x16_bf16((a), (b), (c), 0, 0, 0)
constexpr size_t G_WN = 0, G_QN = 64 * MiB, G_AN = 128 * MiB, G_KT = 160 * MiB, G_UN = 224 * MiB, G_GC = 352 * MiB, G_OO = 353 * MiB, G_VT = 417 * MiB, G_EG = 449 * MiB;
constexpr int GA_LDS = 19456;
constexpr int GA_TSTR = 272;
constexpr int GA_USTR = 144;
constexpr int GA_G = 18304, GA_B = 18560, GA_RK = 18816, GA_RQ = 19072;

__device__ __forceinline__ void gdn_stage_raw(const bf16_t* src  , int seqpos0, LAS unsigned char* wl, int lane) {
    if (seqpos0 > 0) {
#pragma unroll
        for (int u = 0; u < 3; ++u) __builtin_amdgcn_global_load_lds((const unsigned*)(src + (ptrdiff_t)(u - 3) * PROJ_COLS), (LAS unsigned*)(wl + u * GA_TSTR), 4, 0, 0);
    } else {
#pragma unroll
        for (int u = 0; u < 3; ++u) *(LAS unsigned*)(wl + u * GA_TSTR + 4 * lane) = 0u;
    }
#pragma unroll 8
    for (int p = 0; p < 64; ++p) __builtin_amdgcn_global_load_lds((const unsigned*)(src + (size_t)p * PROJ_COLS), (LAS unsigned*)(wl + (p + 3) * GA_TSTR), 4, 0, 0);
}
template <int UNR, class F>
__device__ __forceinline__ void gdn_conv_stream(LAS unsigned char* wl, const float* cw  , int lane, F&& emit) {
    f32x2 w[4];
#pragma unroll
    for (int j = 0; j < 4; ++j) w[j] = *(const f32x2*)(cw + j * 3072);
    asm volatile("s_waitcnt vmcnt(0)" ::: "memory");
    unsigned r0 = *(LAS unsigned*)(wl + 0 * GA_TSTR + 4 * lane), r1 = *(LAS unsigned*)(wl + 1 * GA_TSTR + 4 * lane), r2 = *(LAS unsigned*)(wl + 2 * GA_TSTR + 4 * lane);
#pragma unroll 1
    for (int pb_ = 0; pb_ < 64 / UNR; ++pb_) {
        unsigned cu[UNR];
#pragma unroll
        for (int u = 0; u < UNR; ++u) cu[u] = *(LAS unsigned*)(wl + (UNR * pb_ + u + 3) * GA_TSTR + 4 * lane);
#pragma unroll
        for (int u = 0; u < UNR; ++u) {
            const unsigned r3 = cu[u];
            float y0 = w[0][0] * bflo(r0); y0 = fmaf(w[1][0], bflo(r1), y0); y0 = fmaf(w[2][0], bflo(r2), y0); y0 = fmaf(w[3][0], bflo(r3), y0);
            float y1 = w[0][1] * bfhi(r0); y1 = fmaf(w[1][1], bfhi(r1), y1); y1 = fmaf(w[2][1], bfhi(r2), y1); y1 = fmaf(w[3][1], bfhi(r3), y1);
            r0 = r1; r1 = r2; r2 = r3;
            emit(pb_, u, siluf_(y0), siluf_(y1));
        }
    }
}

__device__ __forceinline__ void gdn_a_item(const __attribute__((address_space(4))) MArgs& a, unsigned char* ws, const int L, LAS unsigned char* wl, const int item, const int lane, const int vt_slot) {
    const int n = item & 63, h = (item >> 6) & 7, b = item >> 9;
    const size_t t0 = (size_t)b * SEQ + (size_t)n * 64;
    const int r = lane & 31, hh = lane >> 5;
    const bf16_t* PROJB = (const bf16_t*)(ws + WS_PROJ);
    unsigned char* RM = ws + WS_M;
    LAS float* Gs = (LAS float*)(wl + GA_G); LAS float* Bs = (LAS float*)(wl + GA_B); LAS float* Rk = (LAS float*)(wl + GA_RK); LAS float* Rq = (LAS float*)(wl + GA_RQ);
    float Gtok, Glast;
    auto row_ss = [&]() { float ss = 0.f;
#pragma unroll
        for (int c8 = 0; c8 < 16; ++c8) { const u32x4 w = *(const LAS u32x4*)(wl + lane * GA_TSTR + 16 * c8);
            ss = fmaf(bflo(w.x), bflo(w.x), ss); ss = fmaf(bfhi(w.x), bfhi(w.x), ss); ss = fmaf(bflo(w.y), bflo(w.y), ss); ss = fmaf(bfhi(w.y), bfhi(w.y), ss);
            ss = fmaf(bflo(w.z), bflo(w.z), ss); ss = fmaf(bfhi(w.z), bfhi(w.z), ss); ss = fmaf(bflo(w.w), bflo(w.w), ss); ss = fmaf(bfhi(w.w), bfhi(w.w), ss); }
        return ss; };
    {
        const float* AB = (const float*)(ws + WS_AB);
        const float av = AB[(t0 + lane) * 16 + h], bv = AB[(t0 + lane) * 16 + 8 + h];
        float G = -expf(a.in[I_ALOG][L * 8 + h]) * softplusf_(av + a.in[I_DTB][L * 8 + h]);
#pragma unroll
        for (int o = 1; o < 64; o <<= 1) { const float y = __shfl_up(G, o); if (lane >= o) G += y; }
        Gs[lane] = G; Bs[lane] = sigmoidf_(bv);
        Gtok = G; Glast = __builtin_bit_cast(float, __builtin_amdgcn_readlane(__builtin_bit_cast(int, G), 63));
    }
    const float* cwL = a.in[I_CONVQKV] + (size_t)L * 4 * 3072 + h * 128 + 2 * lane;
    const bf16_t* srcL = PROJB + t0 * PROJ_COLS + h * 128 + 2 * lane;
    gdn_stage_raw(srcL + PJ_V, n, wl, lane);
    bf16_t* VT = (bf16_t*)(RM + G_VT) + (size_t)vt_slot * 8192;
    {
        float vb0[8], vb1[8];
        gdn_conv_stream<8>(wl, cwL + 2048, lane, [&](int pb_, int u, float y0, float y1) {
            const int p = 8 * pb_ + u;
            vb0[u] = y0; vb1[u] = y1;
            if (u == 7) {
                u32x4 o0; o0.x = cvtpk(vb0[0], vb0[1]); o0.y = cvtpk(vb0[2], vb0[3]); o0.z = cvtpk(vb0[4], vb0[5]); o0.w = cvtpk(vb0[6], vb0[7]);
                u32x4 o1; o1.x = cvtpk(vb1[0], vb1[1]); o1.y = cvtpk(vb1[2], vb1[3]); o1.z = cvtpk(vb1[4], vb1[5]); o1.w = cvtpk(vb1[6], vb1[7]);
                *(u32x4*)(VT + (size_t)(2 * lane) * 64 + (p & ~7)) = o0; *(u32x4*)(VT + (size_t)(2 * lane + 1) * 64 + (p & ~7)) = o1;
            }
        });
    }
    asm volatile("s_waitcnt lgkmcnt(0)" ::: "memory");
    gdn_stage_raw(srcL + PJ_K, n, wl, lane);
    {
        bf16_t* KTN = (bf16_t*)(RM + G_KT) + (size_t)item * 8192;
        float kb0[4], kb1[4];
        const int d0 = 2 * lane, mtp = d0 >> 5, rr = d0 & 31;
        gdn_conv_stream<4>(wl, cwL + 1024, lane, [&](int pb_, int u, float y0, float y1) {
            const int p = 4 * pb_ + u;
            *(LAS unsigned*)(wl + p * GA_TSTR + 4 * lane) = cvtpk(y0, y1);
            kb0[u] = y0; kb1[u] = y1;
            if (u == 3) {
                const int ks = p >> 4, q4 = (p & 15) >> 2, h_ = q4 & 1, jh = q4 >> 1;
                const size_t off = ((size_t)((mtp * 4 + ks) * 64 + h_ * 32 + rr)) * 8 + jh * 4;
                u32x2 o0; o0.x = cvtpk(kb0[0], kb0[1]); o0.y = cvtpk(kb0[2], kb0[3]);
                u32x2 o1; o1.x = cvtpk(kb1[0], kb1[1]); o1.y = cvtpk(kb1[2], kb1[3]);
                *(u32x2*)(KTN + off) = o0; *(u32x2*)(KTN + off + 8) = o1;
            }
        });
    }
    const float rnk = rsqrtf(row_ss() + 1e-6f);
    Rk[lane] = rnk;
    bf16x8 kf[2][8];
#pragma unroll
    for (int mt = 0; mt < 2; ++mt)
#pragma unroll
        for (int s = 0; s < 8; ++s) kf[mt][s] = *(const LAS bf16x8*)(wl + (32 * mt + r) * GA_TSTR + (16 * s + 8 * hh) * 2);
    asm volatile("s_waitcnt lgkmcnt(0)" ::: "memory");
    gdn_stage_raw(srcL + PJ_Q, n, wl, lane);
    gdn_conv_stream<4>(wl, cwL, lane, [&](int pb_, int u, float y0, float y1) {
        *(LAS unsigned*)(wl + (4 * pb_ + u) * GA_TSTR + 4 * lane) = cvtpk(y0, y1);
    });
    const float rnq = rsqrtf(row_ss() + 1e-6f) * 0.08838834764831845f;
    Rq[lane] = rnq;
    {
        float* EG = (float*)(RM + G_EG) + (size_t)item * 192;
        EG[lane] = fexp(Gtok) * rnq; EG[64 + lane] = fexp(Glast - Gtok) * rnk;
        if (lane == 0) EG[128] = fexp(Glast);
    }
    {
        bf16_t* ANf = (bf16_t*)(RM + G_AN) + (size_t)item * 4096;
#pragma unroll
        for (int it = 0; it < 2; ++it)
#pragma unroll
            for (int jt = 0; jt <= it; ++jt) {
                f32x16 c = {0.f, 0.f, 0.f, 0.f, 0.f, 0.f, 0.f, 0.f, 0.f, 0.f, 0.f, 0.f, 0.f, 0.f, 0.f, 0.f};
#pragma unroll
                for (int s = 0; s < 8; ++s) { const bf16x8 qf = *(const LAS bf16x8*)(wl + (32 * it + r) * GA_TSTR + (16 * s + 8 * hh) * 2); c = MFMA32(kf[jt][s], qf, c); }
                const int i = 32 * it + r; const float Gi = Gs[i], Rqi = Rq[i];
#pragma unroll
                for (int g4 = 0; g4 < 4; ++g4) { const f32x4 Gj = *(const LAS f32x4*)(Gs + 32 * jt + 8 * g4 + 4 * hh), Rkj = *(const LAS f32x4*)(Rk + 32 * jt + 8 * g4 + 4 * hh);
#pragma unroll
                    for (int q = 0; q < 4; ++q) { const int j = 32 * jt + 8 * g4 + 4 * hh + q; c[4 * g4 + q] = (i >= j) ? c[4 * g4 + q] * (Rqi * Rkj[q] * fexp(Gi - Gj[q])) : 0.f; } }
#pragma unroll
                for (int sp = 0; sp < 2; ++sp) *(bf16x8*)((unsigned char*)ANf + (unsigned)(lane * 16) + (it * 4 + 2 * jt + sp) * 1024) = pack8(c, sp);
            }
    }
    {
        f32x16 ck[3];
#pragma unroll
        for (int tix = 0; tix < 3; ++tix) {
            const int it = tix == 0 ? 0 : 1, jt = tix == 2 ? 1 : 0;
            f32x16 c = {0.f, 0.f, 0.f, 0.f, 0.f, 0.f, 0.f, 0.f, 0.f, 0.f, 0.f, 0.f, 0.f, 0.f, 0.f, 0.f};
#pragma unroll
            for (int s = 0; s < 8; ++s) c = MFMA32(kf[it][s], kf[jt][s], c);
            const int j = 32 * jt + r; const float Gj = Gs[j], Rkj = Rk[j];
#pragma unroll
            for (int g4 = 0; g4 < 4; ++g4) { const f32x4 Gi = *(const LAS f32x4*)(Gs + 32 * it + 8 * g4 + 4 * hh), Bi = *(const LAS f32x4*)(Bs + 32 * it + 8 * g4 + 4 * hh), Rki = *(const LAS f32x4*)(Rk + 32 * it + 8 * g4 + 4 * hh);
#pragma unroll
                for (int q = 0; q < 4; ++q) { const int i = 32 * it + 8 * g4 + 4 * hh + q; c[4 * g4 + q] = (i > j) ? (Bi[q] * Rki[q] * Rkj) * c[4 * g4 + q] * fexp(Gi[q] - Gj) : 0.f; } }
            ck[tix] = c;
        }
        {
            bf16_t* QNt = (bf16_t*)(RM + G_QN) + (size_t)item * 8192;
    #pragma unroll
            for (int mt = 0; mt < 2; ++mt)
    #pragma unroll
                for (int ks = 0; ks < 8; ++ks) {
                    const LAS unsigned char* rowp = wl + (32 * mt + r) * GA_TSTR + (32 * (ks >> 1) + 16 * (ks & 1) + 4 * hh) * 2;
                    const u32x2 lo = *(const LAS u32x2*)rowp, hi = *(const LAS u32x2*)(rowp + 16);
                    u32x4 o; o.x = lo.x; o.y = lo.y; o.z = hi.x; o.w = hi.y;
                    *(u32x4*)((unsigned char*)QNt + (unsigned)(lane * 16) + (mt * 8 + ks) * 1024) = o;
                }
        }
        asm volatile("s_waitcnt lgkmcnt(0)" ::: "memory");
#pragma unroll
        for (int tix = 0; tix < 3; ++tix) {
            const int it = tix == 0 ? 0 : 1, jt = tix == 2 ? 1 : 0; const int j = 32 * jt + r;
#pragma unroll
            for (int g4 = 0; g4 < 4; ++g4) *(LAS f32x4*)(wl + (j * 64 + 32 * it + 8 * g4 + 4 * hh) * 4) = (f32x4){ck[tix][4 * g4], ck[tix][4 * g4 + 1], ck[tix][4 * g4 + 2], ck[tix][4 * g4 + 3]};
        }
    }
    float t[64];
#pragma unroll
    for (int j = 0; j < 64; ++j) t[j] = 0.f;
    {
        const unsigned ltbase = (unsigned)(size_t)wl;
#pragma unroll
        for (int j = 63; j >= 0; --j) {
            float acc = (lane == j) ? 1.f : 0.f;
            unsigned addr = ltbase + j * 256;
            if (j + 2 < 64) asm volatile("" : "+v"(addr) : "v"(t[(j + 2) & 63]));
#pragma unroll
            for (int i0 = 60; i0 >= ((j + 1) & ~3); i0 -= 4) { const f32x4 l4 = *(const LAS f32x4*)(size_t)(addr + i0 * 4);
                acc = fmaf(-t[i0 + 3], l4[3], acc); acc = fmaf(-t[i0 + 2], l4[2], acc); acc = fmaf(-t[i0 + 1], l4[1], acc); acc = fmaf(-t[i0], l4[0], acc); }
            t[j] = acc;
        }
    }
    bf16x8 vf[4][4];
    {
        unsigned voff = (unsigned)((32 * 0 + r) * 64 + 8 * hh);
        asm volatile("" : "+v"(voff) : "v"(t[0]));
#pragma unroll
        for (int nt = 0; nt < 4; ++nt)
#pragma unroll
            for (int s = 0; s < 4; ++s) vf[nt][s] = *(const bf16x8*)((const unsigned char*)VT + voff * 2u + nt * 4096 + s * 32);
    }
    asm volatile("s_waitcnt lgkmcnt(0)" ::: "memory");
    float bj[64];
#pragma unroll
    for (int j4 = 0; j4 < 16; ++j4) { const f32x4 b4 = *(const LAS f32x4*)(Bs + 4 * j4); bj[4 * j4] = b4[0]; bj[4 * j4 + 1] = b4[1]; bj[4 * j4 + 2] = b4[2]; bj[4 * j4 + 3] = b4[3]; }
#pragma unroll
    for (int j = 0; j < 64; ++j) t[j] *= bj[j];
#pragma unroll
    for (int j8 = 0; j8 < 8; ++j8) { u32x4 o; o.x = cvtpk(t[8 * j8], t[8 * j8 + 1]); o.y = cvtpk(t[8 * j8 + 2], t[8 * j8 + 3]); o.z = cvtpk(t[8 * j8 + 4], t[8 * j8 + 5]); o.w = cvtpk(t[8 * j8 + 6], t[8 * j8 + 7]);
        *(LAS u32x4*)(wl + lane * GA_USTR + 16 * j8) = o; }
    {
        bf16_t* UN = (bf16_t*)(RM + G_UN) + (size_t)item * 8192;
#pragma unroll
        for (int nt = 0; nt < 4; ++nt)
#pragma unroll
            for (int mt = 0; mt < 2; ++mt) {
                f32x16 c = {0.f, 0.f, 0.f, 0.f, 0.f, 0.f, 0.f, 0.f, 0.f, 0.f, 0.f, 0.f, 0.f, 0.f, 0.f, 0.f};
#pragma unroll
                for (int s = 0; s < (mt == 0 ? 2 : 4); ++s) { const bf16x8 af = *(const LAS bf16x8*)(wl + (32 * mt + r) * GA_USTR + (16 * s + 8 * hh) * 2); c = MFMA32(af, vf[nt][s], c); }
#pragma unroll
                for (int sp = 0; sp < 2; ++sp) *(bf16x8*)((unsigned char*)UN + (unsigned)(lane * 16) + ((nt * 2 + mt) * 2 + sp) * 1024) = pack8(c, sp);
            }
    }
    asm volatile("s_waitcnt lgkmcnt(0)" ::: "memory");
#pragma unroll
    for (int j4 = 0; j4 < 16; ++j4) { const f32x4 g4v = *(const LAS f32x4*)(Gs + 4 * j4), rk4 = *(const LAS f32x4*)(Rk + 4 * j4);
        t[4 * j4] *= fexp(g4v[0]) * rk4[0]; t[4 * j4 + 1] *= fexp(g4v[1]) * rk4[1]; t[4 * j4 + 2] *= fexp(g4v[2]) * rk4[2]; t[4 * j4 + 3] *= fexp(g4v[3]) * rk4[3]; }
#pragma unroll
    for (int j8 = 0; j8 < 8; ++j8) { u32x4 o; o.x = cvtpk(t[8 * j8], t[8 * j8 + 1]); o.y = cvtpk(t[8 * j8 + 2], t[8 * j8 + 3]); o.z = cvtpk(t[8 * j8 + 4], t[8 * j8 + 5]); o.w = cvtpk(t[8 * j8 + 6], t[8 * j8 + 7]);
        *(LAS u32x4*)(wl + lane * GA_USTR + 16 * j8) = o; }
    {
        const bf16_t* KTN = (const bf16_t*)(RM + G_KT) + (size_t)item * 8192;
        bf16_t* WN = (bf16_t*)(RM + G_WN) + (size_t)item * 8192;
#pragma unroll
        for (int it = 0; it < 2; ++it) {
            bf16x8 tw[4];
#pragma unroll
            for (int s = 0; s < (it == 0 ? 2 : 4); ++s) { const LAS unsigned char* rowp = wl + (32 * it + r) * GA_USTR + (16 * s + 4 * hh) * 2;
                const u32x2 lo = *(const LAS u32x2*)rowp, hi = *(const LAS u32x2*)(rowp + 16); u32x4 o; o.x = lo.x; o.y = lo.y; o.z = hi.x; o.w = hi.y; tw[s] = __builtin_bit_cast(bf16x8, o); }
#pragma unroll
            for (int dt = 0; dt < 4; ++dt) {
                f32x16 c = {0.f, 0.f, 0.f, 0.f, 0.f, 0.f, 0.f, 0.f, 0.f, 0.f, 0.f, 0.f, 0.f, 0.f, 0.f, 0.f};
#pragma unroll
                for (int s = 0; s < (it == 0 ? 2 : 4); ++s) { const bf16x8 kt = *(const bf16x8*)((const unsigned char*)KTN + (unsigned)(lane * 16) + (dt * 4 + s) * 1024); c = MFMA32(kt, tw[s], c); }
#pragma unroll
                for (int q = 0; q < 16; ++q) c[q] = -c[q];
#pragma unroll
                for (int sp = 0; sp < 2; ++sp) *(bf16x8*)((unsigned char*)WN + (unsigned)(lane * 16) + (it * 8 + 2 * dt + sp) * 1024) = pack8(c, sp);
            }
        }
    }
    asm volatile("s_waitcnt lgkmcnt(0)" ::: "memory");
}

constexpr int GB_BUF = 58112;
__device__ __forceinline__ void gdn_b_scan(unsigned char* ws, LAS unsigned char* lds, const int bh, const int tid) {
    const int lane = tid & 63, wave = __builtin_amdgcn_readfirstlane(tid >> 6), r = lane & 31, hh = lane >> 5;
    unsigned char* RM = ws + WS_M;
    const int b = bh >> 3, h = bh & 7;
    const size_t item0 = (size_t)bh * 64;
    bf16_t* OO = (bf16_t*)(RM + G_OO);
    auto dma_chunk = [&](const size_t item, LAS unsigned char* buf) {
#pragma unroll
        for (int k = 0; k < 7; ++k) {
            const int pi = wave * 7 + k;
            const unsigned char* g;
            if (pi < 16) g = RM + G_WN + item * 16384 + (size_t)pi * 1024;
            else if (pi < 32) g = RM + G_QN + item * 16384 + (size_t)(pi - 16) * 1024;
            else if (pi < 40) g = RM + G_AN + item * 8192 + (size_t)(pi - 32) * 1024;
            else g = RM + G_KT + item * 16384 + (size_t)(pi - 40) * 1024;
            __builtin_amdgcn_global_load_lds((const unsigned*)(g + lane * 16), (LAS unsigned*)(buf + pi * 1024), 16, 0, 0);
        }
        if (wave >= 5) __builtin_amdgcn_global_load_lds((const unsigned*)(RM + G_EG + item * 768 + (size_t)(wave - 5) * 256 + lane * 4), (LAS unsigned*)(buf + 57344 + (wave - 5) * 256), 4, 0, 0);
    };
    f32x16 S[4];
#pragma unroll
    for (int dt = 0; dt < 4; ++dt)
#pragma unroll
        for (int q = 0; q < 16; ++q) S[dt][q] = 0.f;
    dma_chunk(item0, lds);
    bf16x8 Un[2][2];
    if (wave < 4) {
        const unsigned char* UN0 = RM + G_UN + item0 * 16384 + (size_t)wave * 4096 + lane * 16;
#pragma unroll
        for (int mt = 0; mt < 2; ++mt)
#pragma unroll
            for (int sp = 0; sp < 2; ++sp) Un[mt][sp] = *(const bf16x8*)(UN0 + (mt * 2 + sp) * 1024);
    }
    asm volatile("s_waitcnt vmcnt(0)" ::: "memory");
    __syncthreads();
#pragma unroll 1
    for (int n = 0; n < 64; ++n) {
        const size_t item = item0 + n;
        LAS unsigned char* buf = lds + (n & 1) * GB_BUF;
        f32x16 Vn[2], O[2];
        if (wave < 4) {
#pragma unroll
            for (int mt = 0; mt < 2; ++mt)
#pragma unroll
                for (int sp = 0; sp < 2; ++sp) { const u32x4 w = __builtin_bit_cast(u32x4, Un[mt][sp]);
                    Vn[mt][8 * sp + 0] = bflo(w.x); Vn[mt][8 * sp + 1] = bfhi(w.x); Vn[mt][8 * sp + 2] = bflo(w.y); Vn[mt][8 * sp + 3] = bfhi(w.y);
                    Vn[mt][8 * sp + 4] = bflo(w.z); Vn[mt][8 * sp + 5] = bfhi(w.z); Vn[mt][8 * sp + 6] = bflo(w.w); Vn[mt][8 * sp + 7] = bfhi(w.w); }
#pragma unroll
            for (int mt = 0; mt < 2; ++mt)
#pragma unroll
                for (int q = 0; q < 16; ++q) O[mt][q] = 0.f;
            if (n + 1 < 64) {
                const unsigned char* UN = RM + G_UN + (size_t)(item + 1) * 16384 + (size_t)wave * 4096 + lane * 16;
#pragma unroll
                for (int mt = 0; mt < 2; ++mt)
#pragma unroll
                    for (int sp = 0; sp < 2; ++sp) Un[mt][sp] = *(const bf16x8*)(UN + (mt * 2 + sp) * 1024);
            }
        }
        asm volatile("" ::: "memory");
        if (n + 1 < 64) dma_chunk(item + 1, lds + ((n + 1) & 1) * GB_BUF);
        asm volatile("" ::: "memory");
        if (wave < 4) {
            const int sl = wave;
            const LAS float* EGs = (const LAS float*)(buf + 57344);
            bf16x8 Sb[8];
#pragma unroll
            for (int dt = 0; dt < 4; ++dt) { Sb[2 * dt] = pack8(S[dt], 0); Sb[2 * dt + 1] = pack8(S[dt], 1); }
#pragma unroll
            for (int mt = 0; mt < 2; ++mt)
#pragma unroll
                for (int ks = 0; ks < 8; ++ks) {
                    const bf16x8 wf = *(const LAS bf16x8*)(buf + ((mt * 8 + ks) * 64 + lane) * 16);
                    const bf16x8 qf = *(const LAS bf16x8*)(buf + 16384 + ((mt * 8 + ks) * 64 + lane) * 16);
                    Vn[mt] = MFMA32(wf, Sb[ks], Vn[mt]);
                    O[mt] = MFMA32(qf, Sb[ks], O[mt]);
                }
#pragma unroll
            for (int mt = 0; mt < 2; ++mt)
#pragma unroll
                for (int g4 = 0; g4 < 4; ++g4) { const f32x4 E4 = *(const LAS f32x4*)(EGs + 32 * mt + 8 * g4 + 4 * hh);
#pragma unroll
                    for (int q = 0; q < 4; ++q) O[mt][4 * g4 + q] *= E4[q]; }
            bf16x8 Vb[4];
#pragma unroll
            for (int mt = 0; mt < 2; ++mt) { Vb[2 * mt] = pack8(Vn[mt], 0); Vb[2 * mt + 1] = pack8(Vn[mt], 1); }
#pragma unroll
            for (int mt = 0; mt < 2; ++mt)
#pragma unroll
                for (int ks = 0; ks < (mt == 0 ? 2 : 4); ++ks) {
                    const bf16x8 af = *(const LAS bf16x8*)(buf + 32768 + ((mt * 4 + ks) * 64 + lane) * 16);
                    O[mt] = MFMA32(af, Vb[ks], O[mt]);
                }
            {
                bf16_t* orow = OO + ((size_t)b * SEQ + (size_t)n * 64) * DM + h * 128 + sl * 32 + r;
#pragma unroll
                for (int mt = 0; mt < 2; ++mt)
#pragma unroll
                    for (int q = 0; q < 16; ++q) { const int pos = 32 * mt + (q & 3) + 8 * (q >> 2) + 4 * hh; orow[(size_t)pos * DM] = (bf16_t)f2bf(O[mt][q]); }
            }
#pragma unroll
            for (int mt = 0; mt < 2; ++mt)
#pragma unroll
                for (int g4 = 0; g4 < 4; ++g4) { const f32x4 L4 = *(const LAS f32x4*)(EGs + 64 + 32 * mt + 8 * g4 + 4 * hh);
#pragma unroll
                    for (int q = 0; q < 4; ++q) Vn[mt][4 * g4 + q] *= L4[q]; }
#pragma unroll
            for (int mt = 0; mt < 2; ++mt) { Vb[2 * mt] = pack8(Vn[mt], 0); Vb[2 * mt + 1] = pack8(Vn[mt], 1); }
            const float cd = EGs[128];
#pragma unroll
            for (int dt = 0; dt < 4; ++dt)
#pragma unroll
                for (int q = 0; q < 16; ++q) S[dt][q] *= cd;
#pragma unroll
            for (int ks = 0; ks < 4; ++ks)
#pragma unroll
                for (int dt = 0; dt < 4; ++dt) { const bf16x8 kt = *(const LAS bf16x8*)(buf + 40960 + ((dt * 4 + ks) * 64 + lane) * 16); S[dt] = MFMA32(kt, Vb[ks], S[dt]); }
            asm volatile("s_waitcnt vmcnt(32) lgkmcnt(0)" ::: "memory");
        } else {
            asm volatile("s_waitcnt vmcnt(0) lgkmcnt(0)" ::: "memory");
        }
        __syncthreads();
    }
}

constexpr int SW_KSTR = 144, SW_VSTR = 528, SW_K = 0, SW_V = 36864, SW_TB = 70656;
__device__ __forceinline__ void swa_phase(const CAS MArgs& a, unsigned char* ws, const int L, LAS unsigned char* lds, const int tid, const int bid, const int G) {
    const int lane = tid & 63, wave = __builtin_amdgcn_readfirstlane(tid >> 6), r = lane & 31, hh = lane >> 5;
    const bf16_t* PROJB = (const bf16_t*)(ws + WS_PROJ);
    bf16_t* SOB = (bf16_t*)(ws + WS_SO);
    LAS float* tb = (LAS float*)(lds + SW_TB);
    for (int idx = tid; idx < 2048; idx += 512) { const int hq = idx >> 7, dist = idx & 127; tb[idx] = a.in[I_RELB][t5_bucket(dist) * 16 + hq] * 1.4426950408889634f; }
    __syncthreads();
#pragma unroll 1
    for (int item = bid; item < NBATCH * 32 * 4; item += G) {
        const int kvh = item & 3, nb = (item >> 2) & 31, b = item >> 7;
        const size_t tq0 = (size_t)b * SEQ + (size_t)nb * 128;
        {
            const int key = tid >> 1, half = tid & 1;
            const bool exists = (nb > 0) || (key >= 128);
            u32x4 kv[4], vv[4];
#pragma unroll
            for (int i = 0; i < 4; ++i) { kv[i] = (u32x4){0u, 0u, 0u, 0u}; vv[i] = kv[i]; }
            if (exists) {
                const bf16_t* rowp = PROJB + (tq0 - 128 + key) * PROJ_COLS + kvh * 64 + half * 32;
#pragma unroll
                for (int i = 0; i < 4; ++i) { kv[i] = *(const u32x4*)(rowp + PJ_KC + 8 * i); vv[i] = *(const u32x4*)(rowp + PJ_VC + 8 * i); }
            }
#pragma unroll
            for (int i = 0; i < 4; ++i) *(LAS u32x4*)(lds + SW_K + key * SW_KSTR + half * 64 + 16 * i) = kv[i];
#pragma unroll
            for (int i = 0; i < 4; ++i) {
                const unsigned w4[4] = {vv[i].x, vv[i].y, vv[i].z, vv[i].w};
#pragma unroll
                for (int q = 0; q < 4; ++q) { const int d = half * 32 + 8 * i + 2 * q;
                    *(LAS unsigned short*)(lds + SW_V + d * SW_VSTR + key * 2) = (unsigned short)(w4[q] & 0xffffu);
                    *(LAS unsigned short*)(lds + SW_V + (d + 1) * SW_VSTR + key * 2) = (unsigned short)(w4[q] >> 16); }
            }
        }
        __syncthreads();
        {
            const int g = wave >> 1, qh = wave & 1, hq = kvh * 4 + g;
            const float sink2 = a.in[I_SINKS][L * 16 + hq] * 1.4426950408889634f;
#pragma unroll 1
            for (int qt = 0; qt < 2; ++qt) {
                const int i0 = 64 * qh + 32 * qt, kt0 = i0 >> 5;
                const size_t token = tq0 + i0 + r;
                bf16x8 qf[4];
#pragma unroll
                for (int s = 0; s < 4; ++s) qf[s] = *(const bf16x8*)(PROJB + token * PROJ_COLS + PJ_QC + hq * 64 + 16 * s + 8 * hh);
                f32x16 c[5];
#pragma unroll
                for (int k5 = 0; k5 < 5; ++k5) {
#pragma unroll
                    for (int q = 0; q < 16; ++q) c[k5][q] = 0.f;
#pragma unroll
                    for (int s = 0; s < 4; ++s) { const bf16x8 kf = *(const LAS bf16x8*)(lds + SW_K + (32 * (kt0 + k5) + r) * SW_KSTR + (16 * s + 8 * hh) * 2); c[k5] = MFMA32(kf, qf[s], c[k5]); }
                }
                float m = sink2;
#pragma unroll
                for (int k5 = 0; k5 < 5; ++k5)
#pragma unroll
                    for (int q = 0; q < 16; ++q) {
                        const int cr = (q & 3) + 8 * (q >> 2) + 4 * hh;
                        const int dist = 128 + r - 32 * k5 - cr;
                        bool valid = true;
                        if (k5 == 0) valid = dist <= 127;
                        if (k5 == 4) valid = dist >= 0;
                        if (nb == 0) valid = valid && (32 * (kt0 + k5) + cr >= 128);
                        const float sc = valid ? fmaf(c[k5][q], 0.125f * 1.4426950408889634f, tb[hq * 128 + (dist & 127)]) : -3.0e38f;
                        c[k5][q] = sc; m = fmaxf(m, sc);
                    }
                m = fmaxf(m, __shfl_xor(m, 32));
                float sum = 0.f;
#pragma unroll
                for (int k5 = 0; k5 < 5; ++k5)
#pragma unroll
                    for (int q = 0; q < 16; ++q) { const float p = __builtin_amdgcn_exp2f(c[k5][q] - m); c[k5][q] = p; sum += p; }
                sum += __shfl_xor(sum, 32);
                const float inv = 1.0f / (sum + __builtin_amdgcn_exp2f(sink2 - m));
                f32x16 o[2];
#pragma unroll
                for (int dt = 0; dt < 2; ++dt)
#pragma unroll
                    for (int q = 0; q < 16; ++q) o[dt][q] = 0.f;
#pragma unroll
                for (int k5 = 0; k5 < 5; ++k5)
#pragma unroll
                    for (int sp = 0; sp < 2; ++sp) {
                        const bf16x8 pf = pack8(c[k5], sp);
#pragma unroll
                        for (int dt = 0; dt < 2; ++dt) {
                            const LAS unsigned char* vp = lds + SW_V + (32 * dt + r) * SW_VSTR + (32 * (kt0 + k5) + 16 * sp + 4 * hh) * 2;
                            const u32x2 lo = *(const LAS u32x2*)vp, hi = *(const LAS u32x2*)(vp + 16);
                            u32x4 v4; v4.x = lo.x; v4.y = lo.y; v4.z = hi.x; v4.w = hi.y;
                            o[dt] = MFMA32(__builtin_bit_cast(bf16x8, v4), pf, o[dt]);
                        }
                    }
                bf16_t* orow = SOB + token * DM + hq * 64 + 4 * hh;
#pragma unroll
                for (int dt = 0; dt < 2; ++dt)
#pragma unroll
                    for (int g4 = 0; g4 < 4; ++g4) { u32x2 w; w.x = cvtpk(o[dt][4 * g4] * inv, o[dt][4 * g4 + 1] * inv); w.y = cvtpk(o[dt][4 * g4 + 2] * inv, o[dt][4 * g4 + 3] * inv);
                        *(u32x2*)(orow + 32 * dt + 8 * g4) = w; }
            }
        }
        __syncthreads();
    }
}

constexpr int LR_XSTR = 132;
constexpr int LR_X = 0, LR_W = 67584, LR_WSTR = 272, LR_AGG = 137216;
constexpr size_t LRM_AGG = 452 * MiB, LRM_CIN = 454 * MiB;
__device__ __forceinline__ void lru_l1(const CAS MArgs& a, unsigned char* ws, const int L, LAS unsigned char* lds, const int tid, const int bid, const int G) {
    const int lane = tid & 63, wave = __builtin_amdgcn_readfirstlane(tid >> 6), r = lane & 31, hh = lane >> 5;
    const bf16_t* PROJB = (const bf16_t*)(ws + WS_PROJ);
    unsigned char* RM = ws + WS_M;
    LAS float* xc = (LAS float*)(lds + LR_X);
    LAS float* agg = (LAS float*)(lds + LR_AGG);
    const int blk = bid & 7;
    int wblk = -1;
#pragma unroll 1
    for (int it = bid; it < NBATCH * 8 * 32; it += G) {
        const int ib = it & 7, bc = it >> 3, b = bc >> 5, chunk = bc & 31;
        const size_t t0 = (size_t)b * SEQ + (size_t)chunk * 128;
        if (ib != wblk) {
            const bf16_t* W = (const bf16_t*)(ws + WS_W + (size_t)L * WL_STRIDE + W_LRU) + (size_t)ib * 256 * 128;
            for (int i = tid; i < 256 * 16; i += 512) { const int n = i >> 4, seg = i & 15; *(LAS u32x4*)(lds + LR_W + n * LR_WSTR + seg * 16) = *(const u32x4*)(W + n * 128 + seg * 8); }
            wblk = ib;
        }
        {
            const int c2 = 2 * lane, tok0 = 16 * wave;
            const float* cw = a.in[I_RGCW] + (size_t)L * 4 * 1024 + ib * 128 + c2;
            const f32x2 w0 = *(const f32x2*)cw, w1 = *(const f32x2*)(cw + 1024), w2 = *(const f32x2*)(cw + 2048), w3 = *(const f32x2*)(cw + 3072);
            const f32x2 cb = *(const f32x2*)(a.in[I_RGCB] + L * 1024 + ib * 128 + c2);
            const bf16_t* src = PROJB + (t0 + tok0) * PROJ_COLS + PJ_XL + ib * 128 + c2;
            unsigned raw[19];
#pragma unroll
            for (int u = 0; u < 19; ++u) { const int tok = tok0 - 3 + u; raw[u] = (chunk * 128 + tok >= 0) ? *(const unsigned*)(src + (ptrdiff_t)(u - 3) * PROJ_COLS) : 0u; }
#pragma unroll
            for (int u = 0; u < 16; ++u) {
                float y0 = cb[0], y1 = cb[1];
                y0 = fmaf(w0[0], bflo(raw[u]), y0); y0 = fmaf(w1[0], bflo(raw[u + 1]), y0); y0 = fmaf(w2[0], bflo(raw[u + 2]), y0); y0 = fmaf(w3[0], bflo(raw[u + 3]), y0);
                y1 = fmaf(w0[1], bfhi(raw[u]), y1); y1 = fmaf(w1[1], bfhi(raw[u + 1]), y1); y1 = fmaf(w2[1], bfhi(raw[u + 2]), y1); y1 = fmaf(w3[1], bfhi(raw[u + 3]), y1);
                *(LAS f32x2*)(xc + (tok0 + u) * LR_XSTR + c2) = (f32x2){y0, y1};
            }
        }
        __syncthreads();
        const int mt = wave >> 1, ch0 = 64 * (wave & 1);
        f32x16 acc[4];
#pragma unroll
        for (int nt = 0; nt < 4; ++nt)
#pragma unroll
            for (int q = 0; q < 16; ++q) acc[nt][q] = 0.f;
#pragma unroll
        for (int s = 0; s < 8; ++s) {
            const LAS float* ap = xc + (32 * mt + r) * LR_XSTR + 16 * s + 8 * hh;
            const f32x4 x0 = *(const LAS f32x4*)ap, x1 = *(const LAS f32x4*)(ap + 4);
            u32x4 af; af.x = cvtpk(x0[0], x0[1]); af.y = cvtpk(x0[2], x0[3]); af.z = cvtpk(x1[0], x1[1]); af.w = cvtpk(x1[2], x1[3]);
#pragma unroll
            for (int nt = 0; nt < 4; ++nt) {
                const int n = (nt >> 1) * 128 + ch0 + 32 * (nt & 1) + r;
                const bf16x8 bfrag = *(const LAS bf16x8*)(lds + LR_W + n * LR_WSTR + (16 * s + 8 * hh) * 2);
                acc[nt] = MFMA32(__builtin_bit_cast(bf16x8, af), bfrag, acc[nt]);
            }
        }
        float hl[2][16], pc[2][16], Pt[2], Ht[2];
#pragma unroll
        for (int ct = 0; ct < 2; ++ct) {
            const int ch = ch0 + 32 * ct + r, cg = L * 1024 + ib * 128 + ch;
            const float ba = a.in[I_RGBA][cg], bx = a.in[I_RGBX][cg], sp = 8.0f * softplusf_(-a.in[I_RGLAM][cg]);
            float P4[4], H4[4];
#pragma unroll
            for (int g4 = 0; g4 < 4; ++g4) {
                float p = 1.f, h = 0.f;
#pragma unroll
                for (int q = 0; q < 4; ++q) {
                    const int tok = 32 * mt + 8 * g4 + 4 * hh + q;
                    const float rr = sigmoidf_(acc[ct][4 * g4 + q] + ba), ig = sigmoidf_(acc[2 + ct][4 * g4 + q] + bx);
                    const float av = fexp(-sp * rr);
                    const float uv = sqrtf(fmaxf(fmaf(-av, av, 1.0f), 0.f)) * ig * xc[tok * LR_XSTR + ch];
                    p *= av; h = fmaf(av, h, uv);
                    pc[ct][4 * g4 + q] = p; hl[ct][4 * g4 + q] = h;
                }
                P4[g4] = p; H4[g4] = h;
            }
            float c = 0.f, P = 1.f, cin[4], ppre[4];
#pragma unroll
            for (int g4 = 0; g4 < 4; ++g4) {
                const float oP = __shfl_xor(P4[g4], 32), oH = __shfl_xor(H4[g4], 32);
                const float eP = hh ? oP : P4[g4], eH = hh ? oH : H4[g4];
                const float dP = hh ? P4[g4] : oP, dH = hh ? H4[g4] : oH;
                const float c1 = fmaf(eP, c, eH), P1 = P * eP;
                cin[g4] = hh ? c1 : c; ppre[g4] = hh ? P1 : P;
                c = fmaf(dP, c1, dH); P = P1 * dP;
            }
#pragma unroll
            for (int g4 = 0; g4 < 4; ++g4)
#pragma unroll
                for (int q = 0; q < 4; ++q) { hl[ct][4 * g4 + q] = fmaf(pc[ct][4 * g4 + q], cin[g4], hl[ct][4 * g4 + q]); pc[ct][4 * g4 + q] *= ppre[g4]; }
            Pt[ct] = P; Ht[ct] = c;
            if (hh == 0) *(LAS f32x2*)(agg + (mt * 128 + ch) * 2) = (f32x2){P, c};
        }
        __syncthreads();
        bf16_t* HL = (bf16_t*)(ws + WS_XF); bf16_t* PC = (bf16_t*)(ws + WS_LO);
#pragma unroll
        for (int ct = 0; ct < 2; ++ct) {
            const int ch = ch0 + 32 * ct + r;
            float cT = 0.f, PT = 1.f;
            for (int m2 = 0; m2 < mt; ++m2) { const f32x2 ag = *(const LAS f32x2*)(agg + (m2 * 128 + ch) * 2); cT = fmaf(ag[0], cT, ag[1]); PT *= ag[0]; }
            if (mt == 3 && hh == 0) {
                const float ci = fmaf(Pt[ct], cT, Ht[ct]), Pi = PT * Pt[ct];
                *(f32x2*)((float*)(RM + LRM_AGG) + ((size_t)(b * 32 + chunk) * 1024 + ib * 128 + ch) * 2) = (f32x2){Pi, ci};
            }
            const size_t obase = (t0 + 32 * mt) * DM + ib * 128 + ch;
#pragma unroll
            for (int q16 = 0; q16 < 16; ++q16) {
                const int tok = (q16 & 3) + 8 * (q16 >> 2) + 4 * hh;
                HL[obase + (size_t)tok * DM] = (bf16_t)f2bf(fmaf(pc[ct][q16], cT, hl[ct][q16]));
                PC[obase + (size_t)tok * DM] = (bf16_t)f2bf(pc[ct][q16] * PT);
            }
        }
        __syncthreads();
    }
}

#define XB_TMO      128
#define XB_XCNT(j)  (256  + 64 * (j))
#define XB_XSUB(j)  (1280 + 64 * (j))
#define XB_XGEN(j)  (2304 + 64 * (j))
#define XB_TOP      3328
#define XB_TOPGEN   3392
#define XCD_BAR_WORDS 3456
#define XB_SPIN_CAP (1u << 18)
__device__ __forceinline__ unsigned xb_ld(unsigned* p)              { return __hip_atomic_load(p, __ATOMIC_RELAXED, __HIP_MEMORY_SCOPE_AGENT); }
__device__ __forceinline__ unsigned xb_add(unsigned* p, unsigned v) { return __hip_atomic_fetch_add(p, v, __ATOMIC_RELAXED, __HIP_MEMORY_SCOPE_AGENT); }
__device__ __forceinline__ unsigned xb_xcc_id() { return (unsigned)__builtin_amdgcn_s_getreg((3 << 11) | 20) & 0xFu; }
#define XB_SPIN(cond, bar) do { unsigned _sp = 0; while (cond) { __builtin_amdgcn_s_sleep(1); \
    if ((++_sp & 255u) == 0u) { if (xb_ld(&(bar)[XB_TMO])) break; if (_sp > XB_SPIN_CAP) { atomicAdd(&(bar)[XB_TMO], 1u); break; } } } } while (0)
struct XcdBarrier { unsigned* bar; unsigned x; volatile LAS unsigned* st; };
__device__ __forceinline__ XcdBarrier xcd_barrier_post(unsigned* bar, volatile LAS unsigned* st) {
    XcdBarrier b; b.bar = bar; b.x = xb_xcc_id(); b.st = st;
    if (threadIdx.x == 0) (void)xb_add(&bar[XB_XCNT(b.x)], 1u);
    return b;
}
__device__ __forceinline__ void xcd_barrier_complete(unsigned* bar, unsigned x, unsigned& nloc, unsigned& nx) {
    const unsigned G = gridDim.x * gridDim.y * gridDim.z;
    unsigned sum, cnt, mine, sp = 0u;
    for (;;) {
        sum = 0u; cnt = 0u; mine = 0u;
#pragma unroll
        for (unsigned j = 0; j < 16; ++j) { const unsigned c = xb_ld(&bar[XB_XCNT(j)]); sum += c; cnt += (c > 0u) ? 1u : 0u; mine = (j == x) ? c : mine; }
        if (sum == G) break;
        __builtin_amdgcn_s_sleep(1);
        if ((++sp & 255u) == 0u) { if (xb_ld(&bar[XB_TMO])) break; if (sp > XB_SPIN_CAP) { atomicAdd(&bar[XB_TMO], 1u); break; } }
    }
    nloc = mine > 0u ? mine : 1u; nx = cnt > 0u ? cnt : 1u;
}
__device__ __forceinline__ void xcd_barrier(const XcdBarrier& b) {
    asm volatile("s_waitcnt vmcnt(0)" ::: "memory");
    __syncthreads();
    if (threadIdx.x == 0) {
        unsigned* bar = b.bar;
        __builtin_amdgcn_s_waitcnt(0);
        unsigned nloc = b.st[0], nx = b.st[1];
        if (nloc == 0u) { xcd_barrier_complete(bar, b.x, nloc, nx); b.st[0] = nloc; b.st[1] = nx; }
        const unsigned old = xb_add(&bar[XB_XSUB(b.x)], 1u);
        const unsigned gen = old / nloc;
        if (old + 1u == (gen + 1u) * nloc) {
            __builtin_amdgcn_fence(__ATOMIC_RELEASE, "agent");
            asm volatile("s_waitcnt vmcnt(0)" ::: "memory");
            const unsigned og = xb_add(&bar[XB_TOP], 1u);
            const unsigned tg = og / nx;
            if (og + 1u == (tg + 1u) * nx) xb_add(&bar[XB_TOPGEN], 1u);
            else XB_SPIN(xb_ld(&bar[XB_TOPGEN]) == tg, bar);
            __builtin_amdgcn_fence(__ATOMIC_ACQUIRE, "agent");
            xb_add(&bar[XB_XGEN(b.x)], 1u);
            asm volatile("s_waitcnt vmcnt(0)" ::: "memory");
        } else {
            XB_SPIN(xb_ld(&bar[XB_XGEN(b.x)]) == gen, bar);
            __builtin_amdgcn_fence(__ATOMIC_ACQUIRE, "agent");
            asm volatile("s_waitcnt vmcnt(0)" ::: "memory");
        }
    }
    __syncthreads();
}


__device__ __forceinline__ int launder_s(int x) { asm volatile("" : "+s"(x)); return x; }
enum { K_INPROJ = 0, K_GDNPREP, K_GDNREC, K_GDNPOST, K_LRUCONV, K_LRUGATE, K_LRUSCAN, K_SWA, K_BRANCH, K_WOUT, K_LN1, K_SCATTER, K_MOE1, K_MOE2, K_LN2, K_PLEP, K_PLEG, K_LN3, NPL };
constexpr int NPHASES = 1 + DEPTH * NPL;

__global__ void __launch_bounds__(NWAVES * 64, 2) mega(MArgs a_raw) {
    extern __shared__ __attribute__((aligned(16))) unsigned char lds_raw[];
    LAS unsigned char* lds0 = (LAS unsigned char*)lds_raw;
    const int wave0 = __builtin_amdgcn_readfirstlane((int)threadIdx.x >> 6);
    volatile LAS unsigned* MISC = (volatile LAS unsigned*)(lds0 + LDS_MISC);
#define PH_PTRS(Lv) \
    const CAS MArgs* ap_ = (const CAS MArgs*)__builtin_amdgcn_kernarg_segment_ptr(); asm volatile("" : "+s"(ap_)); const CAS MArgs& a = *ap_; \
    unsigned char* ws = a.ws; int L = (Lv); unsigned z_ = 0u; int wave_ = wave0; unsigned ldsb_ = 0u; asm volatile("" : "+s"(ws), "+s"(L), "+s"(wave_), "+s"(ldsb_)); asm volatile("" : "+v"(z_)); \
    const int lane_ = (int)__builtin_amdgcn_mbcnt_hi(~0u, __builtin_amdgcn_mbcnt_lo(~0u, z_)); \
    LAS unsigned char* lds = lds0 + ldsb_; LAS int* tstart = (LAS int*)(lds + LDS_MISC + 256); (void)tstart; \
    int bid_ = blockIdx.x, G_ = gridDim.x; asm volatile("" : "+s"(bid_), "+s"(G_)); \
    const int lane = lane_, wave = wave_, tid = wave * 64 + lane, bid = bid_, G = G_, NGW = G_ * NWAVES, gw = bid * NWAVES + wave; (void)lane; (void)wave; (void)tid; (void)bid; (void)gw; (void)G; (void)NGW; \
    unsigned* ctl = (unsigned*)(ws + WS_CTL); (void)ctl; \
    bf16_t* XB = (bf16_t*)(ws + WS_XB); float* XF = (float*)(ws + WS_XF); bf16_t* PROJB = (bf16_t*)(ws + WS_PROJ); (void)XB; (void)XF; (void)PROJB; \
    bf16_t* GOB = (bf16_t*)(ws + WS_GO); bf16_t* LOB = (bf16_t*)(ws + WS_LO); bf16_t* SOB = (bf16_t*)(ws + WS_SO); (void)GOB; (void)LOB; (void)SOB; \
    unsigned char* RM = ws + WS_M; (void)RM; \
    float* AB = (float*)(ws + WS_AB); float* GG = (float*)(ws + WS_GG); float* BT = (float*)(ws + WS_BT); (void)AB; (void)GG; (void)BT; \
    float* GATES = (float*)(ws + WS_GATES); int* ES = (int*)(ws + WS_ES); int* LIST = (int*)(ws + WS_LIST); (void)GATES; (void)ES; (void)LIST; \
    unsigned char* wl = ws + WS_W + (size_t)L * WL_STRIDE; (void)wl; \
    unsigned* cnt = ctl + CW_CNT + 64 * L; (void)cnt;
    const int lo = a_raw.ph_lo, hi = a_raw.ph_hi;
#if !N_LAUNCH_PER_PHASE
    if (threadIdx.x < 4) MISC[threadIdx.x] = 0u;
    __syncthreads();
    XcdBarrier bar = xcd_barrier_post((unsigned*)(a_raw.ws + WS_CTL) + CW_BAR, MISC);
#ifndef BARDUP
#define BARDUP 1
#endif
#define GRID_BAR(ph) do { if ((ph) + 1 < hi) { for (int bi_ = 0; bi_ < BARDUP; ++bi_) xcd_barrier(bar); } } while (0)
#else
#define GRID_BAR(ph) do { } while (0)
#endif
#define IN(ph) (launder_s(lo) <= (ph) && (ph) < launder_s(hi))

    if (IN(0)) {
        for (int rep_ = 0; rep_ < ((DUPMASK >> 30) & 1) + 1; ++rep_) {
        PH_PTRS(0)
        LAS float* scr = (LAS float*)(lds + wave * 17408);
        for (int Lc = 0; Lc < DEPTH; ++Lc) {
            L = Lc; wl = ws + WS_W + (size_t)L * WL_STRIDE;
            transpose_seg<1>(a.in[I_WIN] + (size_t)L * DM * IN_COLS, DM, IN_COLS, PROJ_COLS, (bf16_t*)(wl + W_IN), scr, gw, NGW, lane);
            transpose_seg<0>(a.in[I_WOG] + (size_t)L * DM * DM, DM, DM, DM, (bf16_t*)(wl + W_O3), scr, gw, NGW, lane);
            transpose_seg<0>(a.in[I_WOL] + (size_t)L * DM * DM, DM, DM, DM, (bf16_t*)(wl + W_O3) + (size_t)DM * DM, scr, gw, NGW, lane);
            transpose_seg<0>(a.in[I_WOS] + (size_t)L * DM * DM, DM, DM, DM, (bf16_t*)(wl + W_O3) + (size_t)2 * DM * DM, scr, gw, NGW, lane);
            transpose_seg<0>(a.in[I_WOUT] + (size_t)L * DM * DM, DM, DM, DM, (bf16_t*)(wl + W_OUT), scr, gw, NGW, lane);
            transpose_seg<0>(a.in[I_PLEG] + (size_t)L * DM * DM, DM, DM, DM, (bf16_t*)(wl + W_PG), scr, gw, NGW, lane);
            transpose_seg<0>(a.in[I_PLEP] + (size_t)L * PLE_DIM * DM, PLE_DIM, DM, DM, (bf16_t*)(wl + W_PP), scr, gw, NGW, lane);
            for (int it = gw; it < NEXP * 512; it += NGW) { const int e = it >> 9;
                transpose_item_gu(a.in[I_WGU] + ((size_t)L * NEXP + e) * DM * 2048, (bf16_t*)(wl + W_GU) + (size_t)e * 2048 * DM, scr, it & 511, lane); }
            for (int it = gw; it < NEXP * 512; it += NGW) { const int e = it >> 9;
                transpose_item<0>(a.in[I_WDN] + ((size_t)L * NEXP + e) * DM * DM, DM, DM, DM, (bf16_t*)(wl + W_DN) + (size_t)e * DM * DM, scr, it & 511, lane); }
            for (int blk = 0; blk < 8; ++blk) {
                transpose_seg<0>(a.in[I_RGWA] + ((size_t)L * 8 + blk) * 128 * 128, 128, 128, 128, (bf16_t*)(wl + W_LRU) + (size_t)blk * 256 * 128, scr, gw, NGW, lane);
                transpose_seg<0>(a.in[I_RGWX] + ((size_t)L * 8 + blk) * 128 * 128, 128, 128, 128, (bf16_t*)(wl + W_LRU) + (size_t)blk * 256 * 128 + 128 * 128, scr, gw, NGW, lane);
            }
        }
        cvt_rows(a.in[I_P], (bf16_t*)(ws + WS_PB), (size_t)DEPTH * NTOK * PLE_DIM, G);
        __syncthreads();
        stage_smallw<4>(a.in[I_WIN], IN_COLS, OFF_A, lds, tid);
        __syncthreads();
        for (int t0 = gw * 4; t0 < NTOK; t0 += NGW * 4) {
            f32x4 vv[4][4];
#pragma unroll
            for (int u = 0; u < 4; ++u)
#pragma unroll
                for (int j = 0; j < 4; ++j) vv[u][j] = *(const f32x4*)(a.in[I_X] + (size_t)(t0 + u) * DM + 256 * j + 4 * lane);
#pragma unroll
            for (int u = 0; u < 4; ++u) { store_row(vv[u], nullptr, XB + (size_t)(t0 + u) * DM, lane); ab_project(vv[u], lds, AB + (size_t)(t0 + u) * 16, lane); }
        }
        }
        GRID_BAR(0);
    }

    for (int Lloop = 0; Lloop < DEPTH; ++Lloop) {
        const int pb = 1 + Lloop * NPL;

        if (IN(pb + K_INPROJ)) {
            for (int rep_ = 0; rep_ < NREP(K_INPROJ); ++rep_) {
            PH_PTRS(Lloop)
            pg8::DenseSched S{(const char*)XB, (const char*)(wl + W_IN), NTOK / 256, PROJ_COLS / 256, G, bid, DM};
            pg8::EpiBf16 E{PROJB, PROJ_COLS, nullptr, 0};
            pg8::gemm_phase<pg8::EpiBf16, pg8::DenseSched, true>(lds, DM, S, E, tid);
            }
            GRID_BAR(pb + K_INPROJ);
        }
        if (IN(pb + K_GDNPREP)) {
            for (int rep_ = 0; rep_ < NREP(K_GDNPREP); ++rep_) {
            PH_PTRS(Lloop)
            LAS unsigned char* wlds = lds + wave * GA_LDS;
#pragma unroll 1
            for (int it = gw; it < NBATCH * 8 * 64; it += NGW) {
                int ln = lane; unsigned char* wsi = ws; unsigned wli = (unsigned)(size_t)wlds; asm volatile("" : "+s"(wsi), "+s"(wli)); asm volatile("" : "+v"(ln));
                gdn_a_item(a, wsi, L, (LAS unsigned char*)(size_t)wli, it, ln, gw);
            }
            }
            GRID_BAR(pb + K_GDNPREP);
        }
        if (IN(pb + K_GDNREC)) {
            for (int rep_ = 0; rep_ < NREP(K_GDNREC); ++rep_) {
            PH_PTRS(Lloop)
            if (G > NBATCH * 8 + 8) {
                if (bid < NBATCH * 8) gdn_b_scan(ws, lds, bid, tid);
                else { swa_phase(a, ws, L, lds, tid, bid - NBATCH * 8, G - NBATCH * 8); __syncthreads(); lru_l1(a, ws, L, lds, tid, bid - NBATCH * 8, G - NBATCH * 8); }
            } else {
                for (int bh = bid; bh < NBATCH * 8; bh += G) { gdn_b_scan(ws, lds, bh, tid); __syncthreads(); }
                swa_phase(a, ws, L, lds, tid, bid, G); __syncthreads(); lru_l1(a, ws, L, lds, tid, bid, G);
            }
            }
            GRID_BAR(pb + K_GDNREC);
        }
        if (IN(pb + K_GDNPOST)) {
            for (int rep_ = 0; rep_ < NREP(K_GDNPOST); ++rep_) {
            PH_PTRS(Lloop)
            {
                const f32x2* AGG = (const f32x2*)(RM + LRM_AGG); float* CIN = (float*)(RM + LRM_CIN);
                for (int i = bid * 512 + tid; i < NBATCH * DM; i += G * 512) {
                    const int b = i >> 10, c = i & 1023;
                    float carry = 0.f;
#pragma unroll 8
                    for (int ch = 0; ch < 32; ++ch) { const size_t o = (size_t)(b * 32 + ch) * 1024 + c; const f32x2 ag = AGG[o]; CIN[o] = carry; carry = fmaf(ag[0], carry, ag[1]); }
                }
            }
            const bf16_t* OO = (const bf16_t*)(RM + G_OO);
            float nw[16];
            { const float* nwp = a.in[I_GNW] + L * 128 + (lane & 7) * 16;
#pragma unroll
              for (int q = 0; q < 4; ++q) { const f32x4 w4 = *(const f32x4*)(nwp + 4 * q); nw[4 * q] = w4[0]; nw[4 * q + 1] = w4[1]; nw[4 * q + 2] = w4[2]; nw[4 * q + 3] = w4[3]; } }
            for (int t0 = gw * 4; t0 < NTOK; t0 += NGW * 4) {
                u32x4 ov[4][2], zv[4][2];
#pragma unroll
                for (int u = 0; u < 4; ++u) { const size_t t = (size_t)(t0 + u);
                    ov[u][0] = *(const u32x4*)(OO + t * DM + 16 * lane); ov[u][1] = *(const u32x4*)(OO + t * DM + 16 * lane + 8);
                    zv[u][0] = *(const u32x4*)(PROJB + t * PROJ_COLS + PJ_Z + 16 * lane); zv[u][1] = *(const u32x4*)(PROJB + t * PROJ_COLS + PJ_Z + 16 * lane + 8); }
#pragma unroll
                for (int u = 0; u < 4; ++u) {
                    const unsigned ow[8] = {ov[u][0].x, ov[u][0].y, ov[u][0].z, ov[u][0].w, ov[u][1].x, ov[u][1].y, ov[u][1].z, ov[u][1].w};
                    const unsigned zw[8] = {zv[u][0].x, zv[u][0].y, zv[u][0].z, zv[u][0].w, zv[u][1].x, zv[u][1].y, zv[u][1].z, zv[u][1].w};
                    float ss = 0.f;
#pragma unroll
                    for (int q = 0; q < 8; ++q) { ss = fmaf(bflo(ow[q]), bflo(ow[q]), ss); ss = fmaf(bfhi(ow[q]), bfhi(ow[q]), ss); }
                    ss += __shfl_xor(ss, 1); ss += __shfl_xor(ss, 2); ss += __shfl_xor(ss, 4);
                    const float rr = rsqrtf(ss * (1.0f / 128.0f) + 1e-6f);
                    unsigned res[8];
#pragma unroll
                    for (int q = 0; q < 8; ++q) res[q] = pk2(bflo(ow[q]) * rr * nw[2 * q] * siluf_(bflo(zw[q])), bfhi(ow[q]) * rr * nw[2 * q + 1] * siluf_(bfhi(zw[q])));
                    bf16_t* gp = GOB + (size_t)(t0 + u) * DM + 16 * lane;
                    *(u32x4*)gp = (u32x4){res[0], res[1], res[2], res[3]}; *(u32x4*)(gp + 8) = (u32x4){res[4], res[5], res[6], res[7]};
                }
            }
            }
            GRID_BAR(pb + K_GDNPOST);
        }
        if (IN(pb + K_LRUSCAN)) {
            for (int rep_ = 0; rep_ < NREP(K_LRUSCAN); ++rep_) {
            PH_PTRS(Lloop)
            const bf16_t* HL = (const bf16_t*)(ws + WS_XF); const bf16_t* PC = (const bf16_t*)(ws + WS_LO); const float* CIN = (const float*)(RM + LRM_CIN);
            for (size_t i = (size_t)bid * 512 + tid; i < (size_t)NTOK * 128; i += (size_t)G * 512) {
                const size_t t = i >> 7; const int c8 = (int)(i & 127) * 8;
                const int b = (int)(t >> 12), chunk = (int)((t & (SEQ - 1)) >> 7);
                const u32x4 h4 = *(const u32x4*)(HL + t * DM + c8), p4 = *(const u32x4*)(PC + t * DM + c8), g4 = *(const u32x4*)(PROJB + t * PROJ_COLS + PJ_GL + c8);
                const float* cp = CIN + (size_t)(b * 32 + chunk) * 1024 + c8;
                const f32x4 c0 = *(const f32x4*)cp, c1 = *(const f32x4*)(cp + 4);
                const unsigned hw[4] = {h4.x, h4.y, h4.z, h4.w}, pw[4] = {p4.x, p4.y, p4.z, p4.w}, gw4[4] = {g4.x, g4.y, g4.z, g4.w};
                const float cc[8] = {c0[0], c0[1], c0[2], c0[3], c1[0], c1[1], c1[2], c1[3]};
                unsigned ow[4];
#pragma unroll
                for (int q = 0; q < 4; ++q) {
                    const float v0 = fmaf(bflo(pw[q]), cc[2 * q], bflo(hw[q])) * gelu_tanhf_(bflo(gw4[q]));
                    const float v1 = fmaf(bfhi(pw[q]), cc[2 * q + 1], bfhi(hw[q])) * gelu_tanhf_(bfhi(gw4[q]));
                    ow[q] = pk2(v0, v1);
                }
                *(u32x4*)(LOB + t * DM + c8) = (u32x4){ow[0], ow[1], ow[2], ow[3]};
            }
            }
            GRID_BAR(pb + K_LRUSCAN);
        }
        if (IN(pb + K_BRANCH)) {
            for (int rep_ = 0; rep_ < NREP(K_BRANCH); ++rep_) {
            PH_PTRS(Lloop)
            pg8::BranchSched S{(const char*)GOB, (const char*)LOB, (const char*)SOB, (const char*)(wl + W_O3), G, bid};
            pg8::EpiBranch E{(float*)(RM + M_MRG), (bf16_t*)(RM + M_MRGB), PROJB};
            pg8::gemm_phase<pg8::EpiBranch, pg8::BranchSched, true>(lds, DM, S, E, tid);
            }
            GRID_BAR(pb + K_BRANCH);
        }
        if (IN(pb + K_WOUT)) {
            for (int rep_ = 0; rep_ < NREP(K_WOUT); ++rep_) {
            PH_PTRS(Lloop)
            pg8::DenseSched S{(const char*)(RM + M_MRGB), (const char*)(wl + W_OUT), NTOK / 256, DM / 256, G, bid, DM};
            pg8::EpiBf16 E{(bf16_t*)(RM + M_YY), DM, nullptr, 0};
            pg8::gemm_phase<pg8::EpiBf16, pg8::DenseSched, true>(lds, DM, S, E, tid);
            }
            GRID_BAR(pb + K_WOUT);
        }
        if (IN(pb + K_LN1)) {
            for (int rep_ = 0; rep_ < NREP(K_LN1); ++rep_) {
            PH_PTRS(Lloop)
            const bf16_t* YY = (const bf16_t*)(RM + M_YY);
            stage_smallw<8>(a.in[I_RW] + (size_t)L * DM * NEXP, NEXP, 0, lds, tid);
            const float rbv = a.in[I_RB][L * NEXP + (lane >> 1)];
            __syncthreads();
            for (int t0 = gw * 4; t0 < NTOK; t0 += NGW * 4) {
                f32x4 vv[4][4];
#pragma unroll
                for (int u = 0; u < 4; ++u)
#pragma unroll
                    for (int j = 0; j < 4; ++j) vv[u][j] = ld_bf4(XB + (size_t)(t0 + u) * DM + 256 * j + 4 * lane) * ALPHA + ld_bf4(YY + (size_t)(t0 + u) * DM + 256 * j + 4 * lane);
#pragma unroll
                for (int u = 0; u < 4; ++u) {
                const int t = t0 + u; f32x4 (&v)[4] = vv[u];
                ln_inplace(v, a.in[I_LN1G] + L * DM, a.in[I_LN1B] + L * DM, lane);
                store_row(v, nullptr, XB + (size_t)t * DM, lane);
                float acc[NEXP];
                small_project<8>(v, lds, acc, lane);
                float mine = reduce_scatter32(acc, lane);
                mine = (lane & 1) ? -INFINITY : mine + rbv;
                float tv[4]; int ti[4];
#pragma unroll
                for (int k = 0; k < 4; ++k) {
                    const float mx = wave_max(mine);
                    const unsigned long long bal = __ballot(mine == mx);
                    const int idx = __ffsll((long long)bal) - 1;
                    tv[k] = mx; ti[k] = idx >> 1;
                    if (lane == idx) mine = -INFINITY;
                }
                if (lane == 0 && rep_ == 0) {
                    const float e1 = expf(tv[1] - tv[0]), e2 = expf(tv[2] - tv[0]), e3 = expf(tv[3] - tv[0]);
                    const float inv = 1.0f / (1.0f + e1 + e2 + e3);
                    *(f32x4*)(GATES + (size_t)t * 4) = (f32x4){inv, e1 * inv, e2 * inv, e3 * inv};
#pragma unroll
                    for (int k = 0; k < 4; ++k) { const int slot = (int)atomicAdd(&cnt[ti[k]], 1u); ES[t * 4 + k] = ti[k] | (slot << 5); LIST[(size_t)ti[k] * NTOK + slot] = t; }
                }
                }
            }
            }
            GRID_BAR(pb + K_LN1);
        }
        if (IN(pb + K_MOE1) || IN(pb + K_MOE2) || IN(pb + K_LN2)) {
            PH_PTRS(Lloop)
            __syncthreads();
            if (tid == 0) { int accu = 0; for (int e = 0; e < NEXP; ++e) { const int ce = (int)__hip_atomic_load(&cnt[e], __ATOMIC_RELAXED, __HIP_MEMORY_SCOPE_AGENT); tstart[e] = accu; tstart[64 + e] = ce; accu += (ce + 255) >> 8; } tstart[NEXP] = accu; }
            __syncthreads();
        }
        if (IN(pb + K_MOE1)) {
            for (int rep_ = 0; rep_ < NREP(K_MOE1); ++rep_) {
            PH_PTRS(Lloop)
            pg8::MoeGatherSched S{(const char*)XB, (const char*)(wl + W_GU), tstart, (size_t)2048 * DM * 2, 8, G, bid, (const char*)XB, LIST, tstart + 128, tstart + 64};
            pg8::EpiSwiglu E{(bf16_t*)(ws + WS_PROJ + PJ_H), a.in[I_BGU] + (size_t)L * NEXP * 2048};
            pg8::gemm_phase<pg8::EpiSwiglu, pg8::MoeGatherSched, true>(lds, DM, S, E, tid);
            }
            GRID_BAR(pb + K_MOE1);
        }
        if (IN(pb + K_MOE2)) {
            for (int rep_ = 0; rep_ < NREP(K_MOE2); ++rep_) {
            PH_PTRS(Lloop)
            pg8::MoeSched S{(const char*)(ws + WS_PROJ + PJ_H), (const char*)(wl + W_DN), tstart, (size_t)DM * DM * 2, 4, G, bid, nullptr, nullptr, nullptr, nullptr};
            pg8::EpiBf16 E{(bf16_t*)(ws + WS_PROJ + PJ_OB), DM, a.in[I_BDN] + (size_t)L * NEXP * DM, DM};
            pg8::gemm_phase<pg8::EpiBf16, pg8::MoeSched, true>(lds, DM, S, E, tid);
            {
                PH_PTRS(Lloop)
                pg8::DenseSched S2{(const char*)(ws + WS_PB) + (size_t)L * NTOK * PLE_DIM * 2, (const char*)(wl + W_PP), NTOK / 256, DM / 256, G, bid, PLE_DIM};
                pg8::EpiBf16 E2{(bf16_t*)(RM + M_PP), DM, nullptr, 0};
                pg8::gemm_phase<pg8::EpiBf16, pg8::DenseSched, true>(lds, PLE_DIM, S2, E2, tid);
            }
            }
            GRID_BAR(pb + K_MOE2);
        }
        if (IN(pb + K_LN2)) {
            for (int rep_ = 0; rep_ < NREP(K_LN2); ++rep_) {
            PH_PTRS(Lloop)
            const bf16_t* OB = (const bf16_t*)(ws + WS_PROJ + PJ_OB);
            for (int t0 = gw * 2; t0 < NTOK; t0 += NGW * 2) {
                f32x4 vv[2][4]; u32x2 yy[2][4][4]; f32x4 gk4[2];
#pragma unroll
                for (int u = 0; u < 2; ++u) {
                    const int t = t0 + u;
                    gk4[u] = *(const f32x4*)(GATES + (size_t)t * 4);
#pragma unroll
                    for (int k = 0; k < 4; ++k) { const int es = ES[t * 4 + k]; const size_t row = (size_t)tstart[es & 31] * 256 + (es >> 5);
#pragma unroll
                        for (int j = 0; j < 4; ++j) yy[u][k][j] = *(const u32x2*)(OB + row * DM + 256 * j + 4 * lane); }
#pragma unroll
                    for (int j = 0; j < 4; ++j) vv[u][j] = ld_bf4(XB + (size_t)t * DM + 256 * j + 4 * lane) * ALPHA;
                }
#pragma unroll
                for (int u = 0; u < 2; ++u) {
                    const int t = t0 + u; f32x4 (&v)[4] = vv[u];
#pragma unroll
                    for (int k = 0; k < 4; ++k)
#pragma unroll
                        for (int j = 0; j < 4; ++j) { const u32x2 y2 = yy[u][k][j]; v[j] += (f32x4){bflo(y2.x), bfhi(y2.x), bflo(y2.y), bfhi(y2.y)} * gk4[u][k]; }
                    ln_inplace(v, a.in[I_LN2G] + L * DM, a.in[I_LN2B] + L * DM, lane);
                    store_row(v, nullptr, XB + (size_t)t * DM, lane);
                }
            }
            }
            GRID_BAR(pb + K_LN2);
        }
        if (IN(pb + K_PLEG)) {
            for (int rep_ = 0; rep_ < NREP(K_PLEG); ++rep_) {
            PH_PTRS(Lloop)
            pg8::DenseSched S{(const char*)XB, (const char*)(wl + W_PG), NTOK / 256, DM / 256, G, bid, DM};
            pg8::EpiPle E{(bf16_t*)(RM + M_PLEO), (const bf16_t*)(RM + M_PP)};
            pg8::gemm_phase<pg8::EpiPle, pg8::DenseSched, true>(lds, DM, S, E, tid);
            }
            GRID_BAR(pb + K_PLEG);
        }
        if (IN(pb + K_LN3)) {
            for (int rep_ = 0; rep_ < NREP(K_LN3); ++rep_) {
            PH_PTRS(Lloop)
            const bf16_t* PLEO = (const bf16_t*)(RM + M_PLEO);
            if (L + 1 < DEPTH) { stage_smallw<4>(a.in[I_WIN] + (size_t)(L + 1) * DM * IN_COLS, IN_COLS, OFF_A, lds, tid); __syncthreads(); }
            for (int t0 = gw * 4; t0 < NTOK; t0 += NGW * 4) {
                f32x4 vv[4][4];
#pragma unroll
                for (int u = 0; u < 4; ++u)
#pragma unroll
                    for (int j = 0; j < 4; ++j) vv[u][j] = ld_bf4(XB + (size_t)(t0 + u) * DM + 256 * j + 4 * lane) * ALPHA + ld_bf4(PLEO + (size_t)(t0 + u) * DM + 256 * j + 4 * lane);
#pragma unroll
                for (int u = 0; u < 4; ++u) {
                    const int t = t0 + u; f32x4 (&v)[4] = vv[u];
                    ln_inplace(v, a.in[I_LN3G] + L * DM, a.in[I_LN3B] + L * DM, lane);
                    store_row(v, (L + 1 < DEPTH) ? nullptr : a.out + (size_t)t * DM, XB + (size_t)t * DM, lane);
                    if (L + 1 < DEPTH) ab_project(v, lds, AB + (size_t)t * 16, lane);
                }
            }
            }
            GRID_BAR(pb + K_LN3);
        }
    }
#undef IN
#undef GRID_BAR
}

extern "C" void kernel_launch(void* const* d_in, const int* in_sizes, int n_in, void* d_out, int out_size, void* d_ws, size_t ws_size, hipStream_t stream) {
    static int grid = 0;
    if (grid == 0) {
        int dev = 0, cus = 0;
        if (hipGetDevice(&dev) != hipSuccess || hipDeviceGetAttribute(&cus, hipDeviceAttributeMultiprocessorCount, dev) != hipSuccess) cus = 256;
        (void)hipFuncSetAttribute((const void*)mega, hipFuncAttributeMaxDynamicSharedMemorySize, LDS_BYTES);
        grid = cus > 0 ? cus : 256;
    }
    if (n_in < 34 || ws_size < WS_END) return;
    (void)in_sizes; (void)out_size;
    (void)hipMemsetAsync((char*)d_ws + WS_CTL, 0, 1 * MiB, stream);
    MArgs a; memset(&a, 0, sizeof a);
    for (int i = 0; i < 34; ++i) a.in[i] = (const float*)d_in[i];
    a.out = (float*)d_out; a.ws = (unsigned char*)d_ws;
#if N_LAUNCH_PER_PHASE
    unsigned char* ws = (unsigned char*)d_ws;
    for (int ph = 0; ph < NPHASES; ++ph) {
        const int L = (ph - 1) / NPL, k = (ph - 1) % NPL;
        a.ph_lo = ph; a.ph_hi = ph + 1; hipLaunchKernelGGL(mega, dim3(grid), dim3(NWAVES * 64), LDS_BYTES, stream, a);
    }
#else
    a.ph_lo = 0; a.ph_hi = NPHASES; hipLaunchKernelGGL(mega, dim3(grid), dim3(NWAVES * 64), LDS_BYTES, stream, a);
#endif
}
```

```cpp
#include <hip/hip_runtime.h>
#include <stdint.h>
#include <string.h>

#ifndef DUPMASK
#define DUPMASK 0u
#endif
#define NREP(k) ((int)((DUPMASK >> (k)) & 1u) + 1)
#ifndef PROBE_ON
#define PROBE_ON 0
#endif
#ifndef PROBE_A
#define PROBE_A 0
#endif
#ifndef PROBE_B
#define PROBE_B 1
#endif
#ifndef N_LAUNCH_PER_PHASE
#define N_LAUNCH_PER_PHASE 0
#endif

#define DM 1024
#define SEQ 4096
#define NBATCH 8
#define DEPTH 2
#define PLE_DIM 256
#define IN_COLS 10768
#define OFF_A 4096
#define NEXP 32
#define ALPHA 1.4142135623730951f
#define NTOK (NBATCH * SEQ)
#define PROJ_COLS 10752
#define PJ_Q 0
#define PJ_K 1024
#define PJ_V 2048
#define PJ_Z 3072
#define PJ_XL 4096
#define PJ_GL 5120
#define PJ_QC 6144
#define PJ_KC 7168
#define PJ_VC 7424
#define PJ_GATES 7680
#define MOE_ROWS (NTOK * 4 + NEXP * 256)

#define LAS __attribute__((address_space(3)))
#define CAS __attribute__((address_space(4)))
typedef unsigned short bf16_t;
typedef short bf16x8 __attribute__((ext_vector_type(8)));
typedef float f32x4 __attribute__((ext_vector_type(4)));
typedef float f32x2 __attribute__((ext_vector_type(2)));
typedef unsigned u32x4 __attribute__((ext_vector_type(4)));
typedef unsigned u32x2 __attribute__((ext_vector_type(2)));

__device__ __forceinline__ float fexp(float x) { return __builtin_amdgcn_exp2f(1.4426950408889634f * x); }
__device__ __forceinline__ float sigmoidf_(float x) { return __builtin_amdgcn_rcpf(1.0f + __builtin_amdgcn_exp2f(-1.4426950408889634f * x)); }
__device__ __forceinline__ float siluf_(float x) { return x * sigmoidf_(x); }
__device__ __forceinline__ float softplusf_(float x) { return fmaxf(x, 0.f) + log1pf(expf(-fabsf(x))); }
__device__ __forceinline__ float gelu_tanhf_(float x) {
    const float y = 0.7978845608028654f * (x + 0.044715f * x * x * x);
    return x * (1.0f - __builtin_amdgcn_rcpf(1.0f + __builtin_amdgcn_exp2f(2.8853900817779268f * y)));
}
__device__ __forceinline__ float wave_sum(float v) {
#pragma unroll
    for (int o = 32; o > 0; o >>= 1) v += __shfl_xor(v, o);
    return v;
}
__device__ __forceinline__ float wave_max(float v) {
#pragma unroll
    for (int o = 32; o > 0; o >>= 1) v = fmaxf(v, __shfl_xor(v, o));
    return v;
}
typedef __bf16 bf16x2_t __attribute__((ext_vector_type(2)));
__device__ __forceinline__ unsigned cvtpk(float lo, float hi) { const f32x2 v = {lo, hi}; const bf16x2_t b = __builtin_convertvector(v, bf16x2_t); return __builtin_bit_cast(unsigned, b); }
__device__ __forceinline__ unsigned f2bf(float f) { return cvtpk(f, f) & 0xffffu; }
__device__ __forceinline__ unsigned pk2(float lo, float hi) { return cvtpk(lo, hi); }
template <class T> __device__ __forceinline__ T* as_global(T* p) {
    __attribute__((address_space(1))) T* g = (__attribute__((address_space(1))) T*)p; asm volatile("" : "+s"(g)); return (T*)g; }
__device__ __forceinline__ float bf2f(unsigned short b) { return __builtin_bit_cast(float, ((unsigned)b) << 16); }
__device__ __forceinline__ float bflo(unsigned u) { return __builtin_bit_cast(float, u << 16); }
__device__ __forceinline__ float bfhi(unsigned u) { return __builtin_bit_cast(float, u & 0xffff0000u); }

namespace pg8 {
constexpr int BM = 256, BK = 64, HALF = 128, HTB = HALF * BK * 2, STAGE_BYTES = 8 * HTB, NXCD = 8, WGM = 8;
__host__ __device__ __forceinline__ int lds_byte(int r, int c) { const int st = (r >> 4) * 2 + (c >> 5), rr = r & 15, cc = c & 31, ob = rr * 64 + cc * 2; return st * 1024 + (ob ^ (((ob >> 9) & 1) << 5)); }
__host__ __device__ __forceinline__ void stage_rc(int b, int& R, int& C) { const int st = b / 1024, sb = b % 1024, swz = sb ^ (((sb >> 9) & 1) << 5); R = (st >> 1) * 16 + swz / 64; C = (st & 1) * 32 + (swz % 64) / 2; }
__host__ __device__ __forceinline__ int perm32(int rho) { const int n = rho >> 4, i = rho & 15; return 8 * (i >> 2) + 4 * n + (i & 3); }
__device__ __forceinline__ unsigned cvt_pk_bf16(float lo, float hi) { unsigned r; asm volatile("v_cvt_pk_bf16_f32 %0, %1, %2" : "=v"(r) : "v"(lo), "v"(hi)); return r; }

struct Unit { const char* A; const char* B; int row0, col0, e, aux; };

__device__ __forceinline__ bool static_tile(int i, int G, int c, int nM, int nN, int& pm, int& pn) {
    const int nwg = nM * nN; const long L = (long)i * G + c; if (L >= nwg) return false;
    int wgid = (int)L; { const int q = nwg / NXCD, r = nwg % NXCD, xcd = wgid % NXCD, off = wgid / NXCD; wgid = (xcd < r ? xcd * (q + 1) : r * (q + 1) + (xcd - r) * q) + off; }
    const int nig = WGM * nN, gid = wgid / nig, fm = gid * WGM, gsz = (nM - fm) < WGM ? (nM - fm) : WGM;
    pm = fm + ((wgid % nig) % gsz); pn = (wgid % nig) / gsz; return true;
}

template <class Epi, class Sched, bool ALIGN_EPI>
__device__ __forceinline__ void gemm_phase(LAS unsigned char* lds, const int K, const Sched& S, const Epi& E, const int tid) {
    const int wid = __builtin_amdgcn_readfirstlane(tid >> 6), lane = tid & 63, wr = wid >> 2, wc = wid & 3, fr = lane & 15, fq = lane >> 4;
    const int nt = K / BK;
    unsigned voffA[2], voffB[2];
    int gR[2]; unsigned gC[2];
#pragma unroll
    for (int i = 0; i < 2; ++i) { int R, C; stage_rc(tid * 16 + i * 8192, R, C); const int Rb = (R & ~31) + perm32(R & 31);
        voffA[i] = (unsigned)(R * K + C) * 2u; voffB[i] = (unsigned)(Rb * K + C) * 2u; gR[i] = R; gC[i] = (unsigned)C * 2u; }
    unsigned oc[2][2] = {{0u, 0u}, {0u, 0u}}, on[2][2] = {{0u, 0u}, {0u, 0u}};
    const size_t kstep = (size_t)(BK * 2);
    const size_t hstep = (size_t)HALF * K * 2;
    const unsigned ldsw = (unsigned)wid * 1024u;
    const int aoff = lds_byte(wr * 64 + fr, fq * 8), boff = lds_byte(wc * 32 + fr, fq * 8);
#define PG8_SA(b, h) (((b) * 2 + (h)) * HTB)
#define PG8_SB(b, h) ((4 + (b) * 2 + (h)) * HTB)
#define PG8_STAGE(bufoff, gbase, voff) do { _Pragma("unroll") for (int _i = 0; _i < 2; ++_i) \
        __builtin_amdgcn_global_load_lds((const unsigned*)((const char*)(gbase) + (voff)[_i]), (LAS unsigned*)(lds + (bufoff) + ldsw + _i * 8192), 16, 0, 0); } while (0)
#define PG8_STAGE_A(bufoff, dptr, koff, half, usenext) do { if constexpr (Sched::GATHER) { const char* _gb = S.Abase + (koff); \
        if (usenext) PG8_STAGE(bufoff, _gb, on[half]); else PG8_STAGE(bufoff, _gb, oc[half]); } else { PG8_STAGE(bufoff, (dptr) + (half) * hstep, voffA); } } while (0)
#define PG8_GOFF(dst, u, bufi) do { const int _cn = S.cntl[(u).e]; _Pragma("unroll") for (int _h = 0; _h < 2; ++_h) _Pragma("unroll") for (int _i = 0; _i < 2; ++_i) { \
        const int _r = _h * 128 + gR[_i]; const int _tok = ((u).aux + _r < _cn) ? S.tab[(bufi) * 256 + _r] : 0; dst[_h][_i] = (unsigned)_tok * (unsigned)(K * 2) + gC[_i]; } } while (0)
#define PG8_TABDMA(u, bufi) do { if (wid < 4) __builtin_amdgcn_global_load_lds((const unsigned*)(S.list + (size_t)(u).e * NTOK + (u).aux + wid * 64 + lane), (LAS unsigned*)(S.tab + (bufi) * 256 + wid * 64), 4, 0, 0); } while (0)
#define PG8_LDA(dst, b, h) do { _Pragma("unroll") for (int m = 0; m < 4; ++m) _Pragma("unroll") for (int k = 0; k < 2; ++k) dst[m][k] = *(const LAS bf16x8*)(lds + PG8_SA(b, h) + aoff + m * 2048 + k * 1024); } while (0)
#define PG8_LDB(dst, b, h) do { _Pragma("unroll") for (int n = 0; n < 2; ++n) _Pragma("unroll") for (int k = 0; k < 2; ++k) dst[n][k] = *(const LAS bf16x8*)(lds + PG8_SB(b, h) + boff + n * 2048 + k * 1024); } while (0)
#define PG8_MMA(ai, bj, At, Bt) do { __builtin_amdgcn_s_setprio(1); _Pragma("unroll") for (int m = 0; m < 4; ++m) _Pragma("unroll") for (int n = 0; n < 2; ++n) _Pragma("unroll") for (int k = 0; k < 2; ++k) \
        acc[ai][bj][m][n] = __builtin_amdgcn_mfma_f32_16x16x32_bf16(Bt[n][k], At[m][k], acc[ai][bj][m][n], 0, 0, 0); __builtin_amdgcn_s_setprio(0); } while (0)
#define PG8_WAIT_V(n) asm volatile("s_waitcnt vmcnt(" #n ")" ::: "memory")
#define PG8_WAIT_L(n) asm volatile("s_waitcnt lgkmcnt(" #n ")" ::: "memory")
#define PG8_BAR __builtin_amdgcn_s_barrier()
#define PG8_SCHED __builtin_amdgcn_sched_barrier(0)
    Unit cur, nxt; int ui = 0;
    if (!S.next(0, cur)) return;
    f32x4 acc[2][2][4][2];
#pragma unroll
    for (int a = 0; a < 2; ++a)
#pragma unroll
        for (int b = 0; b < 2; ++b)
#pragma unroll
            for (int m = 0; m < 4; ++m)
#pragma unroll
                for (int n = 0; n < 2; ++n) acc[a][b][m][n] = (f32x4){0.f, 0.f, 0.f, 0.f};
    bf16x8 At[4][2], B0[2][2], B1[2][2];
    const char* cA = cur.A; const char* cB = cur.B;
    if constexpr (Sched::GATHER) { PG8_TABDMA(cur, 0); PG8_WAIT_V(0); PG8_BAR; PG8_GOFF(oc, cur, 0); }
    PG8_STAGE(PG8_SB(0, 0), cB, voffB); PG8_STAGE(PG8_SB(0, 1), cB + hstep, voffB); PG8_STAGE_A(PG8_SA(0, 0), cA, 0, 0, false); PG8_STAGE_A(PG8_SA(0, 1), cA, 0, 1, false);
    if (wr == 1) PG8_BAR;
    PG8_WAIT_V(2); PG8_BAR;
    PG8_STAGE(PG8_SB(1, 0), cB + kstep, voffB); PG8_STAGE_A(PG8_SA(1, 0), cA + kstep, kstep, 0, false); PG8_STAGE(PG8_SB(1, 1), cB + hstep + kstep, voffB);
    PG8_WAIT_V(6); PG8_BAR;
    for (;;) {
        const bool has_next = S.next(ui + 1, nxt);
        const char* nA = has_next ? nxt.A : cA; const char* nB = has_next ? nxt.B : cB;
        if constexpr (Sched::GATHER) { if (has_next) PG8_TABDMA(nxt, (ui + 1) & 1); }
        for (int t = 0; t < nt; t += 2) {
            const bool last = (t == nt - 2);
            const char* a1 = cA + (size_t)(t + 1) * kstep;
            const char* a2 = last ? nA : cA + (size_t)(t + 2) * kstep; const char* b2 = last ? nB : cB + (size_t)(t + 2) * kstep;
            const char* a3 = a2 + kstep; const char* b3 = b2 + kstep;
            const size_t k2 = last ? 0 : (size_t)(t + 2) * kstep, k3 = k2 + kstep;
            const bool un = last && has_next;
            if constexpr (Sched::GATHER) { if (un) PG8_GOFF(on, nxt, (ui + 1) & 1); }
            PG8_LDB(B0, 0, 0); PG8_LDB(B1, 0, 1); PG8_SCHED; PG8_LDA(At, 0, 0); PG8_STAGE_A(PG8_SA(1, 1), a1, (size_t)(t + 1) * kstep, 1, false);
            PG8_WAIT_V(8); PG8_WAIT_L(0); PG8_BAR; PG8_MMA(0, 0, At, B0); PG8_MMA(0, 1, At, B1); PG8_BAR; PG8_SCHED;
            PG8_LDA(At, 0, 1); PG8_STAGE(PG8_SB(0, 0), b2, voffB); PG8_STAGE(PG8_SB(0, 1), b2 + hstep, voffB); PG8_STAGE_A(PG8_SA(0, 0), a2, k2, 0, un);
            PG8_WAIT_V(8); PG8_WAIT_L(0); PG8_BAR; PG8_MMA(1, 0, At, B0); PG8_MMA(1, 1, At, B1); PG8_BAR; PG8_SCHED;
            PG8_LDB(B0, 1, 0); PG8_LDB(B1, 1, 1); PG8_SCHED; PG8_LDA(At, 1, 0); PG8_STAGE_A(PG8_SA(0, 1), a2, k2, 1, un);
            PG8_WAIT_V(8); PG8_WAIT_L(0); PG8_BAR; PG8_MMA(0, 0, At, B0); PG8_MMA(0, 1, At, B1); PG8_BAR; PG8_SCHED;
            PG8_LDA(At, 1, 1); PG8_STAGE(PG8_SB(1, 0), b3, voffB); PG8_STAGE(PG8_SB(1, 1), b3 + hstep, voffB); PG8_STAGE_A(PG8_SA(1, 0), a3, k3, 0, un);
            PG8_WAIT_V(8); PG8_WAIT_L(0); PG8_BAR; PG8_MMA(1, 0, At, B0); PG8_MMA(1, 1, At, B1); PG8_BAR; PG8_SCHED;
        }
        if constexpr (ALIGN_EPI) { if (wr == 0) PG8_BAR; }
        E(acc, cur, wr, wc, fr, fq);
        if (!has_next) break;
#pragma unroll
        for (int a = 0; a < 2; ++a)
#pragma unroll
            for (int b = 0; b < 2; ++b)
#pragma unroll
                for (int m = 0; m < 4; ++m)
#pragma unroll
                    for (int n = 0; n < 2; ++n) acc[a][b][m][n] = (f32x4){0.f, 0.f, 0.f, 0.f};
        cur = nxt; cA = nA; cB = nB; ++ui;
        if constexpr (Sched::GATHER) { oc[0][0] = on[0][0]; oc[0][1] = on[0][1]; oc[1][0] = on[1][0]; oc[1][1] = on[1][1]; }
        if constexpr (ALIGN_EPI) { if (wr == 1) PG8_BAR; }
    }
    PG8_WAIT_V(0);
    if constexpr (!ALIGN_EPI) { if (wr == 0) PG8_BAR; }
    PG8_BAR;
#undef PG8_SA
#undef PG8_SB
#undef PG8_STAGE
#undef PG8_STAGE_A
#undef PG8_GOFF
#undef PG8_TABDMA
#undef PG8_LDA
#undef PG8_LDB
#undef PG8_MMA
#undef PG8_WAIT_V
#undef PG8_WAIT_L
#undef PG8_BAR
#undef PG8_SCHED
}

struct DenseSched {
    static constexpr bool GATHER = false;
    const char* A; const char* Bt; int nM, nN, G, c, K;
    const char* Abase = nullptr; const int* list = nullptr; const LAS int* tab = nullptr; const LAS int* cntl = nullptr;
    __device__ __forceinline__ bool next(int i, Unit& u) const {
        int pm, pn; if (!static_tile(i, G, c, nM, nN, pm, pn)) return false;
        u.row0 = pm * BM; u.col0 = pn * BM; u.e = 0; u.aux = 0; u.A = A + (size_t)pm * BM * K * 2; u.B = Bt + (size_t)pn * BM * K * 2; return true;
    }
};
struct BranchSched {
    static constexpr bool GATHER = false;
    const char* A0; const char* A1; const char* A2; const char* W3; int G, c;
    const char* Abase = nullptr; const int* list = nullptr; const LAS int* tab = nullptr; const LAS int* cntl = nullptr;
    __device__ __forceinline__ bool next(int i, Unit& u) const {
        const int br = i % 3; int pm, pn; if (!static_tile(i / 3, G, c, NTOK / BM, DM / BM, pm, pn)) return false;
        u.row0 = pm * BM; u.col0 = pn * BM; u.e = br; u.aux = 0;
        u.A = (br == 0 ? A0 : (br == 1 ? A1 : A2)) + (size_t)pm * BM * DM * 2; u.B = W3 + ((size_t)br * DM + (size_t)pn * BM) * DM * 2; return true;
    }
};
template <bool GATHER_>
struct MoeSchedT {
    static constexpr bool GATHER = GATHER_;
    const char* A; const char* W; const LAS int* tstart; size_t Wstride; int nN, G, c;
    const char* Abase; const int* list; const LAS int* tab; const LAS int* cntl;
    __device__ __forceinline__ bool next(int i, Unit& u) const {
        const int nM = tstart[NEXP]; int pm, pn; if (!static_tile(i, G, c, nM, nN, pm, pn)) return false;
        int e = 0;
#pragma unroll 1
        for (int j = 1; j < NEXP; ++j) e += (tstart[j] <= pm) ? 1 : 0;
        u.row0 = pm * BM; u.col0 = pn * BM; u.e = e; u.aux = (pm - tstart[e]) * BM;
        u.A = A + (size_t)pm * BM * DM * 2; u.B = W + (size_t)e * Wstride + (size_t)pn * BM * DM * 2; return true;
    }
};
typedef MoeSchedT<false> MoeSched;
typedef MoeSchedT<true> MoeGatherSched;

struct EpiBf16 {
    bf16_t* O; int ldc; const float* bias; int bstride;
    __device__ __forceinline__ void operator()(const f32x4 (&acc)[2][2][4][2], const Unit& u, int wr, int wc, int fr, int fq) const {
        const int row0 = u.row0 + wr * 64 + fr, col0 = u.col0 + wc * 32 + 8 * fq;
        f32x4 bv[2][2];
#pragma unroll
        for (int bj = 0; bj < 2; ++bj)
#pragma unroll
            for (int n = 0; n < 2; ++n) bv[bj][n] = bias ? *(const f32x4*)(bias + (size_t)u.e * bstride + col0 + bj * HALF + 4 * n) : (f32x4){0.f, 0.f, 0.f, 0.f};
#pragma unroll
        for (int ai = 0; ai < 2; ++ai)
#pragma unroll
            for (int m = 0; m < 4; ++m) { bf16_t* rowp = O + (size_t)(row0 + ai * HALF + m * 16) * ldc + col0;
#pragma unroll
                for (int bj = 0; bj < 2; ++bj) { const f32x4 v0 = acc[ai][bj][m][0] + bv[bj][0], v1 = acc[ai][bj][m][1] + bv[bj][1];
                    u32x4 w; w.x = cvt_pk_bf16(v0[0], v0[1]); w.y = cvt_pk_bf16(v0[2], v0[3]); w.z = cvt_pk_bf16(v1[0], v1[1]); w.w = cvt_pk_bf16(v1[2], v1[3]);
                    *(u32x4*)(rowp + bj * HALF) = w; } }
    }
};
struct EpiBranch {
    bf16_t* Y0; bf16_t* Y1; bf16_t* MRGB; const bf16_t* PROJB;
    __device__ __forceinline__ void operator()(const f32x4 (&acc)[2][2][4][2], const Unit& u, int wr, int wc, int fr, int fq) const {
        const int row0 = u.row0 + wr * 64 + fr, col0 = u.col0 + wc * 32 + 8 * fq, br = u.e;
        bf16_t* dst = br == 0 ? Y0 : (br == 1 ? Y1 : MRGB);
#pragma unroll
        for (int ai = 0; ai < 2; ++ai)
#pragma unroll
            for (int m = 0; m < 4; ++m) { const size_t row = (size_t)(row0 + ai * HALF + m * 16);
#pragma unroll
                for (int bj = 0; bj < 2; ++bj) { const int col = col0 + bj * HALF;
                    const u32x4 gl = *(const u32x4*)(PROJB + row * PROJ_COLS + PJ_GATES + br * DM + col);
                    f32x4 v0, v1;
                    v0[0] = sigmoidf_(bflo(gl.x)) * acc[ai][bj][m][0][0]; v0[1] = sigmoidf_(bfhi(gl.x)) * acc[ai][bj][m][0][1];
                    v0[2] = sigmoidf_(bflo(gl.y)) * acc[ai][bj][m][0][2]; v0[3] = sigmoidf_(bfhi(gl.y)) * acc[ai][bj][m][0][3];
                    v1[0] = sigmoidf_(bflo(gl.z)) * acc[ai][bj][m][1][0]; v1[1] = sigmoidf_(bfhi(gl.z)) * acc[ai][bj][m][1][1];
                    v1[2] = sigmoidf_(bflo(gl.w)) * acc[ai][bj][m][1][2]; v1[3] = sigmoidf_(bfhi(gl.w)) * acc[ai][bj][m][1][3];
                    if (br == 2) {
                        const u32x4 y0 = *(const u32x4*)(Y0 + row * DM + col), y1 = *(const u32x4*)(Y1 + row * DM + col);
                        v0[0] += bflo(y0.x) + bflo(y1.x); v0[1] += bfhi(y0.x) + bfhi(y1.x); v0[2] += bflo(y0.y) + bflo(y1.y); v0[3] += bfhi(y0.y) + bfhi(y1.y);
                        v1[0] += bflo(y0.z) + bflo(y1.z); v1[1] += bfhi(y0.z) + bfhi(y1.z); v1[2] += bflo(y0.w) + bflo(y1.w); v1[3] += bfhi(y0.w) + bfhi(y1.w);
                    }
                    u32x4 w; w.x = cvt_pk_bf16(v0[0], v0[1]); w.y = cvt_pk_bf16(v0[2], v0[3]); w.z = cvt_pk_bf16(v1[0], v1[1]); w.w = cvt_pk_bf16(v1[2], v1[3]);
                    *(u32x4*)(dst + row * DM + col) = w; } }
    }
};
struct EpiSwiglu {
    bf16_t* H; const float* b_gu;
    __device__ __forceinline__ void operator()(const f32x4 (&acc)[2][2][4][2], const Unit& u, int wr, int wc, int fr, int fq) const {
        const int row0 = u.row0 + wr * 64 + fr, jj0 = wc * 32 + 8 * fq, oc0 = (u.col0 >> 1) + jj0;
        const float* bp = b_gu + (size_t)u.e * 2048 + 2 * oc0;
        float bg[8], bl[8];
#pragma unroll
        for (int j = 0; j < 4; ++j) { const f32x4 b4 = *(const f32x4*)(bp + 4 * j); bg[2 * j] = b4[0]; bl[2 * j] = b4[1]; bg[2 * j + 1] = b4[2]; bl[2 * j + 1] = b4[3]; }
#pragma unroll
        for (int ai = 0; ai < 2; ++ai)
#pragma unroll
            for (int m = 0; m < 4; ++m) { const size_t row = (size_t)(row0 + ai * HALF + m * 16);
                float o[8];
#pragma unroll
                for (int n = 0; n < 2; ++n)
#pragma unroll
                    for (int j = 0; j < 4; ++j) {
                        const float gate = fminf(acc[ai][0][m][n][j] + bg[4 * n + j], 7.0f);
                        const float lin = fminf(fmaxf(acc[ai][1][m][n][j] + bl[4 * n + j], -7.0f), 7.0f);
                        o[4 * n + j] = gate * sigmoidf_(1.702f * gate) * (lin + 1.0f);
                    }
                u32x4 w; w.x = cvt_pk_bf16(o[0], o[1]); w.y = cvt_pk_bf16(o[2], o[3]); w.z = cvt_pk_bf16(o[4], o[5]); w.w = cvt_pk_bf16(o[6], o[7]);
                *(u32x4*)(H + row * DM + oc0) = w; }
    }
};
struct EpiPle {
    bf16_t* O; const bf16_t* PP;
    __device__ __forceinline__ void operator()(const f32x4 (&acc)[2][2][4][2], const Unit& u, int wr, int wc, int fr, int fq) const {
        const int row0 = u.row0 + wr * 64 + fr, col0 = u.col0 + wc * 32 + 8 * fq;
#pragma unroll
        for (int ai = 0; ai < 2; ++ai)
#pragma unroll
            for (int m = 0; m < 4; ++m) { const size_t row = (size_t)(row0 + ai * HALF + m * 16);
#pragma unroll
                for (int bj = 0; bj < 2; ++bj) { const int col = col0 + bj * HALF;
                    const u32x4 pp = *(const u32x4*)(PP + row * DM + col);
                    const f32x4 a0 = acc[ai][bj][m][0], a1 = acc[ai][bj][m][1];
                    u32x4 w;
                    w.x = cvt_pk_bf16(sigmoidf_(a0[0]) * bflo(pp.x), sigmoidf_(a0[1]) * bfhi(pp.x));
                    w.y = cvt_pk_bf16(sigmoidf_(a0[2]) * bflo(pp.y), sigmoidf_(a0[3]) * bfhi(pp.y));
                    w.z = cvt_pk_bf16(sigmoidf_(a1[0]) * bflo(pp.z), sigmoidf_(a1[1]) * bfhi(pp.z));
                    w.w = cvt_pk_bf16(sigmoidf_(a1[2]) * bflo(pp.w), sigmoidf_(a1[3]) * bfhi(pp.w));
                    *(u32x4*)(O + row * DM + col) = w; } }
    }
};
}

constexpr int NWAVES = 8;
constexpr int LDS_BYTES = 163840;
constexpr int LDS_MISC = 155648;
constexpr size_t MiB = 1u << 20;
constexpr size_t WS_CTL = 0;
constexpr size_t WS_W = 1 * MiB, WL_STRIDE = 224 * MiB;
constexpr size_t W_IN = 0, W_O3 = 21 * MiB, W_OUT = 27 * MiB, W_GU = 29 * MiB, W_DN = 157 * MiB, W_PG = 221 * MiB, W_PP = 223 * MiB, W_LRU = 223 * MiB + 512 * 1024;
constexpr size_t WS_PB = WS_W + 2 * WL_STRIDE;
constexpr size_t WS_XB = WS_PB + 32 * MiB;
constexpr size_t WS_XF = WS_XB + 64 * MiB;
constexpr size_t WS_PROJ = WS_XF + 128 * MiB;
constexpr size_t WS_GO = WS_PROJ + 672 * MiB, WS_LO = WS_GO + 64 * MiB, WS_SO = WS_LO + 64 * MiB;
constexpr size_t WS_M = WS_SO + 64 * MiB;
constexpr size_t WS_SMALL = WS_M + 496 * MiB;
constexpr size_t WS_AB = WS_SMALL, WS_GG = WS_AB + 2 * MiB, WS_BT = WS_GG + 1 * MiB, WS_GATES = WS_BT + 1 * MiB, WS_ES = WS_GATES + MiB / 2, WS_LIST = WS_ES + MiB / 2;
constexpr size_t WS_END = WS_LIST + 4 * MiB;
static_assert(WS_END <= 2048 * MiB, "workspace map must fit 2 GiB");
constexpr size_t M_QN = 0, M_KN = 64 * MiB, M_VV = 128 * MiB, M_OO = 192 * MiB;
constexpr size_t M_XC = 0, M_LA = 128 * MiB, M_LU = 256 * MiB;
constexpr size_t M_MRG = 0, M_MRGB = 128 * MiB, M_YY = 192 * MiB;
constexpr size_t M_XS = 0;
constexpr size_t M_PP = 0, M_PLEO = 64 * MiB;
constexpr size_t PJ_H = 0, PJ_OB = 272 * MiB;
constexpr int CW_CNT = 8192;
constexpr int CW_BAR = 4096;
constexpr int CW_TS = 16384;

struct MArgs { const float* in[34]; float* out; unsigned char* ws; int ph_lo, ph_hi; };
enum { I_X = 0, I_P, I_WIN, I_CONVQKV, I_ALOG, I_DTB, I_GNW, I_RGCW, I_RGCB, I_RGWA, I_RGBA, I_RGWX, I_RGBX, I_RGLAM, I_SINKS, I_RELB, I_WOG, I_WOL, I_WOS, I_WOUT,
       I_LN1G, I_LN1B, I_RW, I_RB, I_WGU, I_BGU, I_WDN, I_BDN, I_LN2G, I_LN2B, I_PLEG, I_PLEP, I_LN3G, I_LN3B };

template <int MAP>
__device__ __forceinline__ int src_col(int n) {
    if (MAP == 1) return n < 4096 ? n : n + 16;
    if (MAP == 2) { const int pn = n >> 8, half = (n >> 7) & 1, jj = n & 127; return 2 * (pn * 128 + jj) + half; }
    return n;
}
template <int MAP>
__device__ __forceinline__ void transpose_item(const float* W, int K, int ldw, int Nout, bf16_t* WT, LAS float* scr, int item, int lane) {
    const int nblk = Nout / 32, kb = item / nblk, nb = item % nblk, k0 = 64 * kb, n0 = 32 * nb;
    const int sc = src_col<MAP>(n0 + (lane & 31));
    float tmpv[32];
#pragma unroll
    for (int i = 0; i < 32; ++i) tmpv[i] = W[(size_t)(k0 + 2 * i + (lane >> 5)) * ldw + sc];
#pragma unroll
    for (int i = 0; i < 32; ++i) scr[(2 * i + (lane >> 5)) * 33 + (lane & 31)] = tmpv[i];
    asm volatile("s_waitcnt lgkmcnt(0)" ::: "memory");
    const int c = lane & 7;
#pragma unroll
    for (int j = 0; j < 4; ++j) { const int n = (lane >> 3) + 8 * j; const LAS float* s = scr + (8 * c) * 33 + n;
        u32x4 o; o.x = pk2(s[0 * 33], s[1 * 33]); o.y = pk2(s[2 * 33], s[3 * 33]); o.z = pk2(s[4 * 33], s[5 * 33]); o.w = pk2(s[6 * 33], s[7 * 33]);
        *(u32x4*)(WT + (size_t)(n0 + n) * K + k0 + 8 * c) = o; }
    asm volatile("s_waitcnt lgkmcnt(0)" ::: "memory");
}
__device__ __forceinline__ void transpose_item_gu(const float* W, bf16_t* WT, LAS float* scr, int item, int lane) {
    const int kb = item >> 5, jb = item & 31, k0 = 64 * kb, j0 = 32 * jb;
    f32x2 tmpv[32];
#pragma unroll
    for (int i = 0; i < 32; ++i) tmpv[i] = *(const f32x2*)(W + (size_t)(k0 + 2 * i + (lane >> 5)) * 2048 + 2 * (j0 + (lane & 31)));
#pragma unroll
    for (int i = 0; i < 32; ++i) *(LAS f32x2*)(scr + (2 * i + (lane >> 5)) * 66 + 2 * (lane & 31)) = tmpv[i];
    asm volatile("s_waitcnt lgkmcnt(0)" ::: "memory");
    const int c = lane & 7;
#pragma unroll
    for (int half = 0; half < 2; ++half)
#pragma unroll
        for (int jq = 0; jq < 4; ++jq) { const int nl = (lane >> 3) + 8 * jq, j = j0 + nl, n = (j >> 7) * 256 + half * 128 + (j & 127);
            const LAS float* s = scr + (8 * c) * 66 + 2 * nl + half;
            u32x4 o; o.x = pk2(s[0 * 66], s[1 * 66]); o.y = pk2(s[2 * 66], s[3 * 66]); o.z = pk2(s[4 * 66], s[5 * 66]); o.w = pk2(s[6 * 66], s[7 * 66]);
            *(u32x4*)(WT + (size_t)n * 1024 + k0 + 8 * c) = o; }
    asm volatile("s_waitcnt lgkmcnt(0)" ::: "memory");
}
template <int MAP>
__device__ __forceinline__ void transpose_seg(const float* W, int K, int ldw, int Nout, bf16_t* WT, LAS float* scr, int gw, int NGW, int lane) {
    const int nitems = (K / 64) * (Nout / 32);
    for (int it = gw; it < nitems; it += NGW) transpose_item<MAP>(W, K, ldw, Nout, WT, scr, it, lane);
}
__device__ __forceinline__ void cvt_rows(const float* src, bf16_t* dst, size_t n, int G) {
    for (size_t i = (size_t)blockIdx.x * 512 + threadIdx.x; i < n / 8; i += (size_t)G * 512) {
        const f32x4 v0 = *(const f32x4*)(src + i * 8), v1 = *(const f32x4*)(src + i * 8 + 4);
        u32x4 o; o.x = pk2(v0[0], v0[1]); o.y = pk2(v0[2], v0[3]); o.z = pk2(v1[0], v1[1]); o.w = pk2(v1[2], v1[3]);
        *(u32x4*)(dst + i * 8) = o;
    }
}
template <int NE4>
__device__ __forceinline__ void stage_smallw(const float* W, int ld, int col0, LAS unsigned char* dst, int tid) {
    for (int i = tid; i < 1024 * NE4; i += 512) { const int k = i / NE4, e4 = i % NE4; const int m = (k >> 8) * 4 + (k & 3), ln = (k & 255) >> 2;
        *(LAS f32x4*)(dst + ((e4 * 16 + m) * 64 + ln) * 16) = *(const f32x4*)(W + (size_t)k * ld + col0 + 4 * e4); }
}
template <int NE4>
__device__ __forceinline__ void small_project(const f32x4 (&v)[4], const LAS unsigned char* wsm, float (&acc)[4 * NE4], int lane) {
#pragma unroll
    for (int e = 0; e < 4 * NE4; ++e) acc[e] = 0.f;
#pragma unroll
    for (int j = 0; j < 4; ++j)
#pragma unroll
        for (int q = 0; q < 4; ++q) { const float xv = v[j][q];
#pragma unroll
            for (int e4 = 0; e4 < NE4; ++e4) { const f32x4 w4 = *(const LAS f32x4*)(wsm + ((e4 * 16 + 4 * j + q) * 64 + lane) * 16);
                acc[4 * e4 + 0] = fmaf(xv, w4[0], acc[4 * e4 + 0]); acc[4 * e4 + 1] = fmaf(xv, w4[1], acc[4 * e4 + 1]);
                acc[4 * e4 + 2] = fmaf(xv, w4[2], acc[4 * e4 + 2]); acc[4 * e4 + 3] = fmaf(xv, w4[3], acc[4 * e4 + 3]); } }
}
template <int NE4>
__device__ __forceinline__ void small_project2(const f32x4 (&v0)[4], const f32x4 (&v1)[4], const LAS unsigned char* wsm, float (&acc0)[4 * NE4], float (&acc1)[4 * NE4], int lane) {
#pragma unroll
    for (int e = 0; e < 4 * NE4; ++e) { acc0[e] = 0.f; acc1[e] = 0.f; }
#pragma unroll
    for (int j = 0; j < 4; ++j)
#pragma unroll
        for (int q = 0; q < 4; ++q) { const float x0 = v0[j][q], x1 = v1[j][q];
#pragma unroll
            for (int e4 = 0; e4 < NE4; ++e4) { const f32x4 w4 = *(const LAS f32x4*)(wsm + ((e4 * 16 + 4 * j + q) * 64 + lane) * 16);
#pragma unroll
                for (int c = 0; c < 4; ++c) { acc0[4 * e4 + c] = fmaf(x0, w4[c], acc0[4 * e4 + c]); acc1[4 * e4 + c] = fmaf(x1, w4[c], acc1[4 * e4 + c]); } } }
}
__device__ __forceinline__ float reduce_scatter32(const float (&acc)[32], int lane) {
    float a16[16], a8[8], a4[4], a2[2];
    const bool b5 = lane & 32, b4 = lane & 16, b3 = lane & 8, b2 = lane & 4, b1 = lane & 2;
#pragma unroll
    for (int i = 0; i < 16; ++i) { const float keep = b5 ? acc[i + 16] : acc[i], give = b5 ? acc[i] : acc[i + 16]; a16[i] = keep + __shfl_xor(give, 32); }
#pragma unroll
    for (int i = 0; i < 8; ++i) { const float keep = b4 ? a16[i + 8] : a16[i], give = b4 ? a16[i] : a16[i + 8]; a8[i] = keep + __shfl_xor(give, 16); }
#pragma unroll
    for (int i = 0; i < 4; ++i) { const float keep = b3 ? a8[i + 4] : a8[i], give = b3 ? a8[i] : a8[i + 4]; a4[i] = keep + __shfl_xor(give, 8); }
#pragma unroll
    for (int i = 0; i < 2; ++i) { const float keep = b2 ? a4[i + 2] : a4[i], give = b2 ? a4[i] : a4[i + 2]; a2[i] = keep + __shfl_xor(give, 4); }
    const float keep = b1 ? a2[1] : a2[0], give = b1 ? a2[0] : a2[1];
    float v = keep + __shfl_xor(give, 2);
    v += __shfl_xor(v, 1);
    return v;
}
__device__ __forceinline__ float reduce_scatter16(const float (&acc)[16], int lane) {
    float a8[8], a4[4], a2[2];
    const bool b5 = lane & 32, b4 = lane & 16, b3 = lane & 8, b2 = lane & 4;
#pragma unroll
    for (int i = 0; i < 8; ++i) { const float keep = b5 ? acc[i + 8] : acc[i], give = b5 ? acc[i] : acc[i + 8]; a8[i] = keep + __shfl_xor(give, 32); }
#pragma unroll
    for (int i = 0; i < 4; ++i) { const float keep = b4 ? a8[i + 4] : a8[i], give = b4 ? a8[i] : a8[i + 4]; a4[i] = keep + __shfl_xor(give, 16); }
#pragma unroll
    for (int i = 0; i < 2; ++i) { const float keep = b3 ? a4[i + 2] : a4[i], give = b3 ? a4[i] : a4[i + 2]; a2[i] = keep + __shfl_xor(give, 8); }
    const float keep = b2 ? a2[1] : a2[0], give = b2 ? a2[0] : a2[1];
    float v = keep + __shfl_xor(give, 4);
    v += __shfl_xor(v, 2); v += __shfl_xor(v, 1);
    return v;
}
__device__ __forceinline__ void ab_project(const f32x4 (&v)[4], const LAS unsigned char* wsm, float* ABrow, int lane, unsigned& dep) {
    float acc[16];
    small_project<4>(v, wsm + dep, acc, lane);
    const float s = reduce_scatter16(acc, lane);
    if ((lane & 3) == 0) ABrow[lane >> 2] = s;
    asm volatile("" : "+v"(dep) : "v"(s));
}
template <int NE4>
__device__ __forceinline__ void small_project4(const f32x4 (&vv)[4][4], const LAS unsigned char* wsm, float (&acc)[4][4 * NE4], int lane) {
#pragma unroll
    for (int u = 0; u < 4; ++u)
#pragma unroll
        for (int e = 0; e < 4 * NE4; ++e) acc[u][e] = 0.f;
    unsigned tok = 0u;
#pragma unroll
    for (int j = 0; j < 4; ++j)
#pragma unroll
        for (int q = 0; q < 4; ++q) {
            const LAS unsigned char* wp = wsm + tok;
#pragma unroll
            for (int e4 = 0; e4 < NE4; ++e4) { const f32x4 w4 = *(const LAS f32x4*)(wp + ((e4 * 16 + 4 * j + q) * 64 + lane) * 16);
#pragma unroll
                for (int c = 0; c < 4; ++c)
#pragma unroll
                    for (int u = 0; u < 4; ++u) acc[u][4 * e4 + c] = fmaf(vv[u][j][q], w4[c], acc[u][4 * e4 + c]); }
            asm volatile("" : "+v"(tok) : "v"(acc[0][0]));
        }
}
__device__ __forceinline__ void ab_project4(const f32x4 (&vv)[4][4], const LAS unsigned char* wsm, float* ABrow0, int lane, unsigned& dep) {
    float acc[4][16];
    small_project4<4>(vv, wsm + dep, acc, lane);
    float s[4];
#pragma unroll
    for (int u = 0; u < 4; ++u) s[u] = reduce_scatter16(acc[u], lane);
    if ((lane & 3) == 0) {
#pragma unroll
        for (int u = 0; u < 4; ++u) ABrow0[u * 16 + (lane >> 2)] = s[u];
    }
    asm volatile("" : "+v"(dep) : "v"(s[3]));
}
__device__ __forceinline__ void ln_inplace(f32x4 (&v)[4], const float* g, const float* b, int lane) {
    float s = 0.f;
#pragma unroll
    for (int j = 0; j < 4; ++j) s += (v[j][0] + v[j][1]) + (v[j][2] + v[j][3]);
    const float mu = wave_sum(s) * (1.0f / DM);
    float s2 = 0.f;
#pragma unroll
    for (int j = 0; j < 4; ++j) { v[j] = v[j] - mu; s2 += (v[j][0] * v[j][0] + v[j][1] * v[j][1]) + (v[j][2] * v[j][2] + v[j][3] * v[j][3]); }
    const float rstd = rsqrtf(wave_sum(s2) * (1.0f / DM) + 1e-5f);
#pragma unroll
    for (int j = 0; j < 4; ++j) { const f32x4 g4 = *(const f32x4*)(g + 256 * j + 4 * lane), b4 = *(const f32x4*)(b + 256 * j + 4 * lane); v[j] = v[j] * rstd * g4 + b4; }
}
__device__ __forceinline__ void store_row(const f32x4 (&v)[4], float* xf, bf16_t* xb, int lane) {
#pragma unroll
    for (int j = 0; j < 4; ++j) { if (xf) *(f32x4*)(xf + 256 * j + 4 * lane) = v[j];
        u32x2 o; o.x = pk2(v[j][0], v[j][1]); o.y = pk2(v[j][2], v[j][3]); *(u32x2*)(xb + 256 * j + 4 * lane) = o; }
}
__device__ __forceinline__ f32x4 ld_bf4(const bf16_t* p) { const u32x2 y2 = *(const u32x2*)p; return (f32x4){bflo(y2.x), bfhi(y2.x), bflo(y2.y), bfhi(y2.y)}; }
__device__ __forceinline__ int t5_bucket(int dist) {
    if (dist < 16) return dist;
    int l = 16 + (int)(logf((float)dist / 16.0f) / logf(8.0f) * 16.0f);
    return l < 31 ? l : 31;
}


typedef float f32x16 __attribute__((ext_vector_type(16)));
__device__ __forceinline__ bf16x8 pack8(const f32x16& c, const int s) {
    u32x4 p; p.x = cvtpk(c[8 * s + 0], c[8 * s + 1]); p.y = cvtpk(c[8 * s + 2], c[8 * s + 3]); p.z = cvtpk(c[8 * s + 4], c[8 * s + 5]); p.w = cvtpk(c[8 * s + 6], c[8 * s + 7]);
    return __builtin_bit_cast(bf16x8, p);
}
#define MFMA32(a, b, c) __builtin_amdgcn_mfma_f32_32x32x16_bf16((a), (b), (c), 0, 0, 0)
constexpr size_t G_WN = 0, G_QN = 64 * MiB, G_AN = 128 * MiB, G_KT = 160 * MiB, G_UN = 224 * MiB, G_GC = 352 * MiB, G_OO = 353 * MiB, G_VT = 417 * MiB, G_EG = 449 * MiB;
constexpr int GA_LDS = 19456;
constexpr int GA_TSTR = 272;
constexpr int GA_USTR = 144;
constexpr int GA_G = 18304, GA_B = 18560, GA_RK = 18816, GA_RQ = 19072;

__device__ __forceinline__ void gdn_stage_raw(const bf16_t* src  , int seqpos0, LAS unsigned char* wl, int lane) {
    if (seqpos0 > 0) {
#pragma unroll
        for (int u = 0; u < 3; ++u) __builtin_amdgcn_global_load_lds((const unsigned*)(src + (ptrdiff_t)(u - 3) * PROJ_COLS), (LAS unsigned*)(wl + u * GA_TSTR), 4, 0, 0);
    } else {
#pragma unroll
        for (int u = 0; u < 3; ++u) *(LAS unsigned*)(wl + u * GA_TSTR + 4 * lane) = 0u;
    }
#pragma unroll 8
    for (int p = 0; p < 64; ++p) __builtin_amdgcn_global_load_lds((const unsigned*)(src + (size_t)p * PROJ_COLS), (LAS unsigned*)(wl + (p + 3) * GA_TSTR), 4, 0, 0);
}
template <int UNR, class F>
__device__ __forceinline__ void gdn_conv_stream(LAS unsigned char* wl, const float* cw  , int lane, F&& emit) {
    f32x2 w[4];
#pragma unroll
    for (int j = 0; j < 4; ++j) w[j] = *(const f32x2*)(cw + j * 3072);
    asm volatile("s_waitcnt vmcnt(0)" ::: "memory");
    unsigned r0 = *(LAS unsigned*)(wl + 0 * GA_TSTR + 4 * lane), r1 = *(LAS unsigned*)(wl + 1 * GA_TSTR + 4 * lane), r2 = *(LAS unsigned*)(wl + 2 * GA_TSTR + 4 * lane);
#pragma unroll 1
    for (int pb_ = 0; pb_ < 64 / UNR; ++pb_) {
        unsigned cu[UNR];
#pragma unroll
        for (int u = 0; u < UNR; ++u) cu[u] = *(LAS unsigned*)(wl + (UNR * pb_ + u + 3) * GA_TSTR + 4 * lane);
#pragma unroll
        for (int u = 0; u < UNR; ++u) {
            const unsigned r3 = cu[u];
            float y0 = w[0][0] * bflo(r0); y0 = fmaf(w[1][0], bflo(r1), y0); y0 = fmaf(w[2][0], bflo(r2), y0); y0 = fmaf(w[3][0], bflo(r3), y0);
            float y1 = w[0][1] * bfhi(r0); y1 = fmaf(w[1][1], bfhi(r1), y1); y1 = fmaf(w[2][1], bfhi(r2), y1); y1 = fmaf(w[3][1], bfhi(r3), y1);
            r0 = r1; r1 = r2; r2 = r3;
            emit(pb_, u, siluf_(y0), siluf_(y1));
        }
    }
}

__device__ __forceinline__ void gdn_a_item(const __attribute__((address_space(4))) MArgs& a, unsigned char* ws, const int L, LAS unsigned char* wl, const int item, const int lane, const int vt_slot) {
    const int n = item & 63, h = (item >> 6) & 7, b = item >> 9;
    const size_t t0 = (size_t)b * SEQ + (size_t)n * 64;
    const int r = lane & 31, hh = lane >> 5;
    const bf16_t* PROJB = (const bf16_t*)(ws + WS_PROJ);
    unsigned char* RM = ws + WS_M;
    LAS float* Gs = (LAS float*)(wl + GA_G); LAS float* Bs = (LAS float*)(wl + GA_B); LAS float* Rk = (LAS float*)(wl + GA_RK); LAS float* Rq = (LAS float*)(wl + GA_RQ);
    float Gtok, Glast;
    auto row_ss = [&]() { float ss = 0.f;
#pragma unroll
        for (int c8 = 0; c8 < 16; ++c8) { const u32x4 w = *(const LAS u32x4*)(wl + lane * GA_TSTR + 16 * c8);
            ss = fmaf(bflo(w.x), bflo(w.x), ss); ss = fmaf(bfhi(w.x), bfhi(w.x), ss); ss = fmaf(bflo(w.y), bflo(w.y), ss); ss = fmaf(bfhi(w.y), bfhi(w.y), ss);
            ss = fmaf(bflo(w.z), bflo(w.z), ss); ss = fmaf(bfhi(w.z), bfhi(w.z), ss); ss = fmaf(bflo(w.w), bflo(w.w), ss); ss = fmaf(bfhi(w.w), bfhi(w.w), ss); }
        return ss; };
    {
        const float* AB = (const float*)(ws + WS_AB);
        const float av = AB[(t0 + lane) * 16 + h], bv = AB[(t0 + lane) * 16 + 8 + h];
        float G = -expf(as_global(a.in[I_ALOG])[L * 8 + h]) * softplusf_(av + as_global(a.in[I_DTB])[L * 8 + h]);
#pragma unroll
        for (int o = 1; o < 64; o <<= 1) { const float y = __shfl_up(G, o); if (lane >= o) G += y; }
        Gs[lane] = G; Bs[lane] = sigmoidf_(bv);
        Gtok = G; Glast = __builtin_bit_cast(float, __builtin_amdgcn_readlane(__builtin_bit_cast(int, G), 63));
    }
    const float* cwL = as_global(a.in[I_CONVQKV]) + (size_t)L * 4 * 3072 + h * 128 + 2 * lane;
    const bf16_t* srcL = PROJB + t0 * PROJ_COLS + h * 128 + 2 * lane;
    gdn_stage_raw(srcL + PJ_V, n, wl, lane);
    bf16_t* VT = (bf16_t*)(RM + G_VT) + (size_t)vt_slot * 8192;
    {
        float vb0[8], vb1[8];
        gdn_conv_stream<8>(wl, cwL + 2048, lane, [&](int pb_, int u, float y0, float y1) {
            const int p = 8 * pb_ + u;
            vb0[u] = y0; vb1[u] = y1;
            if (u == 7) {
                u32x4 o0; o0.x = cvtpk(vb0[0], vb0[1]); o0.y = cvtpk(vb0[2], vb0[3]); o0.z = cvtpk(vb0[4], vb0[5]); o0.w = cvtpk(vb0[6], vb0[7]);
                u32x4 o1; o1.x = cvtpk(vb1[0], vb1[1]); o1.y = cvtpk(vb1[2], vb1[3]); o1.z = cvtpk(vb1[4], vb1[5]); o1.w = cvtpk(vb1[6], vb1[7]);
                *(u32x4*)(VT + (size_t)(2 * lane) * 64 + (p & ~7)) = o0; *(u32x4*)(VT + (size_t)(2 * lane + 1) * 64 + (p & ~7)) = o1;
            }
        });
    }
    asm volatile("s_waitcnt lgkmcnt(0)" ::: "memory");
    gdn_stage_raw(srcL + PJ_K, n, wl, lane);
    {
        bf16_t* KTN = (bf16_t*)(RM + G_KT) + (size_t)item * 8192;
        float kb0[4], kb1[4];
        const int d0 = 2 * lane, mtp = d0 >> 5, rr = d0 & 31;
        gdn_conv_stream<4>(wl, cwL + 1024, lane, [&](int pb_, int u, float y0, float y1) {
            const int p = 4 * pb_ + u;
            *(LAS unsigned*)(wl + p * GA_TSTR + 4 * lane) = cvtpk(y0, y1);
            kb0[u] = y0; kb1[u] = y1;
            if (u == 3) {
                const int ks = p >> 4, q4 = (p & 15) >> 2, h_ = q4 & 1, jh = q4 >> 1;
                const size_t off = ((size_t)((mtp * 4 + ks) * 64 + h_ * 32 + rr)) * 8 + jh * 4;
                u32x2 o0; o0.x = cvtpk(kb0[0], kb0[1]); o0.y = cvtpk(kb0[2], kb0[3]);
                u32x2 o1; o1.x = cvtpk(kb1[0], kb1[1]); o1.y = cvtpk(kb1[2], kb1[3]);
                *(u32x2*)(KTN + off) = o0; *(u32x2*)(KTN + off + 8) = o1;
            }
        });
    }
    const float rnk = rsqrtf(row_ss() + 1e-6f);
    Rk[lane] = rnk;
    bf16x8 kf[2][8];
#pragma unroll
    for (int mt = 0; mt < 2; ++mt)
#pragma unroll
        for (int s = 0; s < 8; ++s) kf[mt][s] = *(const LAS bf16x8*)(wl + (32 * mt + r) * GA_TSTR + (16 * s + 8 * hh) * 2);
    asm volatile("s_waitcnt lgkmcnt(0)" ::: "memory");
    gdn_stage_raw(srcL + PJ_Q, n, wl, lane);
    gdn_conv_stream<4>(wl, cwL, lane, [&](int pb_, int u, float y0, float y1) {
        *(LAS unsigned*)(wl + (4 * pb_ + u) * GA_TSTR + 4 * lane) = cvtpk(y0, y1);
    });
    const float rnq = rsqrtf(row_ss() + 1e-6f) * 0.08838834764831845f;
    Rq[lane] = rnq;
    {
        float* EG = (float*)(RM + G_EG) + (size_t)item * 192;
        EG[lane] = fexp(Gtok) * rnq; EG[64 + lane] = fexp(Glast - Gtok) * rnk;
        if (lane == 0) EG[128] = fexp(Glast);
    }
    {
        bf16_t* ANf = (bf16_t*)(RM + G_AN) + (size_t)item * 4096;
#pragma unroll
        for (int it = 0; it < 2; ++it)
#pragma unroll
            for (int jt = 0; jt <= it; ++jt) {
                f32x16 c = {0.f, 0.f, 0.f, 0.f, 0.f, 0.f, 0.f, 0.f, 0.f, 0.f, 0.f, 0.f, 0.f, 0.f, 0.f, 0.f};
#pragma unroll
                for (int s = 0; s < 8; ++s) { const bf16x8 qf = *(const LAS bf16x8*)(wl + (32 * it + r) * GA_TSTR + (16 * s + 8 * hh) * 2); c = MFMA32(kf[jt][s], qf, c); }
                const int i = 32 * it + r; const float Gi = Gs[i], Rqi = Rq[i];
#pragma unroll
                for (int g4 = 0; g4 < 4; ++g4) { const f32x4 Gj = *(const LAS f32x4*)(Gs + 32 * jt + 8 * g4 + 4 * hh), Rkj = *(const LAS f32x4*)(Rk + 32 * jt + 8 * g4 + 4 * hh);
#pragma unroll
                    for (int q = 0; q < 4; ++q) { const int j = 32 * jt + 8 * g4 + 4 * hh + q; c[4 * g4 + q] = (i >= j) ? c[4 * g4 + q] * (Rqi * Rkj[q] * fexp(Gi - Gj[q])) : 0.f; } }
#pragma unroll
                for (int sp = 0; sp < 2; ++sp) *(bf16x8*)((unsigned char*)ANf + (unsigned)(lane * 16) + (it * 4 + 2 * jt + sp) * 1024) = pack8(c, sp);
            }
    }
    {
        f32x16 ck[3];
#pragma unroll
        for (int tix = 0; tix < 3; ++tix) {
            const int it = tix == 0 ? 0 : 1, jt = tix == 2 ? 1 : 0;
            f32x16 c = {0.f, 0.f, 0.f, 0.f, 0.f, 0.f, 0.f, 0.f, 0.f, 0.f, 0.f, 0.f, 0.f, 0.f, 0.f, 0.f};
#pragma unroll
            for (int s = 0; s < 8; ++s) c = MFMA32(kf[it][s], kf[jt][s], c);
            const int j = 32 * jt + r; const float Gj = Gs[j], Rkj = Rk[j];
#pragma unroll
            for (int g4 = 0; g4 < 4; ++g4) { const f32x4 Gi = *(const LAS f32x4*)(Gs + 32 * it + 8 * g4 + 4 * hh), Bi = *(const LAS f32x4*)(Bs + 32 * it + 8 * g4 + 4 * hh), Rki = *(const LAS f32x4*)(Rk + 32 * it + 8 * g4 + 4 * hh);
#pragma unroll
                for (int q = 0; q < 4; ++q) { const int i = 32 * it + 8 * g4 + 4 * hh + q; c[4 * g4 + q] = (i > j) ? (Bi[q] * Rki[q] * Rkj) * c[4 * g4 + q] * fexp(Gi[q] - Gj) : 0.f; } }
            ck[tix] = c;
        }
        {
            bf16_t* QNt = (bf16_t*)(RM + G_QN) + (size_t)item * 8192;
    #pragma unroll
            for (int mt = 0; mt < 2; ++mt)
    #pragma unroll
                for (int ks = 0; ks < 8; ++ks) {
                    const LAS unsigned char* rowp = wl + (32 * mt + r) * GA_TSTR + (32 * (ks >> 1) + 16 * (ks & 1) + 4 * hh) * 2;
                    const u32x2 lo = *(const LAS u32x2*)rowp, hi = *(const LAS u32x2*)(rowp + 16);
                    u32x4 o; o.x = lo.x; o.y = lo.y; o.z = hi.x; o.w = hi.y;
                    *(u32x4*)((unsigned char*)QNt + (unsigned)(lane * 16) + (mt * 8 + ks) * 1024) = o;
                }
        }
        asm volatile("s_waitcnt lgkmcnt(0)" ::: "memory");
#pragma unroll
        for (int tix = 0; tix < 3; ++tix) {
            const int it = tix == 0 ? 0 : 1, jt = tix == 2 ? 1 : 0; const int j = 32 * jt + r;
#pragma unroll
            for (int g4 = 0; g4 < 4; ++g4) *(LAS f32x4*)(wl + (j * 64 + 32 * it + 8 * g4 + 4 * hh) * 4) = (f32x4){ck[tix][4 * g4], ck[tix][4 * g4 + 1], ck[tix][4 * g4 + 2], ck[tix][4 * g4 + 3]};
        }
    }
    float t[64];
#pragma unroll
    for (int j = 0; j < 64; ++j) t[j] = 0.f;
    {
        const unsigned ltbase = (unsigned)(size_t)wl;
#pragma unroll
        for (int j = 63; j >= 0; --j) {
            float acc = (lane == j) ? 1.f : 0.f;
            unsigned addr = ltbase + j * 256;
            if (j + 2 < 64) asm volatile("" : "+v"(addr) : "v"(t[(j + 2) & 63]));
#pragma unroll
            for (int i0 = 60; i0 >= ((j + 1) & ~3); i0 -= 4) { const f32x4 l4 = *(const LAS f32x4*)(size_t)(addr + i0 * 4);
                acc = fmaf(-t[i0 + 3], l4[3], acc); acc = fmaf(-t[i0 + 2], l4[2], acc); acc = fmaf(-t[i0 + 1], l4[1], acc); acc = fmaf(-t[i0], l4[0], acc); }
            t[j] = acc;
        }
    }
    bf16x8 vf[4][4];
    {
        unsigned voff = (unsigned)((32 * 0 + r) * 64 + 8 * hh);
        asm volatile("" : "+v"(voff) : "v"(t[0]));
#pragma unroll
        for (int nt = 0; nt < 4; ++nt)
#pragma unroll
            for (int s = 0; s < 4; ++s) vf[nt][s] = *(const bf16x8*)((const unsigned char*)VT + voff * 2u + nt * 4096 + s * 32);
    }
    asm volatile("s_waitcnt lgkmcnt(0)" ::: "memory");
    float bj[64];
#pragma unroll
    for (int j4 = 0; j4 < 16; ++j4) { const f32x4 b4 = *(const LAS f32x4*)(Bs + 4 * j4); bj[4 * j4] = b4[0]; bj[4 * j4 + 1] = b4[1]; bj[4 * j4 + 2] = b4[2]; bj[4 * j4 + 3] = b4[3]; }
#pragma unroll
    for (int j = 0; j < 64; ++j) t[j] *= bj[j];
#pragma unroll
    for (int j8 = 0; j8 < 8; ++j8) { u32x4 o; o.x = cvtpk(t[8 * j8], t[8 * j8 + 1]); o.y = cvtpk(t[8 * j8 + 2], t[8 * j8 + 3]); o.z = cvtpk(t[8 * j8 + 4], t[8 * j8 + 5]); o.w = cvtpk(t[8 * j8 + 6], t[8 * j8 + 7]);
        *(LAS u32x4*)(wl + lane * GA_USTR + 16 * j8) = o; }
    {
        bf16_t* UN = (bf16_t*)(RM + G_UN) + (size_t)item * 8192;
#pragma unroll
        for (int nt = 0; nt < 4; ++nt)
#pragma unroll
            for (int mt = 0; mt < 2; ++mt) {
                f32x16 c = {0.f, 0.f, 0.f, 0.f, 0.f, 0.f, 0.f, 0.f, 0.f, 0.f, 0.f, 0.f, 0.f, 0.f, 0.f, 0.f};
#pragma unroll
                for (int s = 0; s < (mt == 0 ? 2 : 4); ++s) { const bf16x8 af = *(const LAS bf16x8*)(wl + (32 * mt + r) * GA_USTR + (16 * s + 8 * hh) * 2); c = MFMA32(af, vf[nt][s], c); }
#pragma unroll
                for (int sp = 0; sp < 2; ++sp) *(bf16x8*)((unsigned char*)UN + (unsigned)(lane * 16) + ((nt * 2 + mt) * 2 + sp) * 1024) = pack8(c, sp);
            }
    }
    asm volatile("s_waitcnt lgkmcnt(0)" ::: "memory");
#pragma unroll
    for (int j4 = 0; j4 < 16; ++j4) { const f32x4 g4v = *(const LAS f32x4*)(Gs + 4 * j4), rk4 = *(const LAS f32x4*)(Rk + 4 * j4);
        t[4 * j4] *= fexp(g4v[0]) * rk4[0]; t[4 * j4 + 1] *= fexp(g4v[1]) * rk4[1]; t[4 * j4 + 2] *= fexp(g4v[2]) * rk4[2]; t[4 * j4 + 3] *= fexp(g4v[3]) * rk4[3]; }
#pragma unroll
    for (int j8 = 0; j8 < 8; ++j8) { u32x4 o; o.x = cvtpk(t[8 * j8], t[8 * j8 + 1]); o.y = cvtpk(t[8 * j8 + 2], t[8 * j8 + 3]); o.z = cvtpk(t[8 * j8 + 4], t[8 * j8 + 5]); o.w = cvtpk(t[8 * j8 + 6], t[8 * j8 + 7]);
        *(LAS u32x4*)(wl + lane * GA_USTR + 16 * j8) = o; }
    {
        const bf16_t* KTN = (const bf16_t*)(RM + G_KT) + (size_t)item * 8192;
        bf16_t* WN = (bf16_t*)(RM + G_WN) + (size_t)item * 8192;
#pragma unroll
        for (int it = 0; it < 2; ++it) {
            bf16x8 tw[4];
#pragma unroll
            for (int s = 0; s < (it == 0 ? 2 : 4); ++s) { const LAS unsigned char* rowp = wl + (32 * it + r) * GA_USTR + (16 * s + 4 * hh) * 2;
                const u32x2 lo = *(const LAS u32x2*)rowp, hi = *(const LAS u32x2*)(rowp + 16); u32x4 o; o.x = lo.x; o.y = lo.y; o.z = hi.x; o.w = hi.y; tw[s] = __builtin_bit_cast(bf16x8, o); }
            bf16x8 ktf[4][4];
#pragma unroll
            for (int dt = 0; dt < 4; ++dt)
#pragma unroll
                for (int s = 0; s < (it == 0 ? 2 : 4); ++s) ktf[dt][s] = *(const bf16x8*)((const unsigned char*)KTN + (unsigned)(lane * 16) + (dt * 4 + s) * 1024);
#pragma unroll
            for (int dt = 0; dt < 4; ++dt) {
                f32x16 c = {0.f, 0.f, 0.f, 0.f, 0.f, 0.f, 0.f, 0.f, 0.f, 0.f, 0.f, 0.f, 0.f, 0.f, 0.f, 0.f};
#pragma unroll
                for (int s = 0; s < (it == 0 ? 2 : 4); ++s) c = MFMA32(ktf[dt][s], tw[s], c);
#pragma unroll
                for (int q = 0; q < 16; ++q) c[q] = -c[q];
#pragma unroll
                for (int sp = 0; sp < 2; ++sp) *(bf16x8*)((unsigned char*)WN + (unsigned)(lane * 16) + (it * 8 + 2 * dt + sp) * 1024) = pack8(c, sp);
            }
        }
    }
    asm volatile("s_waitcnt lgkmcnt(0)" ::: "memory");
}

constexpr int GB_BUF = 58112;
__device__ __forceinline__ void gdn_b_scan(unsigned char* ws, LAS unsigned char* lds, const int bh, const int tid) {
    const int lane = tid & 63, wave = __builtin_amdgcn_readfirstlane(tid >> 6), r = lane & 31, hh = lane >> 5;
    unsigned char* RM = ws + WS_M;
    const int b = bh >> 3, h = bh & 7;
    const size_t item0 = (size_t)bh * 64;
    bf16_t* OO = (bf16_t*)(RM + G_OO);
    auto dma_chunk = [&](const size_t item, LAS unsigned char* buf) {
#pragma unroll
        for (int k = 0; k < 7; ++k) {
            const int pi = wave * 7 + k;
            const unsigned char* g;
            if (pi < 16) g = RM + G_WN + item * 16384 + (size_t)pi * 1024;
            else if (pi < 32) g = RM + G_QN + item * 16384 + (size_t)(pi - 16) * 1024;
            else if (pi < 40) g = RM + G_AN + item * 8192 + (size_t)(pi - 32) * 1024;
            else g = RM + G_KT + item * 16384 + (size_t)(pi - 40) * 1024;
            __builtin_amdgcn_global_load_lds((const unsigned*)(g + lane * 16), (LAS unsigned*)(buf + pi * 1024), 16, 0, 0);
        }
        if (wave >= 5) __builtin_amdgcn_global_load_lds((const unsigned*)(RM + G_EG + item * 768 + (size_t)(wave - 5) * 256 + lane * 4), (LAS unsigned*)(buf + 57344 + (wave - 5) * 256), 4, 0, 0);
    };
    f32x16 S[4];
#pragma unroll
    for (int dt = 0; dt < 4; ++dt)
#pragma unroll
        for (int q = 0; q < 16; ++q) S[dt][q] = 0.f;
    dma_chunk(item0, lds);
    bf16x8 Un[2][2];
    if (wave < 4) {
        const unsigned char* UN0 = RM + G_UN + item0 * 16384 + (size_t)wave * 4096 + lane * 16;
#pragma unroll
        for (int mt = 0; mt < 2; ++mt)
#pragma unroll
            for (int sp = 0; sp < 2; ++sp) Un[mt][sp] = *(const bf16x8*)(UN0 + (mt * 2 + sp) * 1024);
    }
    asm volatile("s_waitcnt vmcnt(0)" ::: "memory");
    __syncthreads();
#pragma unroll 1
    for (int n = 0; n < 64; ++n) {
        const size_t item = item0 + n;
        LAS unsigned char* buf = lds + (n & 1) * GB_BUF;
        f32x16 Vn[2], O[2];
        if (wave < 4) {
#pragma unroll
            for (int mt = 0; mt < 2; ++mt)
#pragma unroll
                for (int sp = 0; sp < 2; ++sp) { const u32x4 w = __builtin_bit_cast(u32x4, Un[mt][sp]);
                    Vn[mt][8 * sp + 0] = bflo(w.x); Vn[mt][8 * sp + 1] = bfhi(w.x); Vn[mt][8 * sp + 2] = bflo(w.y); Vn[mt][8 * sp + 3] = bfhi(w.y);
                    Vn[mt][8 * sp + 4] = bflo(w.z); Vn[mt][8 * sp + 5] = bfhi(w.z); Vn[mt][8 * sp + 6] = bflo(w.w); Vn[mt][8 * sp + 7] = bfhi(w.w); }
#pragma unroll
            for (int mt = 0; mt < 2; ++mt)
#pragma unroll
                for (int q = 0; q < 16; ++q) O[mt][q] = 0.f;
            if (n + 1 < 64) {
                const unsigned char* UN = RM + G_UN + (size_t)(item + 1) * 16384 + (size_t)wave * 4096 + lane * 16;
#pragma unroll
                for (int mt = 0; mt < 2; ++mt)
#pragma unroll
                    for (int sp = 0; sp < 2; ++sp) Un[mt][sp] = *(const bf16x8*)(UN + (mt * 2 + sp) * 1024);
            }
        }
        asm volatile("" ::: "memory");
        if (n + 1 < 64) dma_chunk(item + 1, lds + ((n + 1) & 1) * GB_BUF);
        asm volatile("" ::: "memory");
        if (wave < 4) {
            const int sl = wave;
            const LAS float* EGs = (const LAS float*)(buf + 57344);
            bf16x8 Sb[8];
#pragma unroll
            for (int dt = 0; dt < 4; ++dt) { Sb[2 * dt] = pack8(S[dt], 0); Sb[2 * dt + 1] = pack8(S[dt], 1); }
#pragma unroll
            for (int mt = 0; mt < 2; ++mt)
#pragma unroll
                for (int ks = 0; ks < 8; ++ks) {
                    const bf16x8 wf = *(const LAS bf16x8*)(buf + ((mt * 8 + ks) * 64 + lane) * 16);
                    const bf16x8 qf = *(const LAS bf16x8*)(buf + 16384 + ((mt * 8 + ks) * 64 + lane) * 16);
                    Vn[mt] = MFMA32(wf, Sb[ks], Vn[mt]);
                    O[mt] = MFMA32(qf, Sb[ks], O[mt]);
                }
#pragma unroll
            for (int mt = 0; mt < 2; ++mt)
#pragma unroll
                for (int g4 = 0; g4 < 4; ++g4) { const f32x4 E4 = *(const LAS f32x4*)(EGs + 32 * mt + 8 * g4 + 4 * hh);
#pragma unroll
                    for (int q = 0; q < 4; ++q) O[mt][4 * g4 + q] *= E4[q]; }
            bf16x8 Vb[4];
#pragma unroll
            for (int mt = 0; mt < 2; ++mt) { Vb[2 * mt] = pack8(Vn[mt], 0); Vb[2 * mt + 1] = pack8(Vn[mt], 1); }
#pragma unroll
            for (int mt = 0; mt < 2; ++mt)
#pragma unroll
                for (int ks = 0; ks < (mt == 0 ? 2 : 4); ++ks) {
                    const bf16x8 af = *(const LAS bf16x8*)(buf + 32768 + ((mt * 4 + ks) * 64 + lane) * 16);
                    O[mt] = MFMA32(af, Vb[ks], O[mt]);
                }
            {
                bf16_t* orow = OO + ((size_t)b * SEQ + (size_t)n * 64) * DM + h * 128 + sl * 32 + r;
#pragma unroll
                for (int mt = 0; mt < 2; ++mt)
#pragma unroll
                    for (int q = 0; q < 16; ++q) { const int pos = 32 * mt + (q & 3) + 8 * (q >> 2) + 4 * hh; orow[(size_t)pos * DM] = (bf16_t)f2bf(O[mt][q]); }
            }
#pragma unroll
            for (int mt = 0; mt < 2; ++mt)
#pragma unroll
                for (int g4 = 0; g4 < 4; ++g4) { const f32x4 L4 = *(const LAS f32x4*)(EGs + 64 + 32 * mt + 8 * g4 + 4 * hh);
#pragma unroll
                    for (int q = 0; q < 4; ++q) Vn[mt][4 * g4 + q] *= L4[q]; }
#pragma unroll
            for (int mt = 0; mt < 2; ++mt) { Vb[2 * mt] = pack8(Vn[mt], 0); Vb[2 * mt + 1] = pack8(Vn[mt], 1); }
            const float cd = EGs[128];
#pragma unroll
            for (int dt = 0; dt < 4; ++dt)
#pragma unroll
                for (int q = 0; q < 16; ++q) S[dt][q] *= cd;
#pragma unroll
            for (int ks = 0; ks < 4; ++ks)
#pragma unroll
                for (int dt = 0; dt < 4; ++dt) { const bf16x8 kt = *(const LAS bf16x8*)(buf + 40960 + ((dt * 4 + ks) * 64 + lane) * 16); S[dt] = MFMA32(kt, Vb[ks], S[dt]); }
            asm volatile("s_waitcnt vmcnt(32) lgkmcnt(0)" ::: "memory");
        } else {
            asm volatile("s_waitcnt vmcnt(0) lgkmcnt(0)" ::: "memory");
        }
        __syncthreads();
    }
}

constexpr int SW_KSTR = 144, SW_VSTR = 528, SW_K = 0, SW_V = 36864, SW_TB = 70656;
__device__ __forceinline__ void swa_phase(const CAS MArgs& a, unsigned char* ws, const int L, LAS unsigned char* lds, const int tid, const int bid, const int G) {
    const int lane = tid & 63, wave = __builtin_amdgcn_readfirstlane(tid >> 6), r = lane & 31, hh = lane >> 5;
    const bf16_t* PROJB = (const bf16_t*)(ws + WS_PROJ);
    bf16_t* SOB = (bf16_t*)(ws + WS_SO);
    LAS float* tb = (LAS float*)(lds + SW_TB);
    for (int idx = tid; idx < 2048; idx += 512) { const int hq = idx >> 7, dist = idx & 127; tb[idx] = as_global(a.in[I_RELB])[t5_bucket(dist) * 16 + hq] * 1.4426950408889634f; }
    __syncthreads();
#pragma unroll 1
    for (int item = bid; item < NBATCH * 32 * 4; item += G) {
        const int kvh = item & 3, nb = (item >> 2) & 31, b = item >> 7;
        const size_t tq0 = (size_t)b * SEQ + (size_t)nb * 128;
        {
            const int key = tid >> 1, half = tid & 1;
            const bool exists = (nb > 0) || (key >= 128);
            u32x4 kv[4], vv[4];
#pragma unroll
            for (int i = 0; i < 4; ++i) { kv[i] = (u32x4){0u, 0u, 0u, 0u}; vv[i] = kv[i]; }
            if (exists) {
                const bf16_t* rowp = PROJB + (tq0 - 128 + key) * PROJ_COLS + kvh * 64 + half * 32;
#pragma unroll
                for (int i = 0; i < 4; ++i) { kv[i] = *(const u32x4*)(rowp + PJ_KC + 8 * i); vv[i] = *(const u32x4*)(rowp + PJ_VC + 8 * i); }
            }
#pragma unroll
            for (int i = 0; i < 4; ++i) *(LAS u32x4*)(lds + SW_K + key * SW_KSTR + half * 64 + 16 * i) = kv[i];
#pragma unroll
            for (int i = 0; i < 4; ++i) {
                const unsigned w4[4] = {vv[i].x, vv[i].y, vv[i].z, vv[i].w};
#pragma unroll
                for (int q = 0; q < 4; ++q) { const int d = half * 32 + 8 * i + 2 * q;
                    *(LAS unsigned short*)(lds + SW_V + d * SW_VSTR + key * 2) = (unsigned short)(w4[q] & 0xffffu);
                    *(LAS unsigned short*)(lds + SW_V + (d + 1) * SW_VSTR + key * 2) = (unsigned short)(w4[q] >> 16); }
            }
        }
        __syncthreads();
        {
            const int g = wave >> 1, qh = wave & 1, hq = kvh * 4 + g;
            const float sink2 = as_global(a.in[I_SINKS])[L * 16 + hq] * 1.4426950408889634f;
#pragma unroll 1
            for (int qt = 0; qt < 2; ++qt) {
                const int i0 = 64 * qh + 32 * qt, kt0 = i0 >> 5;
                const size_t token = tq0 + i0 + r;
                bf16x8 qf[4];
#pragma unroll
                for (int s = 0; s < 4; ++s) qf[s] = *(const bf16x8*)(PROJB + token * PROJ_COLS + PJ_QC + hq * 64 + 16 * s + 8 * hh);
                f32x16 c[5];
#pragma unroll
                for (int k5 = 0; k5 < 5; ++k5) {
#pragma unroll
                    for (int q = 0; q < 16; ++q) c[k5][q] = 0.f;
#pragma unroll
                    for (int s = 0; s < 4; ++s) { const bf16x8 kf = *(const LAS bf16x8*)(lds + SW_K + (32 * (kt0 + k5) + r) * SW_KSTR + (16 * s + 8 * hh) * 2); c[k5] = MFMA32(kf, qf[s], c[k5]); }
                }
                float m = sink2;
#pragma unroll
                for (int k5 = 0; k5 < 5; ++k5)
#pragma unroll
                    for (int q = 0; q < 16; ++q) {
                        const int cr = (q & 3) + 8 * (q >> 2) + 4 * hh;
                        const int dist = 128 + r - 32 * k5 - cr;
                        bool valid = true;
                        if (k5 == 0) valid = dist <= 127;
                        if (k5 == 4) valid = dist >= 0;
                        if (nb == 0) valid = valid && (32 * (kt0 + k5) + cr >= 128);
                        const float sc = valid ? fmaf(c[k5][q], 0.125f * 1.4426950408889634f, tb[hq * 128 + (dist & 127)]) : -3.0e38f;
                        c[k5][q] = sc; m = fmaxf(m, sc);
                    }
                m = fmaxf(m, __shfl_xor(m, 32));
                float sum = 0.f;
#pragma unroll
                for (int k5 = 0; k5 < 5; ++k5)
#pragma unroll
                    for (int q = 0; q < 16; ++q) { const float p = __builtin_amdgcn_exp2f(c[k5][q] - m); c[k5][q] = p; sum += p; }
                sum += __shfl_xor(sum, 32);
                const float inv = 1.0f / (sum + __builtin_amdgcn_exp2f(sink2 - m));
                f32x16 o[2];
#pragma unroll
                for (int dt = 0; dt < 2; ++dt)
#pragma unroll
                    for (int q = 0; q < 16; ++q) o[dt][q] = 0.f;
#pragma unroll
                for (int k5 = 0; k5 < 5; ++k5)
#pragma unroll
                    for (int sp = 0; sp < 2; ++sp) {
                        const bf16x8 pf = pack8(c[k5], sp);
#pragma unroll
                        for (int dt = 0; dt < 2; ++dt) {
                            const LAS unsigned char* vp = lds + SW_V + (32 * dt + r) * SW_VSTR + (32 * (kt0 + k5) + 16 * sp + 4 * hh) * 2;
                            const u32x2 lo = *(const LAS u32x2*)vp, hi = *(const LAS u32x2*)(vp + 16);
                            u32x4 v4; v4.x = lo.x; v4.y = lo.y; v4.z = hi.x; v4.w = hi.y;
                            o[dt] = MFMA32(__builtin_bit_cast(bf16x8, v4), pf, o[dt]);
                        }
                    }
                bf16_t* orow = SOB + token * DM + hq * 64 + 4 * hh;
#pragma unroll
                for (int dt = 0; dt < 2; ++dt)
#pragma unroll
                    for (int g4 = 0; g4 < 4; ++g4) { u32x2 w; w.x = cvtpk(o[dt][4 * g4] * inv, o[dt][4 * g4 + 1] * inv); w.y = cvtpk(o[dt][4 * g4 + 2] * inv, o[dt][4 * g4 + 3] * inv);
                        *(u32x2*)(orow + 32 * dt + 8 * g4) = w; }
            }
        }
        __syncthreads();
    }
}

constexpr int LR_XSTR = 132;
constexpr int LR_X = 0, LR_W = 67584, LR_WSTR = 272, LR_AGG = 137216;
constexpr size_t LRM_AGG = 452 * MiB, LRM_CIN = 454 * MiB;
__device__ __forceinline__ void lru_l1(const CAS MArgs& a, unsigned char* ws, const int L, LAS unsigned char* lds, const int tid, const int bid, const int G) {
    const int lane = tid & 63, wave = __builtin_amdgcn_readfirstlane(tid >> 6), r = lane & 31, hh = lane >> 5;
    const bf16_t* PROJB = (const bf16_t*)(ws + WS_PROJ);
    unsigned char* RM = ws + WS_M;
    LAS float* xc = (LAS float*)(lds + LR_X);
    LAS float* agg = (LAS float*)(lds + LR_AGG);
    const int blk = bid & 7;
    int wblk = -1;
#pragma unroll 1
    for (int it = bid; it < NBATCH * 8 * 32; it += G) {
        const int ib = it & 7, bc = it >> 3, b = bc >> 5, chunk = bc & 31;
        const size_t t0 = (size_t)b * SEQ + (size_t)chunk * 128;
        if (ib != wblk) {
            const bf16_t* W = (const bf16_t*)(ws + WS_W + (size_t)L * WL_STRIDE + W_LRU) + (size_t)ib * 256 * 128;
            for (int i = tid; i < 256 * 16; i += 512) { const int n = i >> 4, seg = i & 15; *(LAS u32x4*)(lds + LR_W + n * LR_WSTR + seg * 16) = *(const u32x4*)(W + n * 128 + seg * 8); }
            wblk = ib;
        }
        {
            const int c2 = 2 * lane, tok0 = 16 * wave;
            const float* cw = as_global(a.in[I_RGCW]) + (size_t)L * 4 * 1024 + ib * 128 + c2;
            const f32x2 w0 = *(const f32x2*)cw, w1 = *(const f32x2*)(cw + 1024), w2 = *(const f32x2*)(cw + 2048), w3 = *(const f32x2*)(cw + 3072);
            const f32x2 cb = *(const f32x2*)(as_global(a.in[I_RGCB]) + L * 1024 + ib * 128 + c2);
            const bf16_t* src = PROJB + (t0 + tok0) * PROJ_COLS + PJ_XL + ib * 128 + c2;
            unsigned raw[19];
#pragma unroll
            for (int u = 0; u < 19; ++u) { const int tok = tok0 - 3 + u; raw[u] = (chunk * 128 + tok >= 0) ? *(const unsigned*)(src + (ptrdiff_t)(u - 3) * PROJ_COLS) : 0u; }
#pragma unroll
            for (int u = 0; u < 16; ++u) {
                float y0 = cb[0], y1 = cb[1];
                y0 = fmaf(w0[0], bflo(raw[u]), y0); y0 = fmaf(w1[0], bflo(raw[u + 1]), y0); y0 = fmaf(w2[0], bflo(raw[u + 2]), y0); y0 = fmaf(w3[0], bflo(raw[u + 3]), y0);
                y1 = fmaf(w0[1], bfhi(raw[u]), y1); y1 = fmaf(w1[1], bfhi(raw[u + 1]), y1); y1 = fmaf(w2[1], bfhi(raw[u + 2]), y1); y1 = fmaf(w3[1], bfhi(raw[u + 3]), y1);
                *(LAS f32x2*)(xc + (tok0 + u) * LR_XSTR + c2) = (f32x2){y0, y1};
            }
        }
        __syncthreads();
        const int mt = wave >> 1, ch0 = 64 * (wave & 1);
        f32x16 acc[4];
#pragma unroll
        for (int nt = 0; nt < 4; ++nt)
#pragma unroll
            for (int q = 0; q < 16; ++q) acc[nt][q] = 0.f;
#pragma unroll
        for (int s = 0; s < 8; ++s) {
            const LAS float* ap = xc + (32 * mt + r) * LR_XSTR + 16 * s + 8 * hh;
            const f32x4 x0 = *(const LAS f32x4*)ap, x1 = *(const LAS f32x4*)(ap + 4);
            u32x4 af; af.x = cvtpk(x0[0], x0[1]); af.y = cvtpk(x0[2], x0[3]); af.z = cvtpk(x1[0], x1[1]); af.w = cvtpk(x1[2], x1[3]);
#pragma unroll
            for (int nt = 0; nt < 4; ++nt) {
                const int n = (nt >> 1) * 128 + ch0 + 32 * (nt & 1) + r;
                const bf16x8 bfrag = *(const LAS bf16x8*)(lds + LR_W + n * LR_WSTR + (16 * s + 8 * hh) * 2);
                acc[nt] = MFMA32(__builtin_bit_cast(bf16x8, af), bfrag, acc[nt]);
            }
        }
        float hl[2][16], pc[2][16], Pt[2], Ht[2];
#pragma unroll
        for (int ct = 0; ct < 2; ++ct) {
            const int ch = ch0 + 32 * ct + r, cg = L * 1024 + ib * 128 + ch;
            const float ba = as_global(a.in[I_RGBA])[cg], bx = as_global(a.in[I_RGBX])[cg], sp = 8.0f * softplusf_(-as_global(a.in[I_RGLAM])[cg]);
            float P4[4], H4[4];
#pragma unroll
            for (int g4 = 0; g4 < 4; ++g4) {
                float p = 1.f, h = 0.f;
#pragma unroll
                for (int q = 0; q < 4; ++q) {
                    const int tok = 32 * mt + 8 * g4 + 4 * hh + q;
                    const float rr = sigmoidf_(acc[ct][4 * g4 + q] + ba), ig = sigmoidf_(acc[2 + ct][4 * g4 + q] + bx);
                    const float av = fexp(-sp * rr);
                    const float uv = sqrtf(fmaxf(fmaf(-av, av, 1.0f), 0.f)) * ig * xc[tok * LR_XSTR + ch];
                    p *= av; h = fmaf(av, h, uv);
                    pc[ct][4 * g4 + q] = p; hl[ct][4 * g4 + q] = h;
                }
                P4[g4] = p; H4[g4] = h;
            }
            float c = 0.f, P = 1.f, cin[4], ppre[4];
#pragma unroll
            for (int g4 = 0; g4 < 4; ++g4) {
                const float oP = __shfl_xor(P4[g4], 32), oH = __shfl_xor(H4[g4], 32);
                const float eP = hh ? oP : P4[g4], eH = hh ? oH : H4[g4];
                const float dP = hh ? P4[g4] : oP, dH = hh ? H4[g4] : oH;
                const float c1 = fmaf(eP, c, eH), P1 = P * eP;
                cin[g4] = hh ? c1 : c; ppre[g4] = hh ? P1 : P;
                c = fmaf(dP, c1, dH); P = P1 * dP;
            }
#pragma unroll
            for (int g4 = 0; g4 < 4; ++g4)
#pragma unroll
                for (int q = 0; q < 4; ++q) { hl[ct][4 * g4 + q] = fmaf(pc[ct][4 * g4 + q], cin[g4], hl[ct][4 * g4 + q]); pc[ct][4 * g4 + q] *= ppre[g4]; }
            Pt[ct] = P; Ht[ct] = c;
            if (hh == 0) *(LAS f32x2*)(agg + (mt * 128 + ch) * 2) = (f32x2){P, c};
        }
        __syncthreads();
        bf16_t* HL = (bf16_t*)(ws + WS_XF); bf16_t* PC = (bf16_t*)(ws + WS_LO);
#pragma unroll
        for (int ct = 0; ct < 2; ++ct) {
            const int ch = ch0 + 32 * ct + r;
            float cT = 0.f, PT = 1.f;
            for (int m2 = 0; m2 < mt; ++m2) { const f32x2 ag = *(const LAS f32x2*)(agg + (m2 * 128 + ch) * 2); cT = fmaf(ag[0], cT, ag[1]); PT *= ag[0]; }
            if (mt == 3 && hh == 0) {
                const float ci = fmaf(Pt[ct], cT, Ht[ct]), Pi = PT * Pt[ct];
                *(f32x2*)((float*)(RM + LRM_AGG) + ((size_t)(b * 32 + chunk) * 1024 + ib * 128 + ch) * 2) = (f32x2){Pi, ci};
            }
            const size_t obase = (t0 + 32 * mt) * DM + ib * 128 + ch;
#pragma unroll
            for (int q16 = 0; q16 < 16; ++q16) {
                const int tok = (q16 & 3) + 8 * (q16 >> 2) + 4 * hh;
                HL[obase + (size_t)tok * DM] = (bf16_t)f2bf(fmaf(pc[ct][q16], cT, hl[ct][q16]));
                PC[obase + (size_t)tok * DM] = (bf16_t)f2bf(pc[ct][q16] * PT);
            }
        }
        __syncthreads();
    }
}

#define XB_TMO      128
#define XB_XCNT(j)  (256  + 64 * (j))
#define XB_XSUB(j)  (1280 + 64 * (j))
#define XB_XGEN(j)  (2304 + 64 * (j))
#define XB_TOP      3328
#define XB_TOPGEN   3392
#define XCD_BAR_WORDS 3456
#define XB_SPIN_CAP (1u << 18)
__device__ __forceinline__ unsigned xb_ld(unsigned* p)              { return __hip_atomic_load(p, __ATOMIC_RELAXED, __HIP_MEMORY_SCOPE_AGENT); }
__device__ __forceinline__ unsigned xb_add(unsigned* p, unsigned v) { return __hip_atomic_fetch_add(p, v, __ATOMIC_RELAXED, __HIP_MEMORY_SCOPE_AGENT); }
__device__ __forceinline__ unsigned xb_xcc_id() { return (unsigned)__builtin_amdgcn_s_getreg((3 << 11) | 20) & 0xFu; }
#define XB_SPIN(cond, bar) do { unsigned _sp = 0; while (cond) { __builtin_amdgcn_s_sleep(1); \
    if ((++_sp & 255u) == 0u) { if (xb_ld(&(bar)[XB_TMO])) break; if (_sp > XB_SPIN_CAP) { atomicAdd(&(bar)[XB_TMO], 1u); break; } } } } while (0)
struct XcdBarrier { unsigned* bar; unsigned x; volatile LAS unsigned* st; };
__device__ __forceinline__ XcdBarrier xcd_barrier_post(unsigned* bar, volatile LAS unsigned* st) {
    XcdBarrier b; b.bar = bar; b.x = xb_xcc_id(); b.st = st;
    if (threadIdx.x == 0) (void)xb_add(&bar[XB_XCNT(b.x)], 1u);
    return b;
}
__device__ __forceinline__ void xcd_barrier_complete(unsigned* bar, unsigned x, unsigned& nloc, unsigned& nx) {
    const unsigned G = gridDim.x * gridDim.y * gridDim.z;
    unsigned sum, cnt, mine, sp = 0u;
    for (;;) {
        sum = 0u; cnt = 0u; mine = 0u;
#pragma unroll
        for (unsigned j = 0; j < 16; ++j) { const unsigned c = xb_ld(&bar[XB_XCNT(j)]); sum += c; cnt += (c > 0u) ? 1u : 0u; mine = (j == x) ? c : mine; }
        if (sum == G) break;
        __builtin_amdgcn_s_sleep(1);
        if ((++sp & 255u) == 0u) { if (xb_ld(&bar[XB_TMO])) break; if (sp > XB_SPIN_CAP) { atomicAdd(&bar[XB_TMO], 1u); break; } }
    }
    nloc = mine > 0u ? mine : 1u; nx = cnt > 0u ? cnt : 1u;
}
__device__ __forceinline__ void xcd_barrier(const XcdBarrier& b) {
    asm volatile("s_waitcnt vmcnt(0)" ::: "memory");
    __syncthreads();
    if (threadIdx.x == 0) {
        unsigned* bar = b.bar;
        __builtin_amdgcn_s_waitcnt(0);
        unsigned nloc = b.st[0], nx = b.st[1];
        if (nloc == 0u) { xcd_barrier_complete(bar, b.x, nloc, nx); b.st[0] = nloc; b.st[1] = nx; }
        const unsigned old = xb_add(&bar[XB_XSUB(b.x)], 1u);
        const unsigned gen = old / nloc;
        if (old + 1u == (gen + 1u) * nloc) {
            __builtin_amdgcn_fence(__ATOMIC_RELEASE, "agent");
            asm volatile("s_waitcnt vmcnt(0)" ::: "memory");
            const unsigned og = xb_add(&bar[XB_TOP], 1u);
            const unsigned tg = og / nx;
            if (og + 1u == (tg + 1u) * nx) xb_add(&bar[XB_TOPGEN], 1u);
            else XB_SPIN(xb_ld(&bar[XB_TOPGEN]) == tg, bar);
            __builtin_amdgcn_fence(__ATOMIC_ACQUIRE, "agent");
            xb_add(&bar[XB_XGEN(b.x)], 1u);
            asm volatile("s_waitcnt vmcnt(0)" ::: "memory");
        } else {
            XB_SPIN(xb_ld(&bar[XB_XGEN(b.x)]) == gen, bar);
            __builtin_amdgcn_fence(__ATOMIC_ACQUIRE, "agent");
            asm volatile("s_waitcnt vmcnt(0)" ::: "memory");
        }
    }
    __syncthreads();
}


__device__ __forceinline__ int launder_s(int x) { asm volatile("" : "+s"(x)); return x; }
enum { K_INPROJ = 0, K_GDNPREP, K_GDNREC, K_GDNPOST, K_LRUCONV, K_LRUGATE, K_LRUSCAN, K_SWA, K_BRANCH, K_WOUT, K_LN1, K_SCATTER, K_MOE1, K_MOE2, K_LN2, K_PLEP, K_PLEG, K_LN3, NPL };
constexpr int NPHASES = 1 + DEPTH * NPL;

__global__ void __launch_bounds__(NWAVES * 64, 2) mega(MArgs a_raw) {
    extern __shared__ __attribute__((aligned(16))) unsigned char lds_raw[];
    LAS unsigned char* lds0 = (LAS unsigned char*)lds_raw;
    const int wave0 = __builtin_amdgcn_readfirstlane((int)threadIdx.x >> 6);
    volatile LAS unsigned* MISC = (volatile LAS unsigned*)(lds0 + LDS_MISC);
#define PH_PTRS(Lv) \
    const CAS MArgs* ap_ = (const CAS MArgs*)__builtin_amdgcn_kernarg_segment_ptr(); asm volatile("" : "+s"(ap_)); const CAS MArgs& a = *ap_; \
    unsigned char* ws = as_global(a.ws); int L = (Lv); unsigned z_ = 0u; int wave_ = wave0; unsigned ldsb_ = 0u; asm volatile("" : "+s"(L), "+s"(wave_), "+s"(ldsb_)); asm volatile("" : "+v"(z_)); \
    const int lane_ = (int)__builtin_amdgcn_mbcnt_hi(~0u, __builtin_amdgcn_mbcnt_lo(~0u, z_)); \
    LAS unsigned char* lds = lds0 + ldsb_; LAS int* tstart = (LAS int*)(lds + LDS_MISC + 256); (void)tstart; \
    int bid_ = blockIdx.x, G_ = gridDim.x; asm volatile("" : "+s"(bid_), "+s"(G_)); \
    const int lane = lane_, wave = wave_, tid = wave * 64 + lane, bid = bid_, G = G_, NGW = G_ * NWAVES, gw = bid * NWAVES + wave; (void)lane; (void)wave; (void)tid; (void)bid; (void)gw; (void)G; (void)NGW; \
    unsigned* ctl = (unsigned*)(ws + WS_CTL); (void)ctl; \
    bf16_t* XB = (bf16_t*)(ws + WS_XB); float* XF = (float*)(ws + WS_XF); bf16_t* PROJB = (bf16_t*)(ws + WS_PROJ); (void)XB; (void)XF; (void)PROJB; \
    bf16_t* GOB = (bf16_t*)(ws + WS_GO); bf16_t* LOB = (bf16_t*)(ws + WS_LO); bf16_t* SOB = (bf16_t*)(ws + WS_SO); (void)GOB; (void)LOB; (void)SOB; \
    unsigned char* RM = ws + WS_M; (void)RM; \
    float* AB = (float*)(ws + WS_AB); float* GG = (float*)(ws + WS_GG); float* BT = (float*)(ws + WS_BT); (void)AB; (void)GG; (void)BT; \
    float* GATES = (float*)(ws + WS_GATES); int* ES = (int*)(ws + WS_ES); int* LIST = (int*)(ws + WS_LIST); (void)GATES; (void)ES; (void)LIST; \
    unsigned char* wl = ws + WS_W + (size_t)L * WL_STRIDE; (void)wl; \
    unsigned* cnt = ctl + CW_CNT + 2048 * L; (void)cnt;
    const int lo = a_raw.ph_lo, hi = a_raw.ph_hi;
#if !N_LAUNCH_PER_PHASE
    if (threadIdx.x < 4) MISC[threadIdx.x] = 0u;
    __syncthreads();
    XcdBarrier bar = xcd_barrier_post((unsigned*)(a_raw.ws + WS_CTL) + CW_BAR, MISC);
#ifndef BARDUP
#define BARDUP 1
#endif
#define GRID_BAR(ph) do { if ((ph) + 1 < hi) { for (int bi_ = 0; bi_ < BARDUP; ++bi_) xcd_barrier(bar); } } while (0)
#else
#define GRID_BAR(ph) do { } while (0)
#endif
#define IN(ph) (launder_s(lo) <= (ph) && (ph) < launder_s(hi))
#define STAMP(ph) do { if (PROBE_ON && blockIdx.x == 0 && threadIdx.x == 0) ((unsigned*)(a_raw.ws + WS_CTL))[CW_TS + (ph)] = (unsigned)__builtin_amdgcn_s_memrealtime(); } while (0)

    if (IN(0)) {
        STAMP(0);
        for (int rep_ = 0; rep_ < ((DUPMASK >> 30) & 1) + 1; ++rep_) {
        PH_PTRS(0)
        LAS float* scr = (LAS float*)(lds + wave * 17408);
        for (int Lc = 0; Lc < DEPTH; ++Lc) {
            L = Lc; wl = ws + WS_W + (size_t)L * WL_STRIDE;
            transpose_seg<1>(as_global(a.in[I_WIN]) + (size_t)L * DM * IN_COLS, DM, IN_COLS, PROJ_COLS, (bf16_t*)(wl + W_IN), scr, gw, NGW, lane);
            transpose_seg<0>(as_global(a.in[I_WOG]) + (size_t)L * DM * DM, DM, DM, DM, (bf16_t*)(wl + W_O3), scr, gw, NGW, lane);
            transpose_seg<0>(as_global(a.in[I_WOL]) + (size_t)L * DM * DM, DM, DM, DM, (bf16_t*)(wl + W_O3) + (size_t)DM * DM, scr, gw, NGW, lane);
            transpose_seg<0>(as_global(a.in[I_WOS]) + (size_t)L * DM * DM, DM, DM, DM, (bf16_t*)(wl + W_O3) + (size_t)2 * DM * DM, scr, gw, NGW, lane);
            transpose_seg<0>(as_global(a.in[I_WOUT]) + (size_t)L * DM * DM, DM, DM, DM, (bf16_t*)(wl + W_OUT), scr, gw, NGW, lane);
            transpose_seg<0>(as_global(a.in[I_PLEG]) + (size_t)L * DM * DM, DM, DM, DM, (bf16_t*)(wl + W_PG), scr, gw, NGW, lane);
            transpose_seg<0>(as_global(a.in[I_PLEP]) + (size_t)L * PLE_DIM * DM, PLE_DIM, DM, DM, (bf16_t*)(wl + W_PP), scr, gw, NGW, lane);
            for (int it = gw; it < NEXP * 512; it += NGW) { const int e = it >> 9;
                transpose_item_gu(as_global(a.in[I_WGU]) + ((size_t)L * NEXP + e) * DM * 2048, (bf16_t*)(wl + W_GU) + (size_t)e * 2048 * DM, scr, it & 511, lane); }
            for (int it = gw; it < NEXP * 512; it += NGW) { const int e = it >> 9;
                transpose_item<0>(as_global(a.in[I_WDN]) + ((size_t)L * NEXP + e) * DM * DM, DM, DM, DM, (bf16_t*)(wl + W_DN) + (size_t)e * DM * DM, scr, it & 511, lane); }
            for (int blk = 0; blk < 8; ++blk) {
                transpose_seg<0>(as_global(a.in[I_RGWA]) + ((size_t)L * 8 + blk) * 128 * 128, 128, 128, 128, (bf16_t*)(wl + W_LRU) + (size_t)blk * 256 * 128, scr, gw, NGW, lane);
                transpose_seg<0>(as_global(a.in[I_RGWX]) + ((size_t)L * 8 + blk) * 128 * 128, 128, 128, 128, (bf16_t*)(wl + W_LRU) + (size_t)blk * 256 * 128 + 128 * 128, scr, gw, NGW, lane);
            }
        }
        cvt_rows(as_global(a.in[I_P]), (bf16_t*)(ws + WS_PB), (size_t)DEPTH * NTOK * PLE_DIM, G);
        __syncthreads();
        stage_smallw<4>(as_global(a.in[I_WIN]), IN_COLS, OFF_A, lds, tid);
        __syncthreads();
        unsigned abdep = 0u;
        for (int t0 = gw * 4; t0 < NTOK; t0 += NGW * 4) {
            f32x4 vv[4][4];
#pragma unroll
            for (int u = 0; u < 4; ++u)
#pragma unroll
                for (int j = 0; j < 4; ++j) vv[u][j] = *(const f32x4*)(as_global(a.in[I_X]) + (size_t)(t0 + u) * DM + 256 * j + 4 * lane);
#pragma unroll
            for (int u = 0; u < 4; ++u) store_row(vv[u], nullptr, XB + (size_t)(t0 + u) * DM, lane);
            ab_project4(vv, lds, AB + (size_t)t0 * 16, lane, abdep);
        }
        }
        GRID_BAR(0);
    }

    for (int Lloop = 0; Lloop < DEPTH; ++Lloop) {
        const int pb = 1 + Lloop * NPL;

        if (IN(pb + K_INPROJ)) {
            STAMP(pb + K_INPROJ);
            for (int rep_ = 0; rep_ < NREP(K_INPROJ); ++rep_) {
            PH_PTRS(Lloop)
            pg8::DenseSched S{(const char*)XB, (const char*)(wl + W_IN), NTOK / 256, PROJ_COLS / 256, G, bid, DM};
            pg8::EpiBf16 E{PROJB, PROJ_COLS, nullptr, 0};
            pg8::gemm_phase<pg8::EpiBf16, pg8::DenseSched, true>(lds, DM, S, E, tid);
            }
            GRID_BAR(pb + K_INPROJ);
        }
        if (IN(pb + K_GDNPREP)) {
            STAMP(pb + K_GDNPREP);
            for (int rep_ = 0; rep_ < NREP(K_GDNPREP); ++rep_) {
            PH_PTRS(Lloop)
            LAS unsigned char* wlds = lds + wave * GA_LDS;
#pragma unroll 1
            for (int it = gw; it < NBATCH * 8 * 64; it += NGW) {
                int ln = lane; unsigned char* wsi = ws; unsigned wli = (unsigned)(size_t)wlds; asm volatile("" : "+s"(wli)); asm volatile("" : "+v"(ln)); wsi = as_global(wsi);
                gdn_a_item(a, wsi, L, (LAS unsigned char*)(size_t)wli, it, ln, gw);
            }
            }
            GRID_BAR(pb + K_GDNPREP);
        }
        if (IN(pb + K_GDNREC)) {
            STAMP(pb + K_GDNREC);
            for (int rep_ = 0; rep_ < NREP(K_GDNREC); ++rep_) {
            PH_PTRS(Lloop)
            if (G > NBATCH * 8 + 8) {
                if (bid < NBATCH * 8) gdn_b_scan(ws, lds, bid, tid);
                else { swa_phase(a, ws, L, lds, tid, bid - NBATCH * 8, G - NBATCH * 8); __syncthreads(); lru_l1(a, ws, L, lds, tid, bid - NBATCH * 8, G - NBATCH * 8); }
            } else {
                for (int bh = bid; bh < NBATCH * 8; bh += G) { gdn_b_scan(ws, lds, bh, tid); __syncthreads(); }
                swa_phase(a, ws, L, lds, tid, bid, G); __syncthreads(); lru_l1(a, ws, L, lds, tid, bid, G);
            }
            }
            GRID_BAR(pb + K_GDNREC);
        }
        if (IN(pb + K_GDNPOST)) {
            STAMP(pb + K_GDNPOST);
            for (int rep_ = 0; rep_ < NREP(K_GDNPOST); ++rep_) {
            PH_PTRS(Lloop)
            const bf16_t* OO = (const bf16_t*)(RM + G_OO);
            float nw[16];
            { const float* nwp = as_global(a.in[I_GNW]) + L * 128 + (lane & 7) * 16;
#pragma unroll
              for (int q = 0; q < 4; ++q) { const f32x4 w4 = *(const f32x4*)(nwp + 4 * q); nw[4 * q] = w4[0]; nw[4 * q + 1] = w4[1]; nw[4 * q + 2] = w4[2]; nw[4 * q + 3] = w4[3]; } }
            for (int t0 = gw * 4; t0 < NTOK; t0 += NGW * 4) {
                u32x4 ov[4][2], zv[4][2];
#pragma unroll
                for (int u = 0; u < 4; ++u) { const size_t t = (size_t)(t0 + u);
                    ov[u][0] = *(const u32x4*)(OO + t * DM + 16 * lane); ov[u][1] = *(const u32x4*)(OO + t * DM + 16 * lane + 8);
                    zv[u][0] = *(const u32x4*)(PROJB + t * PROJ_COLS + PJ_Z + 16 * lane); zv[u][1] = *(const u32x4*)(PROJB + t * PROJ_COLS + PJ_Z + 16 * lane + 8); }
#pragma unroll
                for (int u = 0; u < 4; ++u) {
                    const unsigned ow[8] = {ov[u][0].x, ov[u][0].y, ov[u][0].z, ov[u][0].w, ov[u][1].x, ov[u][1].y, ov[u][1].z, ov[u][1].w};
                    const unsigned zw[8] = {zv[u][0].x, zv[u][0].y, zv[u][0].z, zv[u][0].w, zv[u][1].x, zv[u][1].y, zv[u][1].z, zv[u][1].w};
                    float ss = 0.f;
#pragma unroll
                    for (int q = 0; q < 8; ++q) { ss = fmaf(bflo(ow[q]), bflo(ow[q]), ss); ss = fmaf(bfhi(ow[q]), bfhi(ow[q]), ss); }
                    ss += __shfl_xor(ss, 1); ss += __shfl_xor(ss, 2); ss += __shfl_xor(ss, 4);
                    const float rr = rsqrtf(ss * (1.0f / 128.0f) + 1e-6f);
                    unsigned res[8];
#pragma unroll
                    for (int q = 0; q < 8; ++q) res[q] = pk2(bflo(ow[q]) * rr * nw[2 * q] * siluf_(bflo(zw[q])), bfhi(ow[q]) * rr * nw[2 * q + 1] * siluf_(bfhi(zw[q])));
                    bf16_t* gp = GOB + (size_t)(t0 + u) * DM + 16 * lane;
                    *(u32x4*)gp = (u32x4){res[0], res[1], res[2], res[3]}; *(u32x4*)(gp + 8) = (u32x4){res[4], res[5], res[6], res[7]};
                }
            }
            {
                const bf16_t* HL = (const bf16_t*)(ws + WS_XF); const float* AGG = (const float*)(RM + LRM_AGG);
                LAS float* cl = (LAS float*)lds;
                for (int it = bid; it < NBATCH * 32; it += G) {
                    const int b = it >> 5, chunk = it & 31;
                    float c0 = 0.f, c1 = 0.f;
                    const float* ap = AGG + ((size_t)(b * 32) * 1024 + 2 * tid) * 2;
#pragma unroll 8
                    for (int cp = 0; cp < chunk; ++cp) { const f32x4 ag = *(const f32x4*)(ap + (size_t)cp * 2048); c0 = fmaf(ag[0], c0, ag[1]); c1 = fmaf(ag[2], c1, ag[3]); }
                    *(LAS f32x2*)(cl + 2 * tid) = (f32x2){c0, c1};
                    __syncthreads();
                    for (int i = tid; i < 128 * 128; i += 512) {
                        const size_t t = (size_t)b * SEQ + (size_t)chunk * 128 + (i >> 7); const int c8 = (i & 127) * 8;
                        const u32x4 h4 = *(const u32x4*)(HL + t * DM + c8), p4 = *(const u32x4*)(LOB + t * DM + c8), g4 = *(const u32x4*)(PROJB + t * PROJ_COLS + PJ_GL + c8);
                        const f32x4 ca = *(const LAS f32x4*)(cl + c8), cb = *(const LAS f32x4*)(cl + c8 + 4);
                        const unsigned hw[4] = {h4.x, h4.y, h4.z, h4.w}, pw[4] = {p4.x, p4.y, p4.z, p4.w}, gw4[4] = {g4.x, g4.y, g4.z, g4.w};
                        const float cc[8] = {ca[0], ca[1], ca[2], ca[3], cb[0], cb[1], cb[2], cb[3]};
                        unsigned ow[4];
#pragma unroll
                        for (int q = 0; q < 4; ++q) {
                            const float v0 = fmaf(bflo(pw[q]), cc[2 * q], bflo(hw[q])) * gelu_tanhf_(bflo(gw4[q]));
                            const float v1 = fmaf(bfhi(pw[q]), cc[2 * q + 1], bfhi(hw[q])) * gelu_tanhf_(bfhi(gw4[q]));
                            ow[q] = pk2(v0, v1);
                        }
                        *(u32x4*)(LOB + t * DM + c8) = (u32x4){ow[0], ow[1], ow[2], ow[3]};
                    }
                    __syncthreads();
                }
            }
            }
            GRID_BAR(pb + K_GDNPOST);
        }
        if (IN(pb + K_BRANCH)) {
            STAMP(pb + K_BRANCH);
            for (int rep_ = 0; rep_ < NREP(K_BRANCH); ++rep_) {
            PH_PTRS(Lloop)
            pg8::BranchSched S{(const char*)GOB, (const char*)LOB, (const char*)SOB, (const char*)(wl + W_O3), G, bid};
            pg8::EpiBranch E{(bf16_t*)(RM + M_MRG), (bf16_t*)(RM + M_MRG + 64 * MiB), (bf16_t*)(RM + M_MRGB), PROJB};
            pg8::gemm_phase<pg8::EpiBranch, pg8::BranchSched, true>(lds, DM, S, E, tid);
            }
            GRID_BAR(pb + K_BRANCH);
        }
        if (IN(pb + K_WOUT)) {
            STAMP(pb + K_WOUT);
            for (int rep_ = 0; rep_ < NREP(K_WOUT); ++rep_) {
            PH_PTRS(Lloop)
            pg8::DenseSched S{(const char*)(RM + M_MRGB), (const char*)(wl + W_OUT), NTOK / 256, DM / 256, G, bid, DM};
            pg8::EpiBf16 E{(bf16_t*)(RM + M_YY), DM, nullptr, 0};
            pg8::gemm_phase<pg8::EpiBf16, pg8::DenseSched, true>(lds, DM, S, E, tid);
            }
            GRID_BAR(pb + K_WOUT);
        }
        if (IN(pb + K_LN1)) {
            STAMP(pb + K_LN1);
            for (int rep_ = 0; rep_ < NREP(K_LN1); ++rep_) {
            PH_PTRS(Lloop)
            const bf16_t* YY = (const bf16_t*)(RM + M_YY);
            stage_smallw<8>(as_global(a.in[I_RW]) + (size_t)L * DM * NEXP, NEXP, 0, lds, tid);
            const float rbvA = as_global(a.in[I_RB])[L * NEXP + (lane >> 2)], rbvB = as_global(a.in[I_RB])[L * NEXP + 16 + (lane >> 2)];
            LAS unsigned* rt_lcnt = (LAS unsigned*)(lds + 131072); LAS unsigned* rt_base = rt_lcnt + 32; LAS int* rt_n = (LAS int*)(rt_lcnt + 64);
            LAS int* rt_tokall = (LAS int*)(rt_lcnt + 128); LAS int* rt_esall = rt_tokall + 512;
            LAS int* rt_tok = rt_tokall + wave * 64; LAS int* rt_es = rt_esall + wave * 64;
            if (tid < 64) rt_lcnt[tid] = 0u;
            int nloc = 0; unsigned rdep = 0u;
            __syncthreads();
            for (int t0 = gw * 4; t0 < NTOK; t0 += NGW * 4) {
                f32x4 vv[4][4];
#pragma unroll
                for (int u = 0; u < 4; ++u)
#pragma unroll
                    for (int j = 0; j < 4; ++j) vv[u][j] = ld_bf4(XB + (size_t)(t0 + u) * DM + 256 * j + 4 * lane) * ALPHA + ld_bf4(YY + (size_t)(t0 + u) * DM + 256 * j + 4 * lane);
#pragma unroll
                for (int u = 0; u < 4; ++u) {
                    ln_inplace(vv[u], as_global(a.in[I_LN1G]) + L * DM, as_global(a.in[I_LN1B]) + L * DM, lane);
                    store_row(vv[u], nullptr, XB + (size_t)(t0 + u) * DM, lane);
                }
                float mine4[4];
                {
                    float acc[4][16];
                    small_project4<4>(vv, lds + rdep, acc, lane);
#pragma unroll
                    for (int u = 0; u < 4; ++u) { const float s = reduce_scatter16(acc[u], lane); mine4[u] = s + rbvA; }
                    asm volatile("" : "+v"(rdep) : "v"(mine4[0]), "v"(mine4[1]), "v"(mine4[2]), "v"(mine4[3]));
                    small_project4<4>(vv, lds + 65536 + rdep, acc, lane);
#pragma unroll
                    for (int u = 0; u < 4; ++u) { const float s = reduce_scatter16(acc[u], lane); mine4[u] = (lane & 3) == 0 ? mine4[u] : ((lane & 3) == 1 ? s + rbvB : -INFINITY); }
                }
#pragma unroll
                for (int uu = 0; uu < 4; ++uu) {
                const int t = t0 + uu;
                float mine = mine4[uu];
                float tv[4]; int ti[4];
#pragma unroll
                for (int k = 0; k < 4; ++k) {
                    const float mx = wave_max(mine);
                    const unsigned long long bal = __ballot(mine == mx), balA = bal & 0x1111111111111111ull;
                    const int idx = __ffsll((long long)(balA ? balA : bal)) - 1;
                    tv[k] = mx; ti[k] = (idx >> 2) + ((idx & 1) << 4);
                    if (lane == idx) mine = -INFINITY;
                }
                if (lane == 0 && rep_ == 0) {
                    const float e1 = expf(tv[1] - tv[0]), e2 = expf(tv[2] - tv[0]), e3 = expf(tv[3] - tv[0]);
                    const float inv = 1.0f / (1.0f + e1 + e2 + e3);
                    *(f32x4*)(GATES + (size_t)t * 4) = (f32x4){inv, e1 * inv, e2 * inv, e3 * inv};
#pragma unroll
                    for (int k = 0; k < 4; ++k) {
                        const int ls = (int)__hip_atomic_fetch_add((LAS unsigned*)(rt_lcnt + ti[k]), 1u, __ATOMIC_RELAXED, __HIP_MEMORY_SCOPE_WORKGROUP);
                        rt_tok[nloc * 4 + k] = t; rt_es[nloc * 4 + k] = ti[k] | (ls << 5);
                    }
                }
                asm volatile("" : "+v"(rdep) : "v"(ti[3]));
                ++nloc;
                }
            }
            if (lane == 0) rt_n[wave] = nloc;
            __syncthreads();
            if (rep_ == 0) {
                if (tid < NEXP) { const unsigned c = rt_lcnt[tid]; rt_base[tid] = c ? atomicAdd(&cnt[64 * tid], c) : 0u; }
                __syncthreads();
                for (int i = tid; i < 8 * 16 * 4; i += 512) {
                    const int w = i >> 6, j = (i >> 2) & 15;
                    if (j < rt_n[w]) { const int es = rt_esall[i], e = es & 31, slot = (int)rt_base[e] + (es >> 5), t = rt_tokall[i];
                        ES[t * 4 + (i & 3)] = e | (slot << 5); LIST[(size_t)e * NTOK + slot] = t; }
                }
            }
            }
            GRID_BAR(pb + K_LN1);
        }
        if (IN(pb + K_MOE1) || IN(pb + K_MOE2) || IN(pb + K_LN2)) {
            PH_PTRS(Lloop)
            __syncthreads();
            if (tid == 0) { int accu = 0; for (int e = 0; e < NEXP; ++e) { const int ce = (int)__hip_atomic_load(&cnt[64 * e], __ATOMIC_RELAXED, __HIP_MEMORY_SCOPE_AGENT); tstart[e] = accu; tstart[64 + e] = ce; accu += (ce + 255) >> 8; } tstart[NEXP] = accu; }
            __syncthreads();
        }
        if (IN(pb + K_MOE1)) {
            STAMP(pb + K_MOE1);
            for (int rep_ = 0; rep_ < NREP(K_MOE1); ++rep_) {
            PH_PTRS(Lloop)
            pg8::MoeGatherSched S{(const char*)XB, (const char*)(wl + W_GU), tstart, (size_t)2048 * DM * 2, 8, G, bid, (const char*)XB, LIST, tstart + 128, tstart + 64};
            pg8::EpiSwiglu E{(bf16_t*)(ws + WS_PROJ + PJ_H), as_global(a.in[I_BGU]) + (size_t)L * NEXP * 2048};
            pg8::gemm_phase<pg8::EpiSwiglu, pg8::MoeGatherSched, true>(lds, DM, S, E, tid);
            }
            GRID_BAR(pb + K_MOE1);
        }
        if (IN(pb + K_MOE2)) {
            STAMP(pb + K_MOE2);
            for (int rep_ = 0; rep_ < NREP(K_MOE2); ++rep_) {
            PH_PTRS(Lloop)
            pg8::MoeSched S{(const char*)(ws + WS_PROJ + PJ_H), (const char*)(wl + W_DN), tstart, (size_t)DM * DM * 2, 4, G, bid, nullptr, nullptr, nullptr, nullptr};
            pg8::EpiBf16 E{(bf16_t*)(ws + WS_PROJ + PJ_OB), DM, as_global(a.in[I_BDN]) + (size_t)L * NEXP * DM, DM};
            pg8::gemm_phase<pg8::EpiBf16, pg8::MoeSched, true>(lds, DM, S, E, tid);
            {
                PH_PTRS(Lloop)
                pg8::DenseSched S2{(const char*)(ws + WS_PB) + (size_t)L * NTOK * PLE_DIM * 2, (const char*)(wl + W_PP), NTOK / 256, DM / 256, G, bid, PLE_DIM};
                pg8::EpiBf16 E2{(bf16_t*)(RM + M_PP), DM, nullptr, 0};
                pg8::gemm_phase<pg8::EpiBf16, pg8::DenseSched, true>(lds, PLE_DIM, S2, E2, tid);
            }
            }
            GRID_BAR(pb + K_MOE2);
        }
        if (IN(pb + K_LN2)) {
            STAMP(pb + K_LN2);
            for (int rep_ = 0; rep_ < NREP(K_LN2); ++rep_) {
            PH_PTRS(Lloop)
            const bf16_t* OB = (const bf16_t*)(ws + WS_PROJ + PJ_OB);
            for (int t0 = gw * 2; t0 < NTOK; t0 += NGW * 2) {
                f32x4 vv[2][4]; u32x2 yy[2][4][4]; f32x4 gk4[2];
#pragma unroll
                for (int u = 0; u < 2; ++u) {
                    const int t = t0 + u;
                    gk4[u] = *(const f32x4*)(GATES + (size_t)t * 4);
#pragma unroll
                    for (int k = 0; k < 4; ++k) { const int es = ES[t * 4 + k]; const size_t row = (size_t)tstart[es & 31] * 256 + (es >> 5);
#pragma unroll
                        for (int j = 0; j < 4; ++j) yy[u][k][j] = *(const u32x2*)(OB + row * DM + 256 * j + 4 * lane); }
#pragma unroll
                    for (int j = 0; j < 4; ++j) vv[u][j] = ld_bf4(XB + (size_t)t * DM + 256 * j + 4 * lane) * ALPHA;
                }
#pragma unroll
                for (int u = 0; u < 2; ++u) {
                    const int t = t0 + u; f32x4 (&v)[4] = vv[u];
#pragma unroll
                    for (int k = 0; k < 4; ++k)
#pragma unroll
                        for (int j = 0; j < 4; ++j) { const u32x2 y2 = yy[u][k][j]; v[j] += (f32x4){bflo(y2.x), bfhi(y2.x), bflo(y2.y), bfhi(y2.y)} * gk4[u][k]; }
                    ln_inplace(v, as_global(a.in[I_LN2G]) + L * DM, as_global(a.in[I_LN2B]) + L * DM, lane);
                    store_row(v, nullptr, XB + (size_t)t * DM, lane);
                }
            }
            }
            GRID_BAR(pb + K_LN2);
        }
        if (IN(pb + K_PLEG)) {
            STAMP(pb + K_PLEG);
            for (int rep_ = 0; rep_ < NREP(K_PLEG); ++rep_) {
            PH_PTRS(Lloop)
            pg8::DenseSched S{(const char*)XB, (const char*)(wl + W_PG), NTOK / 256, DM / 256, G, bid, DM};
            pg8::EpiPle E{(bf16_t*)(RM + M_PLEO), (const bf16_t*)(RM + M_PP)};
            pg8::gemm_phase<pg8::EpiPle, pg8::DenseSched, true>(lds, DM, S, E, tid);
            }
            GRID_BAR(pb + K_PLEG);
        }
        if (IN(pb + K_LN3)) {
            STAMP(pb + K_LN3);
            for (int rep_ = 0; rep_ < NREP(K_LN3); ++rep_) {
            PH_PTRS(Lloop)
            const bf16_t* PLEO = (const bf16_t*)(RM + M_PLEO);
            float probe_scale = 1.0f;
            if (PROBE_ON && L + 1 == DEPTH) {
                const unsigned* ts = ctl + CW_TS; unsigned dt = 0u;
                if (PROBE_A < 0) dt = ts[1] - ts[0];
                else if (PROBE_B >= NPL) dt = 2u * (ts[1 + NPL] - ts[1 + PROBE_A]);
                else dt = (ts[1 + PROBE_B] - ts[1 + PROBE_A]) + (ts[1 + NPL + PROBE_B] - ts[1 + NPL + PROBE_A]);
                const unsigned us = dt / 100u, q = (us / 4u) * 4u;
                probe_scale = 1.0f + sqrtf(1.0e-6f * (float)q);
            }
            if (L + 1 < DEPTH) { stage_smallw<4>(as_global(a.in[I_WIN]) + (size_t)(L + 1) * DM * IN_COLS, IN_COLS, OFF_A, lds, tid); __syncthreads(); }
            unsigned abdep = 0u;
            for (int t0 = gw * 4; t0 < NTOK; t0 += NGW * 4) {
                f32x4 vv[4][4];
#pragma unroll
                for (int u = 0; u < 4; ++u)
#pragma unroll
                    for (int j = 0; j < 4; ++j) vv[u][j] = ld_bf4(XB + (size_t)(t0 + u) * DM + 256 * j + 4 * lane) * ALPHA + ld_bf4(PLEO + (size_t)(t0 + u) * DM + 256 * j + 4 * lane);
#pragma unroll
                for (int u = 0; u < 4; ++u) {
                    const int t = t0 + u; f32x4 (&v)[4] = vv[u];
                    ln_inplace(v, as_global(a.in[I_LN3G]) + L * DM, as_global(a.in[I_LN3B]) + L * DM, lane);
                    if (PROBE_ON && L + 1 == DEPTH) {
#pragma unroll
                        for (int j = 0; j < 4; ++j) v[j] = v[j] * probe_scale;
                    }
                    store_row(v, (L + 1 < DEPTH) ? nullptr : as_global(a.out) + (size_t)t * DM, XB + (size_t)t * DM, lane);
                }
                if (L + 1 < DEPTH) ab_project4(vv, lds, AB + (size_t)t0 * 16, lane, abdep);
            }
            }
            GRID_BAR(pb + K_LN3);
        }
    }
#undef IN
#undef GRID_BAR
}

extern "C" void kernel_launch(void* const* d_in, const int* in_sizes, int n_in, void* d_out, int out_size, void* d_ws, size_t ws_size, hipStream_t stream) {
    static int grid = 0;
    if (grid == 0) {
        int dev = 0, cus = 0;
        if (hipGetDevice(&dev) != hipSuccess || hipDeviceGetAttribute(&cus, hipDeviceAttributeMultiprocessorCount, dev) != hipSuccess) cus = 256;
        (void)hipFuncSetAttribute((const void*)mega, hipFuncAttributeMaxDynamicSharedMemorySize, LDS_BYTES);
        grid = cus > 0 ? cus : 256;
    }
    if (n_in < 34 || ws_size < WS_END) return;
    (void)in_sizes; (void)out_size;
    (void)hipMemsetAsync((char*)d_ws + WS_CTL, 0, 1 * MiB, stream);
    MArgs a; memset(&a, 0, sizeof a);
    for (int i = 0; i < 34; ++i) a.in[i] = (const float*)d_in[i];
    a.out = (float*)d_out; a.ws = (unsigned char*)d_ws;
#if N_LAUNCH_PER_PHASE
    unsigned char* ws = (unsigned char*)d_ws;
    for (int ph = 0; ph < NPHASES; ++ph) {
        const int L = (ph - 1) / NPL, k = (ph - 1) % NPL;
        a.ph_lo = ph; a.ph_hi = ph + 1; hipLaunchKernelGGL(mega, dim3(grid), dim3(NWAVES * 64), LDS_BYTES, stream, a);
    }
#else
    a.ph_lo = 0; a.ph_hi = NPHASES; hipLaunchKernelGGL(mega, dim3(grid), dim3(NWAVES * 64), LDS_BYTES, stream, a);
#endif
}
```

```cpp
#include <hip/hip_runtime.h>
#include <stdint.h>
#include <string.h>

#ifndef DUPMASK
#define DUPMASK 0u
#endif
#define NREP(k) ((int)((DUPMASK >> (k)) & 1u) + 1)
#ifndef PROBE_ON
#define PROBE_ON 0
#endif
#ifndef PROBE_A
#define PROBE_A 0
#endif
#ifndef PROBE_B
#define PROBE_B 1
#endif
#ifndef N_LAUNCH_PER_PHASE
#define N_LAUNCH_PER_PHASE 0
#endif

#define DM 1024
#define SEQ 4096
#define NBATCH 8
#define DEPTH 2
#define PLE_DIM 256
#define IN_COLS 10768
#define OFF_A 4096
#define NEXP 32
#define ALPHA 1.4142135623730951f
#define NTOK (NBATCH * SEQ)
#define PROJ_COLS 10752
#define PJ_Q 0
#define PJ_K 1024
#define PJ_V 2048
#define PJ_Z 3072
#define PJ_XL 4096
#define PJ_GL 5120
#define PJ_QC 6144
#define PJ_KC 7168
#define PJ_VC 7424
#define PJ_GATES 7680
#define MOE_ROWS (NTOK * 4 + NEXP * 256)

#define LAS __attribute__((address_space(3)))
#define CAS __attribute__((address_space(4)))
typedef unsigned short bf16_t;
typedef short bf16x8 __attribute__((ext_vector_type(8)));
typedef float f32x4 __attribute__((ext_vector_type(4)));
typedef float f32x2 __attribute__((ext_vector_type(2)));
typedef unsigned u32x4 __attribute__((ext_vector_type(4)));
typedef unsigned u32x2 __attribute__((ext_vector_type(2)));

__device__ __forceinline__ float fexp(float x) { return __builtin_amdgcn_exp2f(1.4426950408889634f * x); }
__device__ __forceinline__ float sigmoidf_(float x) { return __builtin_amdgcn_rcpf(1.0f + __builtin_amdgcn_exp2f(-1.4426950408889634f * x)); }
__device__ __forceinline__ float siluf_(float x) { return x * sigmoidf_(x); }
__device__ __forceinline__ float softplusf_(float x) { return fmaxf(x, 0.f) + log1pf(expf(-fabsf(x))); }
__device__ __forceinline__ float gelu_tanhf_(float x) {
    const float y = 0.7978845608028654f * (x + 0.044715f * x * x * x);
    return x * (1.0f - __builtin_amdgcn_rcpf(1.0f + __builtin_amdgcn_exp2f(2.8853900817779268f * y)));
}
template <int CTRL> __device__ __forceinline__ float dpp_(float x) { return __builtin_bit_cast(float, __builtin_amdgcn_mov_dpp(__builtin_bit_cast(int, x), CTRL, 0xf, 0xf, true)); }
__device__ __forceinline__ float wave_sum(float v) {
    v += dpp_<0xB1>(v); v += dpp_<0x4E>(v); v += dpp_<0x141>(v); v += dpp_<0x140>(v);
    { auto s = __builtin_amdgcn_permlane16_swap(__float_as_uint(v), __float_as_uint(v), false, false); v = __uint_as_float(s[0]) + __uint_as_float(s[1]); }
    { auto s = __builtin_amdgcn_permlane32_swap(__float_as_uint(v), __float_as_uint(v), false, false); v = __uint_as_float(s[0]) + __uint_as_float(s[1]); }
    return v;
}
__device__ __forceinline__ float wave_max(float v) {
    v = fmaxf(v, dpp_<0xB1>(v)); v = fmaxf(v, dpp_<0x4E>(v)); v = fmaxf(v, dpp_<0x141>(v)); v = fmaxf(v, dpp_<0x140>(v));
    { auto s = __builtin_amdgcn_permlane16_swap(__float_as_uint(v), __float_as_uint(v), false, false); v = fmaxf(__uint_as_float(s[0]), __uint_as_float(s[1])); }
    { auto s = __builtin_amdgcn_permlane32_swap(__float_as_uint(v), __float_as_uint(v), false, false); v = fmaxf(__uint_as_float(s[0]), __uint_as_float(s[1])); }
    return v;
}
typedef __bf16 bf16x2_t __attribute__((ext_vector_type(2)));
__device__ __forceinline__ unsigned cvtpk(float lo, float hi) { const f32x2 v = {lo, hi}; const bf16x2_t b = __builtin_convertvector(v, bf16x2_t); return __builtin_bit_cast(unsigned, b); }
__device__ __forceinline__ unsigned f2bf(float f) { return cvtpk(f, f) & 0xffffu; }
__device__ __forceinline__ unsigned pk2(float lo, float hi) { return cvtpk(lo, hi); }
template <class T> __device__ __forceinline__ T* as_global(T* p) {
    __attribute__((address_space(1))) T* g = (__attribute__((address_space(1))) T*)p; asm volatile("" : "+s"(g)); return (T*)g; }
__device__ __forceinline__ float bf2f(unsigned short b) { return __builtin_bit_cast(float, ((unsigned)b) << 16); }
__device__ __forceinline__ float bflo(unsigned u) { return __builtin_bit_cast(float, u << 16); }
__device__ __forceinline__ float bfhi(unsigned u) { return __builtin_bit_cast(float, u & 0xffff0000u); }

namespace pg8 {
constexpr int BM = 256, BK = 64, HALF = 128, HTB = HALF * BK * 2, STAGE_BYTES = 8 * HTB, NXCD = 8, WGM = 8;
__host__ __device__ __forceinline__ int lds_byte(int r, int c) { const int st = (r >> 4) * 2 + (c >> 5), rr = r & 15, cc = c & 31, ob = rr * 64 + cc * 2; return st * 1024 + (ob ^ (((ob >> 9) & 1) << 5)); }
__host__ __device__ __forceinline__ void stage_rc(int b, int& R, int& C) { const int st = b / 1024, sb = b % 1024, swz = sb ^ (((sb >> 9) & 1) << 5); R = (st >> 1) * 16 + swz / 64; C = (st & 1) * 32 + (swz % 64) / 2; }
__host__ __device__ __forceinline__ int perm32(int rho) { const int n = rho >> 4, i = rho & 15; return 8 * (i >> 2) + 4 * n + (i & 3); }
__device__ __forceinline__ unsigned cvt_pk_bf16(float lo, float hi) { unsigned r; asm volatile("v_cvt_pk_bf16_f32 %0, %1, %2" : "=v"(r) : "v"(lo), "v"(hi)); return r; }

struct Unit { const char* A; const char* B; int row0, col0, e, aux; };

__device__ __forceinline__ bool static_tile(int i, int G, int c, int nM, int nN, int& pm, int& pn) {
    const int nwg = nM * nN; const long L = (long)i * G + c; if (L >= nwg) return false;
    int wgid = (int)L; { const int q = nwg / NXCD, r = nwg % NXCD, xcd = wgid % NXCD, off = wgid / NXCD; wgid = (xcd < r ? xcd * (q + 1) : r * (q + 1) + (xcd - r) * q) + off; }
    const int nig = WGM * nN, gid = wgid / nig, fm = gid * WGM, gsz = (nM - fm) < WGM ? (nM - fm) : WGM;
    pm = fm + ((wgid % nig) % gsz); pn = (wgid % nig) / gsz; return true;
}

template <class Epi, class Sched, bool ALIGN_EPI>
__device__ __forceinline__ void gemm_phase(LAS unsigned char* lds, const int K, const Sched& S, const Epi& E, const int tid) {
    const int wid = __builtin_amdgcn_readfirstlane(tid >> 6), lane = tid & 63, wr = wid >> 2, wc = wid & 3, fr = lane & 15, fq = lane >> 4;
    const int nt = K / BK;
    unsigned voffA[2], voffB[2];
    int gR[2]; unsigned gC[2];
#pragma unroll
    for (int i = 0; i < 2; ++i) { int R, C; stage_rc(tid * 16 + i * 8192, R, C); const int Rb = (R & ~31) + perm32(R & 31);
        voffA[i] = (unsigned)(R * K + C) * 2u; voffB[i] = (unsigned)(Rb * K + C) * 2u; gR[i] = R; gC[i] = (unsigned)C * 2u; }
    unsigned oc[2][2] = {{0u, 0u}, {0u, 0u}}, on[2][2] = {{0u, 0u}, {0u, 0u}};
    const size_t kstep = (size_t)(BK * 2);
    const size_t hstep = (size_t)HALF * K * 2;
    const unsigned ldsw = (unsigned)wid * 1024u;
    const int aoff = lds_byte(wr * 64 + fr, fq * 8), boff = lds_byte(wc * 32 + fr, fq * 8);
#define PG8_SA(b, h) (((b) * 2 + (h)) * HTB)
#define PG8_SB(b, h) ((4 + (b) * 2 + (h)) * HTB)
#define PG8_STAGE(bufoff, gbase, voff) do { _Pragma("unroll") for (int _i = 0; _i < 2; ++_i) \
        __builtin_amdgcn_global_load_lds((const unsigned*)((const char*)(gbase) + (voff)[_i]), (LAS unsigned*)(lds + (bufoff) + ldsw + _i * 8192), 16, 0, 0); } while (0)
#define PG8_STAGE_A(bufoff, dptr, koff, half, usenext) do { if constexpr (Sched::GATHER) { const char* _gb = S.Abase + (koff); \
        if (usenext) PG8_STAGE(bufoff, _gb, on[half]); else PG8_STAGE(bufoff, _gb, oc[half]); } else { PG8_STAGE(bufoff, (dptr) + (half) * hstep, voffA); } } while (0)
#define PG8_GOFF(dst, u, bufi) do { const int _cn = S.cntl[(u).e]; _Pragma("unroll") for (int _h = 0; _h < 2; ++_h) _Pragma("unroll") for (int _i = 0; _i < 2; ++_i) { \
        const int _r = _h * 128 + gR[_i]; const int _tok = ((u).aux + _r < _cn) ? S.tab[(bufi) * 256 + _r] : 0; dst[_h][_i] = (unsigned)_tok * (unsigned)(K * 2) + gC[_i]; } } while (0)
#define PG8_TABDMA(u, bufi) do { if (wid < 4) __builtin_amdgcn_global_load_lds((const unsigned*)(S.list + (size_t)(u).e * NTOK + (u).aux + wid * 64 + lane), (LAS unsigned*)(S.tab + (bufi) * 256 + wid * 64), 4, 0, 0); } while (0)
#define PG8_LDA(dst, b, h) do { _Pragma("unroll") for (int m = 0; m < 4; ++m) _Pragma("unroll") for (int k = 0; k < 2; ++k) dst[m][k] = *(const LAS bf16x8*)(lds + PG8_SA(b, h) + aoff + m * 2048 + k * 1024); } while (0)
#define PG8_LDB(dst, b, h) do { _Pragma("unroll") for (int n = 0; n < 2; ++n) _Pragma("unroll") for (int k = 0; k < 2; ++k) dst[n][k] = *(const LAS bf16x8*)(lds + PG8_SB(b, h) + boff + n * 2048 + k * 1024); } while (0)
#define PG8_MMA(ai, bj, At, Bt) do { __builtin_amdgcn_s_setprio(1); _Pragma("unroll") for (int m = 0; m < 4; ++m) _Pragma("unroll") for (int n = 0; n < 2; ++n) _Pragma("unroll") for (int k = 0; k < 2; ++k) \
        acc[ai][bj][m][n] = __builtin_amdgcn_mfma_f32_16x16x32_bf16(Bt[n][k], At[m][k], acc[ai][bj][m][n], 0, 0, 0); __builtin_amdgcn_s_setprio(0); } while (0)
#define PG8_WAIT_V(n) asm volatile("s_waitcnt vmcnt(" #n ")" ::: "memory")
#define PG8_WAIT_L(n) asm volatile("s_waitcnt lgkmcnt(" #n ")" ::: "memory")
#define PG8_BAR __builtin_amdgcn_s_barrier()
#define PG8_SCHED __builtin_amdgcn_sched_barrier(0)
    Unit cur, nxt; int ui = 0;
    if (!S.next(0, cur)) return;
    f32x4 acc[2][2][4][2];
#pragma unroll
    for (int a = 0; a < 2; ++a)
#pragma unroll
        for (int b = 0; b < 2; ++b)
#pragma unroll
            for (int m = 0; m < 4; ++m)
#pragma unroll
                for (int n = 0; n < 2; ++n) acc[a][b][m][n] = (f32x4){0.f, 0.f, 0.f, 0.f};
    bf16x8 At[4][2], B0[2][2], B1[2][2];
    const char* cA = cur.A; const char* cB = cur.B;
    if constexpr (Sched::GATHER) { PG8_TABDMA(cur, 0); PG8_WAIT_V(0); PG8_BAR; PG8_GOFF(oc, cur, 0); }
    PG8_STAGE(PG8_SB(0, 0), cB, voffB); PG8_STAGE(PG8_SB(0, 1), cB + hstep, voffB); PG8_STAGE_A(PG8_SA(0, 0), cA, 0, 0, false); PG8_STAGE_A(PG8_SA(0, 1), cA, 0, 1, false);
    if (wr == 1) PG8_BAR;
    PG8_WAIT_V(2); PG8_BAR;
    PG8_STAGE(PG8_SB(1, 0), cB + kstep, voffB); PG8_STAGE_A(PG8_SA(1, 0), cA + kstep, kstep, 0, false); PG8_STAGE(PG8_SB(1, 1), cB + hstep + kstep, voffB);
    PG8_WAIT_V(6); PG8_BAR;
    for (;;) {
        const bool has_next = S.next(ui + 1, nxt);
        const char* nA = has_next ? nxt.A : cA; const char* nB = has_next ? nxt.B : cB;
        if constexpr (Sched::GATHER) { if (has_next) PG8_TABDMA(nxt, (ui + 1) & 1); }
        for (int t = 0; t < nt; t += 2) {
            const bool last = (t == nt - 2);
            const char* a1 = cA + (size_t)(t + 1) * kstep;
            const char* a2 = last ? nA : cA + (size_t)(t + 2) * kstep; const char* b2 = last ? nB : cB + (size_t)(t + 2) * kstep;
            const char* a3 = a2 + kstep; const char* b3 = b2 + kstep;
            const size_t k2 = last ? 0 : (size_t)(t + 2) * kstep, k3 = k2 + kstep;
            const bool un = last && has_next;
            if constexpr (Sched::GATHER) { if (un) PG8_GOFF(on, nxt, (ui + 1) & 1); }
            PG8_LDB(B0, 0, 0); PG8_LDB(B1, 0, 1); PG8_SCHED; PG8_LDA(At, 0, 0); PG8_STAGE_A(PG8_SA(1, 1), a1, (size_t)(t + 1) * kstep, 1, false);
            PG8_WAIT_V(8); PG8_WAIT_L(0); PG8_BAR; PG8_MMA(0, 0, At, B0); PG8_MMA(0, 1, At, B1); PG8_BAR; PG8_SCHED;
            PG8_LDA(At, 0, 1); PG8_STAGE(PG8_SB(0, 0), b2, voffB); PG8_STAGE(PG8_SB(0, 1), b2 + hstep, voffB); PG8_STAGE_A(PG8_SA(0, 0), a2, k2, 0, un);
            PG8_WAIT_V(8); PG8_WAIT_L(0); PG8_BAR; PG8_MMA(1, 0, At, B0); PG8_MMA(1, 1, At, B1); PG8_BAR; PG8_SCHED;
            PG8_LDB(B0, 1, 0); PG8_LDB(B1, 1, 1); PG8_SCHED; PG8_LDA(At, 1, 0); PG8_STAGE_A(PG8_SA(0, 1), a2, k2, 1, un);
            PG8_WAIT_V(8); PG8_WAIT_L(0); PG8_BAR; PG8_MMA(0, 0, At, B0); PG8_MMA(0, 1, At, B1); PG8_BAR; PG8_SCHED;
            PG8_LDA(At, 1, 1); PG8_STAGE(PG8_SB(1, 0), b3, voffB); PG8_STAGE(PG8_SB(1, 1), b3 + hstep, voffB); PG8_STAGE_A(PG8_SA(1, 0), a3, k3, 0, un);
            PG8_WAIT_V(8); PG8_WAIT_L(0); PG8_BAR; PG8_MMA(1, 0, At, B0); PG8_MMA(1, 1, At, B1); PG8_BAR; PG8_SCHED;
        }
        if constexpr (ALIGN_EPI) { if (wr == 0) PG8_BAR; }
        E(acc, cur, wr, wc, fr, fq);
        if (!has_next) break;
#pragma unroll
        for (int a = 0; a < 2; ++a)
#pragma unroll
            for (int b = 0; b < 2; ++b)
#pragma unroll
                for (int m = 0; m < 4; ++m)
#pragma unroll
                    for (int n = 0; n < 2; ++n) acc[a][b][m][n] = (f32x4){0.f, 0.f, 0.f, 0.f};
        cur = nxt; cA = nA; cB = nB; ++ui;
        if constexpr (Sched::GATHER) { oc[0][0] = on[0][0]; oc[0][1] = on[0][1]; oc[1][0] = on[1][0]; oc[1][1] = on[1][1]; }
        if constexpr (ALIGN_EPI) { if (wr == 1) PG8_BAR; }
    }
    PG8_WAIT_V(0);
    if constexpr (!ALIGN_EPI) { if (wr == 0) PG8_BAR; }
    PG8_BAR;
#undef PG8_SA
#undef PG8_SB
#undef PG8_STAGE
#undef PG8_STAGE_A
#undef PG8_GOFF
#undef PG8_TABDMA
#undef PG8_LDA
#undef PG8_LDB
#undef PG8_MMA
#undef PG8_WAIT_V
#undef PG8_WAIT_L
#undef PG8_BAR
#undef PG8_SCHED
}

struct DenseSched {
    static constexpr bool GATHER = false;
    const char* A; const char* Bt; int nM, nN, G, c, K;
    const char* Abase = nullptr; const int* list = nullptr; const LAS int* tab = nullptr; const LAS int* cntl = nullptr;
    __device__ __forceinline__ bool next(int i, Unit& u) const {
        int pm, pn; if (!static_tile(i, G, c, nM, nN, pm, pn)) return false;
        u.row0 = pm * BM; u.col0 = pn * BM; u.e = 0; u.aux = 0; u.A = A + (size_t)pm * BM * K * 2; u.B = Bt + (size_t)pn * BM * K * 2; return true;
    }
};
struct BranchSched {
    static constexpr bool GATHER = false;
    const char* A0; const char* A1; const char* A2; const char* W3; int G, c;
    const char* Abase = nullptr; const int* list = nullptr; const LAS int* tab = nullptr; const LAS int* cntl = nullptr;
    __device__ __forceinline__ bool next(int i, Unit& u) const {
        const int br = i % 3; int pm, pn; if (!static_tile(i / 3, G, c, NTOK / BM, DM / BM, pm, pn)) return false;
        u.row0 = pm * BM; u.col0 = pn * BM; u.e = br; u.aux = 0;
        u.A = (br == 0 ? A0 : (br == 1 ? A1 : A2)) + (size_t)pm * BM * DM * 2; u.B = W3 + ((size_t)br * DM + (size_t)pn * BM) * DM * 2; return true;
    }
};
template <bool GATHER_>
struct MoeSchedT {
    static constexpr bool GATHER = GATHER_;
    const char* A; const char* W; const LAS int* tstart; size_t Wstride; int nN, G, c;
    const char* Abase; const int* list; const LAS int* tab; const LAS int* cntl;
    __device__ __forceinline__ bool next(int i, Unit& u) const {
        const int nM = tstart[NEXP]; int pm, pn; if (!static_tile(i, G, c, nM, nN, pm, pn)) return false;
        int e = 0;
#pragma unroll 1
        for (int j = 1; j < NEXP; ++j) e += (tstart[j] <= pm) ? 1 : 0;
        u.row0 = pm * BM; u.col0 = pn * BM; u.e = e; u.aux = (pm - tstart[e]) * BM;
        u.A = A + (size_t)pm * BM * DM * 2; u.B = W + (size_t)e * Wstride + (size_t)pn * BM * DM * 2; return true;
    }
};
typedef MoeSchedT<false> MoeSched;
typedef MoeSchedT<true> MoeGatherSched;

struct EpiBf16 {
    bf16_t* O; int ldc; const float* bias; int bstride;
    __device__ __forceinline__ void operator()(const f32x4 (&acc)[2][2][4][2], const Unit& u, int wr, int wc, int fr, int fq) const {
        const int row0 = u.row0 + wr * 64 + fr, col0 = u.col0 + wc * 32 + 8 * fq;
        f32x4 bv[2][2];
#pragma unroll
        for (int bj = 0; bj < 2; ++bj)
#pragma unroll
            for (int n = 0; n < 2; ++n) bv[bj][n] = bias ? *(const f32x4*)(bias + (size_t)u.e * bstride + col0 + bj * HALF + 4 * n) : (f32x4){0.f, 0.f, 0.f, 0.f};
#pragma unroll
        for (int ai = 0; ai < 2; ++ai)
#pragma unroll
            for (int m = 0; m < 4; ++m) { bf16_t* rowp = O + (size_t)(row0 + ai * HALF + m * 16) * ldc + col0;
#pragma unroll
                for (int bj = 0; bj < 2; ++bj) { const f32x4 v0 = acc[ai][bj][m][0] + bv[bj][0], v1 = acc[ai][bj][m][1] + bv[bj][1];
                    u32x4 w; w.x = cvt_pk_bf16(v0[0], v0[1]); w.y = cvt_pk_bf16(v0[2], v0[3]); w.z = cvt_pk_bf16(v1[0], v1[1]); w.w = cvt_pk_bf16(v1[2], v1[3]);
                    *(u32x4*)(rowp + bj * HALF) = w; } }
    }
};
struct EpiBranch {
    bf16_t* Y0; bf16_t* Y1; bf16_t* MRGB; const bf16_t* PROJB;
    __device__ __forceinline__ void operator()(const f32x4 (&acc)[2][2][4][2], const Unit& u, int wr, int wc, int fr, int fq) const {
        const int row0 = u.row0 + wr * 64 + fr, col0 = u.col0 + wc * 32 + 8 * fq, br = u.e;
        bf16_t* dst = br == 0 ? Y0 : (br == 1 ? Y1 : MRGB);
#pragma unroll
        for (int ai = 0; ai < 2; ++ai)
#pragma unroll
            for (int m = 0; m < 4; ++m) { const size_t row = (size_t)(row0 + ai * HALF + m * 16);
#pragma unroll
                for (int bj = 0; bj < 2; ++bj) { const int col = col0 + bj * HALF;
                    const u32x4 gl = *(const u32x4*)(PROJB + row * PROJ_COLS + PJ_GATES + br * DM + col);
                    f32x4 v0, v1;
                    v0[0] = sigmoidf_(bflo(gl.x)) * acc[ai][bj][m][0][0]; v0[1] = sigmoidf_(bfhi(gl.x)) * acc[ai][bj][m][0][1];
                    v0[2] = sigmoidf_(bflo(gl.y)) * acc[ai][bj][m][0][2]; v0[3] = sigmoidf_(bfhi(gl.y)) * acc[ai][bj][m][0][3];
                    v1[0] = sigmoidf_(bflo(gl.z)) * acc[ai][bj][m][1][0]; v1[1] = sigmoidf_(bfhi(gl.z)) * acc[ai][bj][m][1][1];
                    v1[2] = sigmoidf_(bflo(gl.w)) * acc[ai][bj][m][1][2]; v1[3] = sigmoidf_(bfhi(gl.w)) * acc[ai][bj][m][1][3];
                    if (br == 2) {
                        const u32x4 y0 = *(const u32x4*)(Y0 + row * DM + col), y1 = *(const u32x4*)(Y1 + row * DM + col);
                        v0[0] += bflo(y0.x) + bflo(y1.x); v0[1] += bfhi(y0.x) + bfhi(y1.x); v0[2] += bflo(y0.y) + bflo(y1.y); v0[3] += bfhi(y0.y) + bfhi(y1.y);
                        v1[0] += bflo(y0.z) + bflo(y1.z); v1[1] += bfhi(y0.z) + bfhi(y1.z); v1[2] += bflo(y0.w) + bflo(y1.w); v1[3] += bfhi(y0.w) + bfhi(y1.w);
                    }
                    u32x4 w; w.x = cvt_pk_bf16(v0[0], v0[1]); w.y = cvt_pk_bf16(v0[2], v0[3]); w.z = cvt_pk_bf16(v1[0], v1[1]); w.w = cvt_pk_bf16(v1[2], v1[3]);
                    *(u32x4*)(dst + row * DM + col) = w; } }
    }
};
struct EpiSwiglu {
    bf16_t* H; const float* b_gu;
    __device__ __forceinline__ void operator()(const f32x4 (&acc)[2][2][4][2], const Unit& u, int wr, int wc, int fr, int fq) const {
        const int row0 = u.row0 + wr * 64 + fr, jj0 = wc * 32 + 8 * fq, oc0 = (u.col0 >> 1) + jj0;
        const float* bp = b_gu + (size_t)u.e * 2048 + 2 * oc0;
        float bg[8], bl[8];
#pragma unroll
        for (int j = 0; j < 4; ++j) { const f32x4 b4 = *(const f32x4*)(bp + 4 * j); bg[2 * j] = b4[0]; bl[2 * j] = b4[1]; bg[2 * j + 1] = b4[2]; bl[2 * j + 1] = b4[3]; }
#pragma unroll
        for (int ai = 0; ai < 2; ++ai)
#pragma unroll
            for (int m = 0; m < 4; ++m) { const size_t row = (size_t)(row0 + ai * HALF + m * 16);
                float o[8];
#pragma unroll
                for (int n = 0; n < 2; ++n)
#pragma unroll
                    for (int j = 0; j < 4; ++j) {
                        const float gate = fminf(acc[ai][0][m][n][j] + bg[4 * n + j], 7.0f);
                        const float lin = fminf(fmaxf(acc[ai][1][m][n][j] + bl[4 * n + j], -7.0f), 7.0f);
                        o[4 * n + j] = gate * sigmoidf_(1.702f * gate) * (lin + 1.0f);
                    }
                u32x4 w; w.x = cvt_pk_bf16(o[0], o[1]); w.y = cvt_pk_bf16(o[2], o[3]); w.z = cvt_pk_bf16(o[4], o[5]); w.w = cvt_pk_bf16(o[6], o[7]);
                *(u32x4*)(H + row * DM + oc0) = w; }
    }
};
struct EpiPle {
    bf16_t* O; const bf16_t* PP;
    __device__ __forceinline__ void operator()(const f32x4 (&acc)[2][2][4][2], const Unit& u, int wr, int wc, int fr, int fq) const {
        const int row0 = u.row0 + wr * 64 + fr, col0 = u.col0 + wc * 32 + 8 * fq;
#pragma unroll
        for (int ai = 0; ai < 2; ++ai)
#pragma unroll
            for (int m = 0; m < 4; ++m) { const size_t row = (size_t)(row0 + ai * HALF + m * 16);
#pragma unroll
                for (int bj = 0; bj < 2; ++bj) { const int col = col0 + bj * HALF;
                    const u32x4 pp = *(const u32x4*)(PP + row * DM + col);
                    const f32x4 a0 = acc[ai][bj][m][0], a1 = acc[ai][bj][m][1];
                    u32x4 w;
                    w.x = cvt_pk_bf16(sigmoidf_(a0[0]) * bflo(pp.x), sigmoidf_(a0[1]) * bfhi(pp.x));
                    w.y = cvt_pk_bf16(sigmoidf_(a0[2]) * bflo(pp.y), sigmoidf_(a0[3]) * bfhi(pp.y));
                    w.z = cvt_pk_bf16(sigmoidf_(a1[0]) * bflo(pp.z), sigmoidf_(a1[1]) * bfhi(pp.z));
                    w.w = cvt_pk_bf16(sigmoidf_(a1[2]) * bflo(pp.w), sigmoidf_(a1[3]) * bfhi(pp.w));
                    *(u32x4*)(O + row * DM + col) = w; } }
    }
};
}

constexpr int NWAVES = 8;
constexpr int LDS_BYTES = 163840;
constexpr int LDS_MISC = 155648;
constexpr size_t MiB = 1u << 20;
constexpr size_t WS_CTL = 0;
constexpr size_t WS_W = 1 * MiB, WL_STRIDE = 224 * MiB;
constexpr size_t W_IN = 0, W_O3 = 21 * MiB, W_OUT = 27 * MiB, W_GU = 29 * MiB, W_DN = 157 * MiB, W_PG = 221 * MiB, W_PP = 223 * MiB, W_LRU = 223 * MiB + 512 * 1024;
constexpr size_t WS_PB = WS_W + 2 * WL_STRIDE;
constexpr size_t WS_XB = WS_PB + 32 * MiB;
constexpr size_t WS_XF = WS_XB + 64 * MiB;
constexpr size_t WS_PROJ = WS_XF + 128 * MiB;
constexpr size_t WS_GO = WS_PROJ + 672 * MiB, WS_LO = WS_GO + 64 * MiB, WS_SO = WS_LO + 64 * MiB;
constexpr size_t WS_M = WS_SO + 64 * MiB;
constexpr size_t WS_SMALL = WS_M + 496 * MiB;
constexpr size_t WS_AB = WS_SMALL, WS_GG = WS_AB + 2 * MiB, WS_BT = WS_GG + 1 * MiB, WS_GATES = WS_BT + 1 * MiB, WS_ES = WS_GATES + MiB / 2, WS_LIST = WS_ES + MiB / 2;
constexpr size_t WS_END = WS_LIST + 4 * MiB;
static_assert(WS_END <= 2048 * MiB, "workspace map must fit 2 GiB");
constexpr size_t M_QN = 0, M_KN = 64 * MiB, M_VV = 128 * MiB, M_OO = 192 * MiB;
constexpr size_t M_XC = 0, M_LA = 128 * MiB, M_LU = 256 * MiB;
constexpr size_t M_MRG = 0, M_MRGB = 128 * MiB, M_YY = 192 * MiB;
constexpr size_t M_XS = 0;
constexpr size_t M_PP = 0, M_PLEO = 64 * MiB;
constexpr size_t PJ_H = 0, PJ_OB = 272 * MiB;
constexpr int CW_CNT = 8192;
constexpr int CW_BAR = 4096;
constexpr int CW_TS = 16384;

struct MArgs { const float* in[34]; float* out; unsigned char* ws; int ph_lo, ph_hi; };
enum { I_X = 0, I_P, I_WIN, I_CONVQKV, I_ALOG, I_DTB, I_GNW, I_RGCW, I_RGCB, I_RGWA, I_RGBA, I_RGWX, I_RGBX, I_RGLAM, I_SINKS, I_RELB, I_WOG, I_WOL, I_WOS, I_WOUT,
       I_LN1G, I_LN1B, I_RW, I_RB, I_WGU, I_BGU, I_WDN, I_BDN, I_LN2G, I_LN2B, I_PLEG, I_PLEP, I_LN3G, I_LN3B };

template <int MAP>
__device__ __forceinline__ int src_col(int n) {
    if (MAP == 1) return n < 4096 ? n : n + 16;
    if (MAP == 2) { const int pn = n >> 8, half = (n >> 7) & 1, jj = n & 127; return 2 * (pn * 128 + jj) + half; }
    return n;
}
template <int MAP>
__device__ __forceinline__ void transpose_item(const float* W, int K, int ldw, int Nout, bf16_t* WT, LAS float* scr, int item, int lane) {
    const int nblk = Nout / 32, kb = item / nblk, nb = item % nblk, k0 = 64 * kb, n0 = 32 * nb;
    const int sc = src_col<MAP>(n0 + (lane & 31));
    float tmpv[32];
#pragma unroll
    for (int i = 0; i < 32; ++i) tmpv[i] = W[(size_t)(k0 + 2 * i + (lane >> 5)) * ldw + sc];
#pragma unroll
    for (int i = 0; i < 32; ++i) scr[(2 * i + (lane >> 5)) * 33 + (lane & 31)] = tmpv[i];
    asm volatile("s_waitcnt lgkmcnt(0)" ::: "memory");
    const int c = lane & 7;
#pragma unroll
    for (int j = 0; j < 4; ++j) { const int n = (lane >> 3) + 8 * j; const LAS float* s = scr + (8 * c) * 33 + n;
        u32x4 o; o.x = pk2(s[0 * 33], s[1 * 33]); o.y = pk2(s[2 * 33], s[3 * 33]); o.z = pk2(s[4 * 33], s[5 * 33]); o.w = pk2(s[6 * 33], s[7 * 33]);
        *(u32x4*)(WT + (size_t)(n0 + n) * K + k0 + 8 * c) = o; }
    asm volatile("s_waitcnt lgkmcnt(0)" ::: "memory");
}
__device__ __forceinline__ void transpose_item_gu(const float* W, bf16_t* WT, LAS float* scr, int item, int lane) {
    const int kb = item >> 5, jb = item & 31, k0 = 64 * kb, j0 = 32 * jb;
    f32x2 tmpv[32];
#pragma unroll
    for (int i = 0; i < 32; ++i) tmpv[i] = *(const f32x2*)(W + (size_t)(k0 + 2 * i + (lane >> 5)) * 2048 + 2 * (j0 + (lane & 31)));
#pragma unroll
    for (int i = 0; i < 32; ++i) *(LAS f32x2*)(scr + (2 * i + (lane >> 5)) * 66 + 2 * (lane & 31)) = tmpv[i];
    asm volatile("s_waitcnt lgkmcnt(0)" ::: "memory");
    const int c = lane & 7;
#pragma unroll
    for (int half = 0; half < 2; ++half)
#pragma unroll
        for (int jq = 0; jq < 4; ++jq) { const int nl = (lane >> 3) + 8 * jq, j = j0 + nl, n = (j >> 7) * 256 + half * 128 + (j & 127);
            const LAS float* s = scr + (8 * c) * 66 + 2 * nl + half;
            u32x4 o; o.x = pk2(s[0 * 66], s[1 * 66]); o.y = pk2(s[2 * 66], s[3 * 66]); o.z = pk2(s[4 * 66], s[5 * 66]); o.w = pk2(s[6 * 66], s[7 * 66]);
            *(u32x4*)(WT + (size_t)n * 1024 + k0 + 8 * c) = o; }
    asm volatile("s_waitcnt lgkmcnt(0)" ::: "memory");
}
template <int MAP>
__device__ __forceinline__ void transpose_seg(const float* W, int K, int ldw, int Nout, bf16_t* WT, LAS float* scr, int gw, int NGW, int lane) {
    const int nitems = (K / 64) * (Nout / 32);
    for (int it = gw; it < nitems; it += NGW) transpose_item<MAP>(W, K, ldw, Nout, WT, scr, it, lane);
}
__device__ __forceinline__ void cvt_rows(const float* src, bf16_t* dst, size_t n, int G) {
    for (size_t i = (size_t)blockIdx.x * 512 + threadIdx.x; i < n / 8; i += (size_t)G * 512) {
        const f32x4 v0 = *(const f32x4*)(src + i * 8), v1 = *(const f32x4*)(src + i * 8 + 4);
        u32x4 o; o.x = pk2(v0[0], v0[1]); o.y = pk2(v0[2], v0[3]); o.z = pk2(v1[0], v1[1]); o.w = pk2(v1[2], v1[3]);
        *(u32x4*)(dst + i * 8) = o;
    }
}
template <int NE4>
__device__ __forceinline__ void stage_smallw(const float* W, int ld, int col0, LAS unsigned char* dst, int tid) {
    for (int i = tid; i < 1024 * NE4; i += 512) { const int k = i / NE4, e4 = i % NE4; const int m = (k >> 8) * 4 + (k & 3), ln = (k & 255) >> 2;
        *(LAS f32x4*)(dst + ((e4 * 16 + m) * 64 + ln) * 16) = *(const f32x4*)(W + (size_t)k * ld + col0 + 4 * e4); }
}
template <int NE4>
__device__ __forceinline__ void small_project(const f32x4 (&v)[4], const LAS unsigned char* wsm, float (&acc)[4 * NE4], int lane) {
#pragma unroll
    for (int e = 0; e < 4 * NE4; ++e) acc[e] = 0.f;
#pragma unroll
    for (int j = 0; j < 4; ++j)
#pragma unroll
        for (int q = 0; q < 4; ++q) { const float xv = v[j][q];
#pragma unroll
            for (int e4 = 0; e4 < NE4; ++e4) { const f32x4 w4 = *(const LAS f32x4*)(wsm + ((e4 * 16 + 4 * j + q) * 64 + lane) * 16);
                acc[4 * e4 + 0] = fmaf(xv, w4[0], acc[4 * e4 + 0]); acc[4 * e4 + 1] = fmaf(xv, w4[1], acc[4 * e4 + 1]);
                acc[4 * e4 + 2] = fmaf(xv, w4[2], acc[4 * e4 + 2]); acc[4 * e4 + 3] = fmaf(xv, w4[3], acc[4 * e4 + 3]); } }
}
template <int NE4>
__device__ __forceinline__ void small_project2(const f32x4 (&v0)[4], const f32x4 (&v1)[4], const LAS unsigned char* wsm, float (&acc0)[4 * NE4], float (&acc1)[4 * NE4], int lane) {
#pragma unroll
    for (int e = 0; e < 4 * NE4; ++e) { acc0[e] = 0.f; acc1[e] = 0.f; }
#pragma unroll
    for (int j = 0; j < 4; ++j)
#pragma unroll
        for (int q = 0; q < 4; ++q) { const float x0 = v0[j][q], x1 = v1[j][q];
#pragma unroll
            for (int e4 = 0; e4 < NE4; ++e4) { const f32x4 w4 = *(const LAS f32x4*)(wsm + ((e4 * 16 + 4 * j + q) * 64 + lane) * 16);
#pragma unroll
                for (int c = 0; c < 4; ++c) { acc0[4 * e4 + c] = fmaf(x0, w4[c], acc0[4 * e4 + c]); acc1[4 * e4 + c] = fmaf(x1, w4[c], acc1[4 * e4 + c]); } } }
}
__device__ __forceinline__ float reduce_scatter32(const float (&acc)[32], int lane) {
    float a16[16], a8[8], a4[4], a2[2];
    const bool b5 = lane & 32, b4 = lane & 16, b3 = lane & 8, b2 = lane & 4, b1 = lane & 2;
#pragma unroll
    for (int i = 0; i < 16; ++i) { const float keep = b5 ? acc[i + 16] : acc[i], give = b5 ? acc[i] : acc[i + 16]; a16[i] = keep + __shfl_xor(give, 32); }
#pragma unroll
    for (int i = 0; i < 8; ++i) { const float keep = b4 ? a16[i + 8] : a16[i], give = b4 ? a16[i] : a16[i + 8]; a8[i] = keep + __shfl_xor(give, 16); }
#pragma unroll
    for (int i = 0; i < 4; ++i) { const float keep = b3 ? a8[i + 4] : a8[i], give = b3 ? a8[i] : a8[i + 4]; a4[i] = keep + __shfl_xor(give, 8); }
#pragma unroll
    for (int i = 0; i < 2; ++i) { const float keep = b2 ? a4[i + 2] : a4[i], give = b2 ? a4[i] : a4[i + 2]; a2[i] = keep + __shfl_xor(give, 4); }
    const float keep = b1 ? a2[1] : a2[0], give = b1 ? a2[0] : a2[1];
    float v = keep + __shfl_xor(give, 2);
    v += __shfl_xor(v, 1);
    return v;
}
__device__ __forceinline__ float reduce_scatter16(const float (&acc)[16], int lane) {
    float a8[8], a4[4], a2[2];
    const bool b5 = lane & 32, b4 = lane & 16, b3 = lane & 8, b2 = lane & 4;
#pragma unroll
    for (int i = 0; i < 8; ++i) { const float keep = b5 ? acc[i + 8] : acc[i], give = b5 ? acc[i] : acc[i + 8]; a8[i] = keep + __shfl_xor(give, 32); }
#pragma unroll
    for (int i = 0; i < 4; ++i) { const float keep = b4 ? a8[i + 4] : a8[i], give = b4 ? a8[i] : a8[i + 4]; a4[i] = keep + __shfl_xor(give, 16); }
#pragma unroll
    for (int i = 0; i < 2; ++i) { const float keep = b3 ? a4[i + 2] : a4[i], give = b3 ? a4[i] : a4[i + 2]; a2[i] = keep + __shfl_xor(give, 8); }
    const float keep = b2 ? a2[1] : a2[0], give = b2 ? a2[0] : a2[1];
    float v = keep + __shfl_xor(give, 4);
    v += __shfl_xor(v, 2); v += __shfl_xor(v, 1);
    return v;
}
__device__ __forceinline__ void ab_project(const f32x4 (&v)[4], const LAS unsigned char* wsm, float* ABrow, int lane, unsigned& dep) {
    float acc[16];
    small_project<4>(v, wsm + dep, acc, lane);
    const float s = reduce_scatter16(acc, lane);
    if ((lane & 3) == 0) ABrow[lane >> 2] = s;
    asm volatile("" : "+v"(dep) : "v"(s));
}
template <int NE4>
__device__ __forceinline__ void small_project4(const f32x4 (&vv)[4][4], const LAS unsigned char* wsm, float (&acc)[4][4 * NE4], int lane) {
#pragma unroll
    for (int u = 0; u < 4; ++u)
#pragma unroll
        for (int e = 0; e < 4 * NE4; ++e) acc[u][e] = 0.f;
    unsigned tok = 0u;
#pragma unroll
    for (int j = 0; j < 4; ++j)
#pragma unroll
        for (int q = 0; q < 4; ++q) {
            const LAS unsigned char* wp = wsm + tok;
#pragma unroll
            for (int e4 = 0; e4 < NE4; ++e4) { const f32x4 w4 = *(const LAS f32x4*)(wp + ((e4 * 16 + 4 * j + q) * 64 + lane) * 16);
#pragma unroll
                for (int c = 0; c < 4; ++c)
#pragma unroll
                    for (int u = 0; u < 4; ++u) acc[u][4 * e4 + c] = fmaf(vv[u][j][q], w4[c], acc[u][4 * e4 + c]); }
            asm volatile("" : "+v"(tok) : "v"(acc[0][0]));
        }
}
__device__ __forceinline__ void ab_project4(const f32x4 (&vv)[4][4], const LAS unsigned char* wsm, float* ABrow0, int lane, unsigned& dep) {
    float acc[4][16];
    small_project4<4>(vv, wsm + dep, acc, lane);
    float s[4];
#pragma unroll
    for (int u = 0; u < 4; ++u) s[u] = reduce_scatter16(acc[u], lane);
    if ((lane & 3) == 0) {
#pragma unroll
        for (int u = 0; u < 4; ++u) ABrow0[u * 16 + (lane >> 2)] = s[u];
    }
    asm volatile("" : "+v"(dep) : "v"(s[3]));
}
__device__ __forceinline__ void ln_inplace(f32x4 (&v)[4], const float* g, const float* b, int lane) {
    float s = 0.f;
#pragma unroll
    for (int j = 0; j < 4; ++j) s += (v[j][0] + v[j][1]) + (v[j][2] + v[j][3]);
    const float mu = wave_sum(s) * (1.0f / DM);
    float s2 = 0.f;
#pragma unroll
    for (int j = 0; j < 4; ++j) { v[j] = v[j] - mu; s2 += (v[j][0] * v[j][0] + v[j][1] * v[j][1]) + (v[j][2] * v[j][2] + v[j][3] * v[j][3]); }
    const float rstd = rsqrtf(wave_sum(s2) * (1.0f / DM) + 1e-5f);
#pragma unroll
    for (int j = 0; j < 4; ++j) { const f32x4 g4 = *(const f32x4*)(g + 256 * j + 4 * lane), b4 = *(const f32x4*)(b + 256 * j + 4 * lane); v[j] = v[j] * rstd * g4 + b4; }
}
__device__ __forceinline__ void store_row(const f32x4 (&v)[4], float* xf, bf16_t* xb, int lane) {
#pragma unroll
    for (int j = 0; j < 4; ++j) { if (xf) *(f32x4*)(xf + 256 * j + 4 * lane) = v[j];
        u32x2 o; o.x = pk2(v[j][0], v[j][1]); o.y = pk2(v[j][2], v[j][3]); *(u32x2*)(xb + 256 * j + 4 * lane) = o; }
}
__device__ __forceinline__ f32x4 ld_bf4(const bf16_t* p) { const u32x2 y2 = *(const u32x2*)p; return (f32x4){bflo(y2.x), bfhi(y2.x), bflo(y2.y), bfhi(y2.y)}; }
__device__ __forceinline__ int t5_bucket(int dist) {
    if (dist < 16) return dist;
    int l = 16 + (int)(logf((float)dist / 16.0f) / logf(8.0f) * 16.0f);
    return l < 31 ? l : 31;
}


typedef float f32x16 __attribute__((ext_vector_type(16)));
__device__ __forceinline__ bf16x8 pack8(const f32x16& c, const int s) {
    u32x4 p; p.x = cvtpk(c[8 * s + 0], c[8 * s + 1]); p.y = cvtpk(c[8 * s + 2], c[8 * s + 3]); p.z = cvtpk(c[8 * s + 4], c[8 * s + 5]); p.w = cvtpk(c[8 * s + 6], c[8 * s + 7]);
    return __builtin_bit_cast(bf16x8, p);
}
#define MFMA32(a, b, c) __builtin_amdgcn_mfma_f32_32x32x16_bf16((a), (b), (c), 0, 0, 0)
constexpr size_t G_WN = 0, G_QN = 64 * MiB, G_AN = 128 * MiB, G_KT = 160 * MiB, G_UN = 224 * MiB, G_GC = 352 * MiB, G_OO = 353 * MiB, G_VT = 417 * MiB, G_EG = 449 * MiB;
constexpr int GA_LDS = 19456;
constexpr int GA_TSTR = 272;
constexpr int GA_USTR = 144;
constexpr int GA_G = 18304, GA_B = 18560, GA_RK = 18816, GA_RQ = 19072;

__device__ __forceinline__ void gdn_stage_raw(const bf16_t* src  , int seqpos0, LAS unsigned char* wl, int lane) {
    if (seqpos0 > 0) {
#pragma unroll
        for (int u = 0; u < 3; ++u) __builtin_amdgcn_global_load_lds((const unsigned*)(src + (ptrdiff_t)(u - 3) * PROJ_COLS), (LAS unsigned*)(wl + u * GA_TSTR), 4, 0, 0);
    } else {
#pragma unroll
        for (int u = 0; u < 3; ++u) *(LAS unsigned*)(wl + u * GA_TSTR + 4 * lane) = 0u;
    }
#pragma unroll 8
    for (int p = 0; p < 64; ++p) __builtin_amdgcn_global_load_lds((const unsigned*)(src + (size_t)p * PROJ_COLS), (LAS unsigned*)(wl + (p + 3) * GA_TSTR), 4, 0, 0);
}
template <int UNR, class F>
__device__ __forceinline__ void gdn_conv_stream(LAS unsigned char* wl, const float* cw  , int lane, F&& emit) {
    f32x2 w[4];
#pragma unroll
    for (int j = 0; j < 4; ++j) w[j] = *(const f32x2*)(cw + j * 3072);
    asm volatile("s_waitcnt vmcnt(0)" ::: "memory");
    unsigned r0 = *(LAS unsigned*)(wl + 0 * GA_TSTR + 4 * lane), r1 = *(LAS unsigned*)(wl + 1 * GA_TSTR + 4 * lane), r2 = *(LAS unsigned*)(wl + 2 * GA_TSTR + 4 * lane);
#pragma unroll 1
    for (int pb_ = 0; pb_ < 64 / UNR; ++pb_) {
        unsigned cu[UNR];
#pragma unroll
        for (int u = 0; u < UNR; ++u) cu[u] = *(LAS unsigned*)(wl + (UNR * pb_ + u + 3) * GA_TSTR + 4 * lane);
#pragma unroll
        for (int u = 0; u < UNR; ++u) {
            const unsigned r3 = cu[u];
            float y0 = w[0][0] * bflo(r0); y0 = fmaf(w[1][0], bflo(r1), y0); y0 = fmaf(w[2][0], bflo(r2), y0); y0 = fmaf(w[3][0], bflo(r3), y0);
            float y1 = w[0][1] * bfhi(r0); y1 = fmaf(w[1][1], bfhi(r1), y1); y1 = fmaf(w[2][1], bfhi(r2), y1); y1 = fmaf(w[3][1], bfhi(r3), y1);
            r0 = r1; r1 = r2; r2 = r3;
            emit(pb_, u, siluf_(y0), siluf_(y1));
        }
    }
}

__device__ __forceinline__ void gdn_a_item(const __attribute__((address_space(4))) MArgs& a, unsigned char* ws, const int L, LAS unsigned char* wl, const int item, const int lane, const int vt_slot) {
    const int n = item & 63, h = (item >> 6) & 7, b = item >> 9;
    const size_t t0 = (size_t)b * SEQ + (size_t)n * 64;
    const int r = lane & 31, hh = lane >> 5;
    const bf16_t* PROJB = (const bf16_t*)(ws + WS_PROJ);
    unsigned char* RM = ws + WS_M;
    LAS float* Gs = (LAS float*)(wl + GA_G); LAS float* Bs = (LAS float*)(wl + GA_B); LAS float* Rk = (LAS float*)(wl + GA_RK); LAS float* Rq = (LAS float*)(wl + GA_RQ);
    float Gtok, Glast;
    auto row_ss = [&]() { float ss = 0.f;
#pragma unroll
        for (int c8 = 0; c8 < 16; ++c8) { const u32x4 w = *(const LAS u32x4*)(wl + lane * GA_TSTR + 16 * c8);
            ss = fmaf(bflo(w.x), bflo(w.x), ss); ss = fmaf(bfhi(w.x), bfhi(w.x), ss); ss = fmaf(bflo(w.y), bflo(w.y), ss); ss = fmaf(bfhi(w.y), bfhi(w.y), ss);
            ss = fmaf(bflo(w.z), bflo(w.z), ss); ss = fmaf(bfhi(w.z), bfhi(w.z), ss); ss = fmaf(bflo(w.w), bflo(w.w), ss); ss = fmaf(bfhi(w.w), bfhi(w.w), ss); }
        return ss; };
    {
        const float* AB = (const float*)(ws + WS_AB);
        const float av = AB[(t0 + lane) * 16 + h], bv = AB[(t0 + lane) * 16 + 8 + h];
        float G = -expf(as_global(a.in[I_ALOG])[L * 8 + h]) * softplusf_(av + as_global(a.in[I_DTB])[L * 8 + h]);
#pragma unroll
        for (int o = 1; o < 64; o <<= 1) { const float y = __shfl_up(G, o); if (lane >= o) G += y; }
        Gs[lane] = G; Bs[lane] = sigmoidf_(bv);
        Gtok = G; Glast = __builtin_bit_cast(float, __builtin_amdgcn_readlane(__builtin_bit_cast(int, G), 63));
    }
    const float* cwL = as_global(a.in[I_CONVQKV]) + (size_t)L * 4 * 3072 + h * 128 + 2 * lane;
    const bf16_t* srcL = PROJB + t0 * PROJ_COLS + h * 128 + 2 * lane;
    gdn_stage_raw(srcL + PJ_V, n, wl, lane);
    bf16_t* VT = (bf16_t*)(RM + G_VT) + (size_t)vt_slot * 8192;
    {
        float vb0[8], vb1[8];
        gdn_conv_stream<8>(wl, cwL + 2048, lane, [&](int pb_, int u, float y0, float y1) {
            const int p = 8 * pb_ + u;
            vb0[u] = y0; vb1[u] = y1;
            if (u == 7) {
                u32x4 o0; o0.x = cvtpk(vb0[0], vb0[1]); o0.y = cvtpk(vb0[2], vb0[3]); o0.z = cvtpk(vb0[4], vb0[5]); o0.w = cvtpk(vb0[6], vb0[7]);
                u32x4 o1; o1.x = cvtpk(vb1[0], vb1[1]); o1.y = cvtpk(vb1[2], vb1[3]); o1.z = cvtpk(vb1[4], vb1[5]); o1.w = cvtpk(vb1[6], vb1[7]);
                *(u32x4*)(VT + (size_t)(2 * lane) * 64 + (p & ~7)) = o0; *(u32x4*)(VT + (size_t)(2 * lane + 1) * 64 + (p & ~7)) = o1;
            }
        });
    }
    asm volatile("s_waitcnt lgkmcnt(0)" ::: "memory");
    gdn_stage_raw(srcL + PJ_K, n, wl, lane);
    {
        bf16_t* KTN = (bf16_t*)(RM + G_KT) + (size_t)item * 8192;
        float kb0[4], kb1[4];
        const int d0 = 2 * lane, mtp = d0 >> 5, rr = d0 & 31;
        gdn_conv_stream<4>(wl, cwL + 1024, lane, [&](int pb_, int u, float y0, float y1) {
            const int p = 4 * pb_ + u;
            *(LAS unsigned*)(wl + p * GA_TSTR + 4 * lane) = cvtpk(y0, y1);
            kb0[u] = y0; kb1[u] = y1;
            if (u == 3) {
                const int ks = p >> 4, q4 = (p & 15) >> 2, h_ = q4 & 1, jh = q4 >> 1;
                const size_t off = ((size_t)((mtp * 4 + ks) * 64 + h_ * 32 + rr)) * 8 + jh * 4;
                u32x2 o0; o0.x = cvtpk(kb0[0], kb0[1]); o0.y = cvtpk(kb0[2], kb0[3]);
                u32x2 o1; o1.x = cvtpk(kb1[0], kb1[1]); o1.y = cvtpk(kb1[2], kb1[3]);
                *(u32x2*)(KTN + off) = o0; *(u32x2*)(KTN + off + 8) = o1;
            }
        });
    }
    const float rnk = rsqrtf(row_ss() + 1e-6f);
    Rk[lane] = rnk;
    bf16x8 kf[2][8];
#pragma unroll
    for (int mt = 0; mt < 2; ++mt)
#pragma unroll
        for (int s = 0; s < 8; ++s) kf[mt][s] = *(const LAS bf16x8*)(wl + (32 * mt + r) * GA_TSTR + (16 * s + 8 * hh) * 2);
    asm volatile("s_waitcnt lgkmcnt(0)" ::: "memory");
    gdn_stage_raw(srcL + PJ_Q, n, wl, lane);
    gdn_conv_stream<4>(wl, cwL, lane, [&](int pb_, int u, float y0, float y1) {
        *(LAS unsigned*)(wl + (4 * pb_ + u) * GA_TSTR + 4 * lane) = cvtpk(y0, y1);
    });
    const float rnq = rsqrtf(row_ss() + 1e-6f) * 0.08838834764831845f;
    Rq[lane] = rnq;
    {
        float* EG = (float*)(RM + G_EG) + (size_t)item * 192;
        EG[lane] = fexp(Gtok) * rnq; EG[64 + lane] = fexp(Glast - Gtok) * rnk;
        if (lane == 0) EG[128] = fexp(Glast);
    }
    {
        bf16_t* ANf = (bf16_t*)(RM + G_AN) + (size_t)item * 4096;
#pragma unroll
        for (int it = 0; it < 2; ++it)
#pragma unroll
            for (int jt = 0; jt <= it; ++jt) {
                f32x16 c = {0.f, 0.f, 0.f, 0.f, 0.f, 0.f, 0.f, 0.f, 0.f, 0.f, 0.f, 0.f, 0.f, 0.f, 0.f, 0.f};
#pragma unroll
                for (int s = 0; s < 8; ++s) { const bf16x8 qf = *(const LAS bf16x8*)(wl + (32 * it + r) * GA_TSTR + (16 * s + 8 * hh) * 2); c = MFMA32(kf[jt][s], qf, c); }
                const int i = 32 * it + r; const float Gi = Gs[i], Rqi = Rq[i];
#pragma unroll
                for (int g4 = 0; g4 < 4; ++g4) { const f32x4 Gj = *(const LAS f32x4*)(Gs + 32 * jt + 8 * g4 + 4 * hh), Rkj = *(const LAS f32x4*)(Rk + 32 * jt + 8 * g4 + 4 * hh);
#pragma unroll
                    for (int q = 0; q < 4; ++q) { const int j = 32 * jt + 8 * g4 + 4 * hh + q; c[4 * g4 + q] = (i >= j) ? c[4 * g4 + q] * (Rqi * Rkj[q] * fexp(Gi - Gj[q])) : 0.f; } }
#pragma unroll
                for (int sp = 0; sp < 2; ++sp) *(bf16x8*)((unsigned char*)ANf + (unsigned)(lane * 16) + (it * 4 + 2 * jt + sp) * 1024) = pack8(c, sp);
            }
    }
    {
        f32x16 ck[3];
#pragma unroll
        for (int tix = 0; tix < 3; ++tix) {
            const int it = tix == 0 ? 0 : 1, jt = tix == 2 ? 1 : 0;
            f32x16 c = {0.f, 0.f, 0.f, 0.f, 0.f, 0.f, 0.f, 0.f, 0.f, 0.f, 0.f, 0.f, 0.f, 0.f, 0.f, 0.f};
#pragma unroll
            for (int s = 0; s < 8; ++s) c = MFMA32(kf[it][s], kf[jt][s], c);
            const int j = 32 * jt + r; const float Gj = Gs[j], Rkj = Rk[j];
#pragma unroll
            for (int g4 = 0; g4 < 4; ++g4) { const f32x4 Gi = *(const LAS f32x4*)(Gs + 32 * it + 8 * g4 + 4 * hh), Bi = *(const LAS f32x4*)(Bs + 32 * it + 8 * g4 + 4 * hh), Rki = *(const LAS f32x4*)(Rk + 32 * it + 8 * g4 + 4 * hh);
#pragma unroll
                for (int q = 0; q < 4; ++q) { const int i = 32 * it + 8 * g4 + 4 * hh + q; c[4 * g4 + q] = (i > j) ? (Bi[q] * Rki[q] * Rkj) * c[4 * g4 + q] * fexp(Gi[q] - Gj) : 0.f; } }
            ck[tix] = c;
        }
        {
            bf16_t* QNt = (bf16_t*)(RM + G_QN) + (size_t)item * 8192;
    #pragma unroll
            for (int mt = 0; mt < 2; ++mt)
    #pragma unroll
                for (int ks = 0; ks < 8; ++ks) {
                    const LAS unsigned char* rowp = wl + (32 * mt + r) * GA_TSTR + (32 * (ks >> 1) + 16 * (ks & 1) + 4 * hh) * 2;
                    const u32x2 lo = *(const LAS u32x2*)rowp, hi = *(const LAS u32x2*)(rowp + 16);
                    u32x4 o; o.x = lo.x; o.y = lo.y; o.z = hi.x; o.w = hi.y;
                    *(u32x4*)((unsigned char*)QNt + (unsigned)(lane * 16) + (mt * 8 + ks) * 1024) = o;
                }
        }
        asm volatile("s_waitcnt lgkmcnt(0)" ::: "memory");
#pragma unroll
        for (int tix = 0; tix < 3; ++tix) {
            const int it = tix == 0 ? 0 : 1, jt = tix == 2 ? 1 : 0; const int j = 32 * jt + r;
#pragma unroll
            for (int g4 = 0; g4 < 4; ++g4) *(LAS f32x4*)(wl + (j * 64 + 32 * it + 8 * g4 + 4 * hh) * 4) = (f32x4){ck[tix][4 * g4], ck[tix][4 * g4 + 1], ck[tix][4 * g4 + 2], ck[tix][4 * g4 + 3]};
        }
    }
    float t[64];
#pragma unroll
    for (int j = 0; j < 64; ++j) t[j] = 0.f;
    {
        const unsigned ltbase = (unsigned)(size_t)wl;
#pragma unroll
        for (int j = 63; j >= 0; --j) {
            float acc = (lane == j) ? 1.f : 0.f;
            unsigned addr = ltbase + j * 256;
            if (j + 2 < 64) asm volatile("" : "+v"(addr) : "v"(t[(j + 2) & 63]));
#pragma unroll
            for (int i0 = 60; i0 >= ((j + 1) & ~3); i0 -= 4) { const f32x4 l4 = *(const LAS f32x4*)(size_t)(addr + i0 * 4);
                acc = fmaf(-t[i0 + 3], l4[3], acc); acc = fmaf(-t[i0 + 2], l4[2], acc); acc = fmaf(-t[i0 + 1], l4[1], acc); acc = fmaf(-t[i0], l4[0], acc); }
            t[j] = acc;
        }
    }
    bf16x8 vf[4][4];
    {
        unsigned voff = (unsigned)((32 * 0 + r) * 64 + 8 * hh);
        asm volatile("" : "+v"(voff) : "v"(t[0]));
#pragma unroll
        for (int nt = 0; nt < 4; ++nt)
#pragma unroll
            for (int s = 0; s < 4; ++s) vf[nt][s] = *(const bf16x8*)((const unsigned char*)VT + voff * 2u + nt * 4096 + s * 32);
    }
    asm volatile("s_waitcnt lgkmcnt(0)" ::: "memory");
    float bj[64];
#pragma unroll
    for (int j4 = 0; j4 < 16; ++j4) { const f32x4 b4 = *(const LAS f32x4*)(Bs + 4 * j4); bj[4 * j4] = b4[0]; bj[4 * j4 + 1] = b4[1]; bj[4 * j4 + 2] = b4[2]; bj[4 * j4 + 3] = b4[3]; }
#pragma unroll
    for (int j = 0; j < 64; ++j) t[j] *= bj[j];
#pragma unroll
    for (int j8 = 0; j8 < 8; ++j8) { u32x4 o; o.x = cvtpk(t[8 * j8], t[8 * j8 + 1]); o.y = cvtpk(t[8 * j8 + 2], t[8 * j8 + 3]); o.z = cvtpk(t[8 * j8 + 4], t[8 * j8 + 5]); o.w = cvtpk(t[8 * j8 + 6], t[8 * j8 + 7]);
        *(LAS u32x4*)(wl + lane * GA_USTR + 16 * j8) = o; }
    {
        bf16_t* UN = (bf16_t*)(RM + G_UN) + (size_t)item * 8192;
#pragma unroll
        for (int nt = 0; nt < 4; ++nt)
#pragma unroll
            for (int mt = 0; mt < 2; ++mt) {
                f32x16 c = {0.f, 0.f, 0.f, 0.f, 0.f, 0.f, 0.f, 0.f, 0.f, 0.f, 0.f, 0.f, 0.f, 0.f, 0.f, 0.f};
#pragma unroll
                for (int s = 0; s < (mt == 0 ? 2 : 4); ++s) { const bf16x8 af = *(const LAS bf16x8*)(wl + (32 * mt + r) * GA_USTR + (16 * s + 8 * hh) * 2); c = MFMA32(af, vf[nt][s], c); }
#pragma unroll
                for (int sp = 0; sp < 2; ++sp) *(bf16x8*)((unsigned char*)UN + (unsigned)(lane * 16) + ((nt * 2 + mt) * 2 + sp) * 1024) = pack8(c, sp);
            }
    }
    asm volatile("s_waitcnt lgkmcnt(0)" ::: "memory");
#pragma unroll
    for (int j4 = 0; j4 < 16; ++j4) { const f32x4 g4v = *(const LAS f32x4*)(Gs + 4 * j4), rk4 = *(const LAS f32x4*)(Rk + 4 * j4);
        t[4 * j4] *= fexp(g4v[0]) * rk4[0]; t[4 * j4 + 1] *= fexp(g4v[1]) * rk4[1]; t[4 * j4 + 2] *= fexp(g4v[2]) * rk4[2]; t[4 * j4 + 3] *= fexp(g4v[3]) * rk4[3]; }
#pragma unroll
    for (int j8 = 0; j8 < 8; ++j8) { u32x4 o; o.x = cvtpk(t[8 * j8], t[8 * j8 + 1]); o.y = cvtpk(t[8 * j8 + 2], t[8 * j8 + 3]); o.z = cvtpk(t[8 * j8 + 4], t[8 * j8 + 5]); o.w = cvtpk(t[8 * j8 + 6], t[8 * j8 + 7]);
        *(LAS u32x4*)(wl + lane * GA_USTR + 16 * j8) = o; }
    {
        const bf16_t* KTN = (const bf16_t*)(RM + G_KT) + (size_t)item * 8192;
        bf16_t* WN = (bf16_t*)(RM + G_WN) + (size_t)item * 8192;
#pragma unroll
        for (int it = 0; it < 2; ++it) {
            bf16x8 tw[4];
#pragma unroll
            for (int s = 0; s < (it == 0 ? 2 : 4); ++s) { const LAS unsigned char* rowp = wl + (32 * it + r) * GA_USTR + (16 * s + 4 * hh) * 2;
                const u32x2 lo = *(const LAS u32x2*)rowp, hi = *(const LAS u32x2*)(rowp + 16); u32x4 o; o.x = lo.x; o.y = lo.y; o.z = hi.x; o.w = hi.y; tw[s] = __builtin_bit_cast(bf16x8, o); }
            bf16x8 ktf[4][4];
#pragma unroll
            for (int dt = 0; dt < 4; ++dt)
#pragma unroll
                for (int s = 0; s < (it == 0 ? 2 : 4); ++s) ktf[dt][s] = *(const bf16x8*)((const unsigned char*)KTN + (unsigned)(lane * 16) + (dt * 4 + s) * 1024);
#pragma unroll
            for (int dt = 0; dt < 4; ++dt) {
                f32x16 c = {0.f, 0.f, 0.f, 0.f, 0.f, 0.f, 0.f, 0.f, 0.f, 0.f, 0.f, 0.f, 0.f, 0.f, 0.f, 0.f};
#pragma unroll
                for (int s = 0; s < (it == 0 ? 2 : 4); ++s) c = MFMA32(ktf[dt][s], tw[s], c);
#pragma unroll
                for (int q = 0; q < 16; ++q) c[q] = -c[q];
#pragma unroll
                for (int sp = 0; sp < 2; ++sp) *(bf16x8*)((unsigned char*)WN + (unsigned)(lane * 16) + (it * 8 + 2 * dt + sp) * 1024) = pack8(c, sp);
            }
        }
    }
    asm volatile("s_waitcnt lgkmcnt(0)" ::: "memory");
}

constexpr int GB_BUF = 58112;
__device__ __forceinline__ void gdn_b_scan(unsigned char* ws, LAS unsigned char* lds, const int bh, const int tid) {
    const int lane = tid & 63, wave = __builtin_amdgcn_readfirstlane(tid >> 6), r = lane & 31, hh = lane >> 5;
    unsigned char* RM = ws + WS_M;
    const int b = bh >> 3, h = bh & 7;
    const size_t item0 = (size_t)bh * 64;
    bf16_t* OO = (bf16_t*)(RM + G_OO);
    auto dma_chunk = [&](const size_t item, LAS unsigned char* buf) {
#pragma unroll
        for (int k = 0; k < 7; ++k) {
            const int pi = wave * 7 + k;
            const unsigned char* g;
            if (pi < 16) g = RM + G_WN + item * 16384 + (size_t)pi * 1024;
            else if (pi < 32) g = RM + G_QN + item * 16384 + (size_t)(pi - 16) * 1024;
            else if (pi < 40) g = RM + G_AN + item * 8192 + (size_t)(pi - 32) * 1024;
            else g = RM + G_KT + item * 16384 + (size_t)(pi - 40) * 1024;
            __builtin_amdgcn_global_load_lds((const unsigned*)(g + lane * 16), (LAS unsigned*)(buf + pi * 1024), 16, 0, 0);
        }
        if (wave >= 5) __builtin_amdgcn_global_load_lds((const unsigned*)(RM + G_EG + item * 768 + (size_t)(wave - 5) * 256 + lane * 4), (LAS unsigned*)(buf + 57344 + (wave - 5) * 256), 4, 0, 0);
    };
    f32x16 S[4];
#pragma unroll
    for (int dt = 0; dt < 4; ++dt)
#pragma unroll
        for (int q = 0; q < 16; ++q) S[dt][q] = 0.f;
    dma_chunk(item0, lds);
    bf16x8 Un[2][2];
    if (wave < 4) {
        const unsigned char* UN0 = RM + G_UN + item0 * 16384 + (size_t)wave * 4096 + lane * 16;
#pragma unroll
        for (int mt = 0; mt < 2; ++mt)
#pragma unroll
            for (int sp = 0; sp < 2; ++sp) Un[mt][sp] = *(const bf16x8*)(UN0 + (mt * 2 + sp) * 1024);
    }
    asm volatile("s_waitcnt vmcnt(0)" ::: "memory");
    __syncthreads();
#pragma unroll 1
    for (int n = 0; n < 64; ++n) {
        const size_t item = item0 + n;
        LAS unsigned char* buf = lds + (n & 1) * GB_BUF;
        f32x16 Vn[2], O[2];
        if (wave < 4) {
#pragma unroll
            for (int mt = 0; mt < 2; ++mt)
#pragma unroll
                for (int sp = 0; sp < 2; ++sp) { const u32x4 w = __builtin_bit_cast(u32x4, Un[mt][sp]);
                    Vn[mt][8 * sp + 0] = bflo(w.x); Vn[mt][8 * sp + 1] = bfhi(w.x); Vn[mt][8 * sp + 2] = bflo(w.y); Vn[mt][8 * sp + 3] = bfhi(w.y);
                    Vn[mt][8 * sp + 4] = bflo(w.z); Vn[mt][8 * sp + 5] = bfhi(w.z); Vn[mt][8 * sp + 6] = bflo(w.w); Vn[mt][8 * sp + 7] = bfhi(w.w); }
#pragma unroll
            for (int mt = 0; mt < 2; ++mt)
#pragma unroll
                for (int q = 0; q < 16; ++q) O[mt][q] = 0.f;
            if (n + 1 < 64) {
                const unsigned char* UN = RM + G_UN + (size_t)(item + 1) * 16384 + (size_t)wave * 4096 + lane * 16;
#pragma unroll
                for (int mt = 0; mt < 2; ++mt)
#pragma unroll
                    for (int sp = 0; sp < 2; ++sp) Un[mt][sp] = *(const bf16x8*)(UN + (mt * 2 + sp) * 1024);
            }
        }
        asm volatile("" ::: "memory");
        if (n + 1 < 64) dma_chunk(item + 1, lds + ((n + 1) & 1) * GB_BUF);
        asm volatile("" ::: "memory");
        if (wave < 4) {
            const int sl = wave;
            const LAS float* EGs = (const LAS float*)(buf + 57344);
            bf16x8 Sb[8];
#pragma unroll
            for (int dt = 0; dt < 4; ++dt) { Sb[2 * dt] = pack8(S[dt], 0); Sb[2 * dt + 1] = pack8(S[dt], 1); }
#pragma unroll
            for (int mt = 0; mt < 2; ++mt)
#pragma unroll
                for (int ks = 0; ks < 8; ++ks) {
                    const bf16x8 wf = *(const LAS bf16x8*)(buf + ((mt * 8 + ks) * 64 + lane) * 16);
                    const bf16x8 qf = *(const LAS bf16x8*)(buf + 16384 + ((mt * 8 + ks) * 64 + lane) * 16);
                    Vn[mt] = MFMA32(wf, Sb[ks], Vn[mt]);
                    O[mt] = MFMA32(qf, Sb[ks], O[mt]);
                }
#pragma unroll
            for (int mt = 0; mt < 2; ++mt)
#pragma unroll
                for (int g4 = 0; g4 < 4; ++g4) { const f32x4 E4 = *(const LAS f32x4*)(EGs + 32 * mt + 8 * g4 + 4 * hh);
#pragma unroll
                    for (int q = 0; q < 4; ++q) O[mt][4 * g4 + q] *= E4[q]; }
            bf16x8 Vb[4];
#pragma unroll
            for (int mt = 0; mt < 2; ++mt) { Vb[2 * mt] = pack8(Vn[mt], 0); Vb[2 * mt + 1] = pack8(Vn[mt], 1); }
#pragma unroll
            for (int mt = 0; mt < 2; ++mt)
#pragma unroll
                for (int ks = 0; ks < (mt == 0 ? 2 : 4); ++ks) {
                    const bf16x8 af = *(const LAS bf16x8*)(buf + 32768 + ((mt * 4 + ks) * 64 + lane) * 16);
                    O[mt] = MFMA32(af, Vb[ks], O[mt]);
                }
            {
                bf16_t* orow = OO + ((size_t)b * SEQ + (size_t)n * 64) * DM + h * 128 + sl * 32 + r;
#pragma unroll
                for (int mt = 0; mt < 2; ++mt)
#pragma unroll
                    for (int q = 0; q < 16; ++q) { const int pos = 32 * mt + (q & 3) + 8 * (q >> 2) + 4 * hh; orow[(size_t)pos * DM] = (bf16_t)f2bf(O[mt][q]); }
            }
#pragma unroll
            for (int mt = 0; mt < 2; ++mt)
#pragma unroll
                for (int g4 = 0; g4 < 4; ++g4) { const f32x4 L4 = *(const LAS f32x4*)(EGs + 64 + 32 * mt + 8 * g4 + 4 * hh);
#pragma unroll
                    for (int q = 0; q < 4; ++q) Vn[mt][4 * g4 + q] *= L4[q]; }
#pragma unroll
            for (int mt = 0; mt < 2; ++mt) { Vb[2 * mt] = pack8(Vn[mt], 0); Vb[2 * mt + 1] = pack8(Vn[mt], 1); }
            const float cd = EGs[128];
#pragma unroll
            for (int dt = 0; dt < 4; ++dt)
#pragma unroll
                for (int q = 0; q < 16; ++q) S[dt][q] *= cd;
#pragma unroll
            for (int ks = 0; ks < 4; ++ks)
#pragma unroll
                for (int dt = 0; dt < 4; ++dt) { const bf16x8 kt = *(const LAS bf16x8*)(buf + 40960 + ((dt * 4 + ks) * 64 + lane) * 16); S[dt] = MFMA32(kt, Vb[ks], S[dt]); }
            asm volatile("s_waitcnt vmcnt(32) lgkmcnt(0)" ::: "memory");
        } else {
            asm volatile("s_waitcnt vmcnt(0) lgkmcnt(0)" ::: "memory");
        }
        __syncthreads();
    }
}

constexpr int SW_KSTR = 144, SW_VSTR = 528, SW_K = 0, SW_V = 36864, SW_TB = 70656;
__device__ __forceinline__ void swa_phase(const CAS MArgs& a, unsigned char* ws, const int L, LAS unsigned char* lds, const int tid, const int bid, const int G) {
    const int lane = tid & 63, wave = __builtin_amdgcn_readfirstlane(tid >> 6), r = lane & 31, hh = lane >> 5;
    const bf16_t* PROJB = (const bf16_t*)(ws + WS_PROJ);
    bf16_t* SOB = (bf16_t*)(ws + WS_SO);
    LAS float* tb = (LAS float*)(lds + SW_TB);
    for (int idx = tid; idx < 2048; idx += 512) { const int hq = idx >> 7, dist = idx & 127; tb[idx] = as_global(a.in[I_RELB])[t5_bucket(dist) * 16 + hq] * 1.4426950408889634f; }
    __syncthreads();
#pragma unroll 1
    for (int item = bid; item < NBATCH * 32 * 4; item += G) {
        const int kvh = item & 3, nb = (item >> 2) & 31, b = item >> 7;
        const size_t tq0 = (size_t)b * SEQ + (size_t)nb * 128;
        {
            const int key = tid >> 1, half = tid & 1;
            const bool exists = (nb > 0) || (key >= 128);
            u32x4 kv[4], vv[4];
#pragma unroll
            for (int i = 0; i < 4; ++i) { kv[i] = (u32x4){0u, 0u, 0u, 0u}; vv[i] = kv[i]; }
            if (exists) {
                const bf16_t* rowp = PROJB + (tq0 - 128 + key) * PROJ_COLS + kvh * 64 + half * 32;
#pragma unroll
                for (int i = 0; i < 4; ++i) { kv[i] = *(const u32x4*)(rowp + PJ_KC + 8 * i); vv[i] = *(const u32x4*)(rowp + PJ_VC + 8 * i); }
            }
#pragma unroll
            for (int i = 0; i < 4; ++i) *(LAS u32x4*)(lds + SW_K + key * SW_KSTR + half * 64 + 16 * i) = kv[i];
#pragma unroll
            for (int i = 0; i < 4; ++i) {
                const unsigned w4[4] = {vv[i].x, vv[i].y, vv[i].z, vv[i].w};
#pragma unroll
                for (int q = 0; q < 4; ++q) { const int d = half * 32 + 8 * i + 2 * q;
                    *(LAS unsigned short*)(lds + SW_V + d * SW_VSTR + key * 2) = (unsigned short)(w4[q] & 0xffffu);
                    *(LAS unsigned short*)(lds + SW_V + (d + 1) * SW_VSTR + key * 2) = (unsigned short)(w4[q] >> 16); }
            }
        }
        __syncthreads();
        {
            const int g = wave >> 1, qh = wave & 1, hq = kvh * 4 + g;
            const float sink2 = as_global(a.in[I_SINKS])[L * 16 + hq] * 1.4426950408889634f;
#pragma unroll 1
            for (int qt = 0; qt < 2; ++qt) {
                const int i0 = 64 * qh + 32 * qt, kt0 = i0 >> 5;
                const size_t token = tq0 + i0 + r;
                bf16x8 qf[4];
#pragma unroll
                for (int s = 0; s < 4; ++s) qf[s] = *(const bf16x8*)(PROJB + token * PROJ_COLS + PJ_QC + hq * 64 + 16 * s + 8 * hh);
                f32x16 c[5];
#pragma unroll
                for (int k5 = 0; k5 < 5; ++k5) {
#pragma unroll
                    for (int q = 0; q < 16; ++q) c[k5][q] = 0.f;
#pragma unroll
                    for (int s = 0; s < 4; ++s) { const bf16x8 kf = *(const LAS bf16x8*)(lds + SW_K + (32 * (kt0 + k5) + r) * SW_KSTR + (16 * s + 8 * hh) * 2); c[k5] = MFMA32(kf, qf[s], c[k5]); }
                }
                float m = sink2;
#pragma unroll
                for (int k5 = 0; k5 < 5; ++k5)
#pragma unroll
                    for (int q = 0; q < 16; ++q) {
                        const int cr = (q & 3) + 8 * (q >> 2) + 4 * hh;
                        const int dist = 128 + r - 32 * k5 - cr;
                        bool valid = true;
                        if (k5 == 0) valid = dist <= 127;
                        if (k5 == 4) valid = dist >= 0;
                        if (nb == 0) valid = valid && (32 * (kt0 + k5) + cr >= 128);
                        const float sc = valid ? fmaf(c[k5][q], 0.125f * 1.4426950408889634f, tb[hq * 128 + (dist & 127)]) : -3.0e38f;
                        c[k5][q] = sc; m = fmaxf(m, sc);
                    }
                m = fmaxf(m, __shfl_xor(m, 32));
                float sum = 0.f;
#pragma unroll
                for (int k5 = 0; k5 < 5; ++k5)
#pragma unroll
                    for (int q = 0; q < 16; ++q) { const float p = __builtin_amdgcn_exp2f(c[k5][q] - m); c[k5][q] = p; sum += p; }
                sum += __shfl_xor(sum, 32);
                const float inv = 1.0f / (sum + __builtin_amdgcn_exp2f(sink2 - m));
                f32x16 o[2];
#pragma unroll
                for (int dt = 0; dt < 2; ++dt)
#pragma unroll
                    for (int q = 0; q < 16; ++q) o[dt][q] = 0.f;
#pragma unroll
                for (int k5 = 0; k5 < 5; ++k5)
#pragma unroll
                    for (int sp = 0; sp < 2; ++sp) {
                        const bf16x8 pf = pack8(c[k5], sp);
#pragma unroll
                        for (int dt = 0; dt < 2; ++dt) {
                            const LAS unsigned char* vp = lds + SW_V + (32 * dt + r) * SW_VSTR + (32 * (kt0 + k5) + 16 * sp + 4 * hh) * 2;
                            const u32x2 lo = *(const LAS u32x2*)vp, hi = *(const LAS u32x2*)(vp + 16);
                            u32x4 v4; v4.x = lo.x; v4.y = lo.y; v4.z = hi.x; v4.w = hi.y;
                            o[dt] = MFMA32(__builtin_bit_cast(bf16x8, v4), pf, o[dt]);
                        }
                    }
                bf16_t* orow = SOB + token * DM + hq * 64 + 4 * hh;
#pragma unroll
                for (int dt = 0; dt < 2; ++dt)
#pragma unroll
                    for (int g4 = 0; g4 < 4; ++g4) { u32x2 w; w.x = cvtpk(o[dt][4 * g4] * inv, o[dt][4 * g4 + 1] * inv); w.y = cvtpk(o[dt][4 * g4 + 2] * inv, o[dt][4 * g4 + 3] * inv);
                        *(u32x2*)(orow + 32 * dt + 8 * g4) = w; }
            }
        }
        __syncthreads();
    }
}

constexpr int LR_XSTR = 132;
constexpr int LR_X = 0, LR_W = 67584, LR_WSTR = 272, LR_AGG = 137216;
constexpr size_t LRM_AGG = 452 * MiB, LRM_CIN = 454 * MiB;
__device__ __forceinline__ void lru_l1(const CAS MArgs& a, unsigned char* ws, const int L, LAS unsigned char* lds, const int tid, const int bid, const int G) {
    const int lane = tid & 63, wave = __builtin_amdgcn_readfirstlane(tid >> 6), r = lane & 31, hh = lane >> 5;
    const bf16_t* PROJB = (const bf16_t*)(ws + WS_PROJ);
    unsigned char* RM = ws + WS_M;
    LAS float* xc = (LAS float*)(lds + LR_X);
    LAS float* agg = (LAS float*)(lds + LR_AGG);
    const int blk = bid & 7;
    int wblk = -1;
#pragma unroll 1
    for (int it = bid; it < NBATCH * 8 * 32; it += G) {
        const int ib = it & 7, bc = it >> 3, b = bc >> 5, chunk = bc & 31;
        const size_t t0 = (size_t)b * SEQ + (size_t)chunk * 128;
        if (ib != wblk) {
            const bf16_t* W = (const bf16_t*)(ws + WS_W + (size_t)L * WL_STRIDE + W_LRU) + (size_t)ib * 256 * 128;
            for (int i = tid; i < 256 * 16; i += 512) { const int n = i >> 4, seg = i & 15; *(LAS u32x4*)(lds + LR_W + n * LR_WSTR + seg * 16) = *(const u32x4*)(W + n * 128 + seg * 8); }
            wblk = ib;
        }
        {
            const int c2 = 2 * lane, tok0 = 16 * wave;
            const float* cw = as_global(a.in[I_RGCW]) + (size_t)L * 4 * 1024 + ib * 128 + c2;
            const f32x2 w0 = *(const f32x2*)cw, w1 = *(const f32x2*)(cw + 1024), w2 = *(const f32x2*)(cw + 2048), w3 = *(const f32x2*)(cw + 3072);
            const f32x2 cb = *(const f32x2*)(as_global(a.in[I_RGCB]) + L * 1024 + ib * 128 + c2);
            const bf16_t* src = PROJB + (t0 + tok0) * PROJ_COLS + PJ_XL + ib * 128 + c2;
            unsigned raw[19];
#pragma unroll
            for (int u = 0; u < 19; ++u) { const int tok = tok0 - 3 + u; raw[u] = (chunk * 128 + tok >= 0) ? *(const unsigned*)(src + (ptrdiff_t)(u - 3) * PROJ_COLS) : 0u; }
#pragma unroll
            for (int u = 0; u < 16; ++u) {
                float y0 = cb[0], y1 = cb[1];
                y0 = fmaf(w0[0], bflo(raw[u]), y0); y0 = fmaf(w1[0], bflo(raw[u + 1]), y0); y0 = fmaf(w2[0], bflo(raw[u + 2]), y0); y0 = fmaf(w3[0], bflo(raw[u + 3]), y0);
                y1 = fmaf(w0[1], bfhi(raw[u]), y1); y1 = fmaf(w1[1], bfhi(raw[u + 1]), y1); y1 = fmaf(w2[1], bfhi(raw[u + 2]), y1); y1 = fmaf(w3[1], bfhi(raw[u + 3]), y1);
                *(LAS f32x2*)(xc + (tok0 + u) * LR_XSTR + c2) = (f32x2){y0, y1};
            }
        }
        __syncthreads();
        const int mt = wave >> 1, ch0 = 64 * (wave & 1);
        f32x16 acc[4];
#pragma unroll
        for (int nt = 0; nt < 4; ++nt)
#pragma unroll
            for (int q = 0; q < 16; ++q) acc[nt][q] = 0.f;
#pragma unroll
        for (int s = 0; s < 8; ++s) {
            const LAS float* ap = xc + (32 * mt + r) * LR_XSTR + 16 * s + 8 * hh;
            const f32x4 x0 = *(const LAS f32x4*)ap, x1 = *(const LAS f32x4*)(ap + 4);
            u32x4 af; af.x = cvtpk(x0[0], x0[1]); af.y = cvtpk(x0[2], x0[3]); af.z = cvtpk(x1[0], x1[1]); af.w = cvtpk(x1[2], x1[3]);
#pragma unroll
            for (int nt = 0; nt < 4; ++nt) {
                const int n = (nt >> 1) * 128 + ch0 + 32 * (nt & 1) + r;
                const bf16x8 bfrag = *(const LAS bf16x8*)(lds + LR_W + n * LR_WSTR + (16 * s + 8 * hh) * 2);
                acc[nt] = MFMA32(__builtin_bit_cast(bf16x8, af), bfrag, acc[nt]);
            }
        }
        float hl[2][16], pc[2][16], Pt[2], Ht[2];
#pragma unroll
        for (int ct = 0; ct < 2; ++ct) {
            const int ch = ch0 + 32 * ct + r, cg = L * 1024 + ib * 128 + ch;
            const float ba = as_global(a.in[I_RGBA])[cg], bx = as_global(a.in[I_RGBX])[cg], sp = 8.0f * softplusf_(-as_global(a.in[I_RGLAM])[cg]);
            float P4[4], H4[4];
#pragma unroll
            for (int g4 = 0; g4 < 4; ++g4) {
                float p = 1.f, h = 0.f;
#pragma unroll
                for (int q = 0; q < 4; ++q) {
                    const int tok = 32 * mt + 8 * g4 + 4 * hh + q;
                    const float rr = sigmoidf_(acc[ct][4 * g4 + q] + ba), ig = sigmoidf_(acc[2 + ct][4 * g4 + q] + bx);
                    const float av = fexp(-sp * rr);
                    const float uv = sqrtf(fmaxf(fmaf(-av, av, 1.0f), 0.f)) * ig * xc[tok * LR_XSTR + ch];
                    p *= av; h = fmaf(av, h, uv);
                    pc[ct][4 * g4 + q] = p; hl[ct][4 * g4 + q] = h;
                }
                P4[g4] = p; H4[g4] = h;
            }
            float c = 0.f, P = 1.f, cin[4], ppre[4];
#pragma unroll
            for (int g4 = 0; g4 < 4; ++g4) {
                const float oP = __shfl_xor(P4[g4], 32), oH = __shfl_xor(H4[g4], 32);
                const float eP = hh ? oP : P4[g4], eH = hh ? oH : H4[g4];
                const float dP = hh ? P4[g4] : oP, dH = hh ? H4[g4] : oH;
                const float c1 = fmaf(eP, c, eH), P1 = P * eP;
                cin[g4] = hh ? c1 : c; ppre[g4] = hh ? P1 : P;
                c = fmaf(dP, c1, dH); P = P1 * dP;
            }
#pragma unroll
            for (int g4 = 0; g4 < 4; ++g4)
#pragma unroll
                for (int q = 0; q < 4; ++q) { hl[ct][4 * g4 + q] = fmaf(pc[ct][4 * g4 + q], cin[g4], hl[ct][4 * g4 + q]); pc[ct][4 * g4 + q] *= ppre[g4]; }
            Pt[ct] = P; Ht[ct] = c;
            if (hh == 0) *(LAS f32x2*)(agg + (mt * 128 + ch) * 2) = (f32x2){P, c};
        }
        __syncthreads();
        bf16_t* HL = (bf16_t*)(ws + WS_XF); bf16_t* PC = (bf16_t*)(ws + WS_LO);
#pragma unroll
        for (int ct = 0; ct < 2; ++ct) {
            const int ch = ch0 + 32 * ct + r;
            float cT = 0.f, PT = 1.f;
            for (int m2 = 0; m2 < mt; ++m2) { const f32x2 ag = *(const LAS f32x2*)(agg + (m2 * 128 + ch) * 2); cT = fmaf(ag[0], cT, ag[1]); PT *= ag[0]; }
            if (mt == 3 && hh == 0) {
                const float ci = fmaf(Pt[ct], cT, Ht[ct]), Pi = PT * Pt[ct];
                *(f32x2*)((float*)(RM + LRM_AGG) + ((size_t)(b * 32 + chunk) * 1024 + ib * 128 + ch) * 2) = (f32x2){Pi, ci};
            }
            const size_t obase = (t0 + 32 * mt) * DM + ib * 128 + ch;
#pragma unroll
            for (int q16 = 0; q16 < 16; ++q16) {
                const int tok = (q16 & 3) + 8 * (q16 >> 2) + 4 * hh;
                HL[obase + (size_t)tok * DM] = (bf16_t)f2bf(fmaf(pc[ct][q16], cT, hl[ct][q16]));
                PC[obase + (size_t)tok * DM] = (bf16_t)f2bf(pc[ct][q16] * PT);
            }
        }
        __syncthreads();
    }
}

#define XB_TMO      128
#define XB_XCNT(j)  (256  + 64 * (j))
#define XB_XSUB(j)  (1280 + 64 * (j))
#define XB_XGEN(j)  (2304 + 64 * (j))
#define XB_TOP      3328
#define XB_TOPGEN   3392
#define XCD_BAR_WORDS 3456
#define XB_SPIN_CAP (1u << 18)
__device__ __forceinline__ unsigned xb_ld(unsigned* p)              { return __hip_atomic_load(p, __ATOMIC_RELAXED, __HIP_MEMORY_SCOPE_AGENT); }
__device__ __forceinline__ unsigned xb_add(unsigned* p, unsigned v) { return __hip_atomic_fetch_add(p, v, __ATOMIC_RELAXED, __HIP_MEMORY_SCOPE_AGENT); }
__device__ __forceinline__ unsigned xb_xcc_id() { return (unsigned)__builtin_amdgcn_s_getreg((3 << 11) | 20) & 0xFu; }
#define XB_SPIN(cond, bar) do { unsigned _sp = 0; while (cond) { __builtin_amdgcn_s_sleep(1); \
    if ((++_sp & 255u) == 0u) { if (xb_ld(&(bar)[XB_TMO])) break; if (_sp > XB_SPIN_CAP) { atomicAdd(&(bar)[XB_TMO], 1u); break; } } } } while (0)
struct XcdBarrier { unsigned* bar; unsigned x; volatile LAS unsigned* st; };
__device__ __forceinline__ XcdBarrier xcd_barrier_post(unsigned* bar, volatile LAS unsigned* st) {
    XcdBarrier b; b.bar = bar; b.x = xb_xcc_id(); b.st = st;
    if (threadIdx.x == 0) (void)xb_add(&bar[XB_XCNT(b.x)], 1u);
    return b;
}
__device__ __forceinline__ void xcd_barrier_complete(unsigned* bar, unsigned x, unsigned& nloc, unsigned& nx) {
    const unsigned G = gridDim.x * gridDim.y * gridDim.z;
    unsigned sum, cnt, mine, sp = 0u;
    for (;;) {
        sum = 0u; cnt = 0u; mine = 0u;
#pragma unroll
        for (unsigned j = 0; j < 16; ++j) { const unsigned c = xb_ld(&bar[XB_XCNT(j)]); sum += c; cnt += (c > 0u) ? 1u : 0u; mine = (j == x) ? c : mine; }
        if (sum == G) break;
        __builtin_amdgcn_s_sleep(1);
        if ((++sp & 255u) == 0u) { if (xb_ld(&bar[XB_TMO])) break; if (sp > XB_SPIN_CAP) { atomicAdd(&bar[XB_TMO], 1u); break; } }
    }
    nloc = mine > 0u ? mine : 1u; nx = cnt > 0u ? cnt : 1u;
}
__device__ __forceinline__ void xcd_barrier(const XcdBarrier& b) {
    asm volatile("s_waitcnt vmcnt(0)" ::: "memory");
    __syncthreads();
    if (threadIdx.x == 0) {
        unsigned* bar = b.bar;
        __builtin_amdgcn_s_waitcnt(0);
        unsigned nloc = b.st[0], nx = b.st[1];
        if (nloc == 0u) { xcd_barrier_complete(bar, b.x, nloc, nx); b.st[0] = nloc; b.st[1] = nx; }
        const unsigned old = xb_add(&bar[XB_XSUB(b.x)], 1u);
        const unsigned gen = old / nloc;
        if (old + 1u == (gen + 1u) * nloc) {
            __builtin_amdgcn_fence(__ATOMIC_RELEASE, "agent");
            asm volatile("s_waitcnt vmcnt(0)" ::: "memory");
            const unsigned og = xb_add(&bar[XB_TOP], 1u);
            const unsigned tg = og / nx;
            if (og + 1u == (tg + 1u) * nx) xb_add(&bar[XB_TOPGEN], 1u);
            else XB_SPIN(xb_ld(&bar[XB_TOPGEN]) == tg, bar);
            __builtin_amdgcn_fence(__ATOMIC_ACQUIRE, "agent");
            xb_add(&bar[XB_XGEN(b.x)], 1u);
            asm volatile("s_waitcnt vmcnt(0)" ::: "memory");
        } else {
            XB_SPIN(xb_ld(&bar[XB_XGEN(b.x)]) == gen, bar);
            __builtin_amdgcn_fence(__ATOMIC_ACQUIRE, "agent");
            asm volatile("s_waitcnt vmcnt(0)" ::: "memory");
        }
    }
    __syncthreads();
}


__device__ __forceinline__ int launder_s(int x) { asm volatile("" : "+s"(x)); return x; }
enum { K_INPROJ = 0, K_GDNPREP, K_GDNREC, K_GDNPOST, K_LRUCONV, K_LRUGATE, K_LRUSCAN, K_SWA, K_BRANCH, K_WOUT, K_LN1, K_SCATTER, K_MOE1, K_MOE2, K_LN2, K_PLEP, K_PLEG, K_LN3, NPL };
constexpr int NPHASES = 1 + DEPTH * NPL;

__global__ void __launch_bounds__(NWAVES * 64, 2) mega(MArgs a_raw) {
    extern __shared__ __attribute__((aligned(16))) unsigned char lds_raw[];
    LAS unsigned char* lds0 = (LAS unsigned char*)lds_raw;
    const int wave0 = __builtin_amdgcn_readfirstlane((int)threadIdx.x >> 6);
    volatile LAS unsigned* MISC = (volatile LAS unsigned*)(lds0 + LDS_MISC);
#define PH_PTRS(Lv) \
    const CAS MArgs* ap_ = (const CAS MArgs*)__builtin_amdgcn_kernarg_segment_ptr(); asm volatile("" : "+s"(ap_)); const CAS MArgs& a = *ap_; \
    unsigned char* ws = as_global(a.ws); int L = (Lv); unsigned z_ = 0u; int wave_ = wave0; unsigned ldsb_ = 0u; asm volatile("" : "+s"(L), "+s"(wave_), "+s"(ldsb_)); asm volatile("" : "+v"(z_)); \
    const int lane_ = (int)__builtin_amdgcn_mbcnt_hi(~0u, __builtin_amdgcn_mbcnt_lo(~0u, z_)); \
    LAS unsigned char* lds = lds0 + ldsb_; LAS int* tstart = (LAS int*)(lds + LDS_MISC + 256); (void)tstart; \
    int bid_ = blockIdx.x, G_ = gridDim.x; asm volatile("" : "+s"(bid_), "+s"(G_)); \
    const int lane = lane_, wave = wave_, tid = wave * 64 + lane, bid = bid_, G = G_, NGW = G_ * NWAVES, gw = bid * NWAVES + wave; (void)lane; (void)wave; (void)tid; (void)bid; (void)gw; (void)G; (void)NGW; \
    unsigned* ctl = (unsigned*)(ws + WS_CTL); (void)ctl; \
    bf16_t* XB = (bf16_t*)(ws + WS_XB); float* XF = (float*)(ws + WS_XF); bf16_t* PROJB = (bf16_t*)(ws + WS_PROJ); (void)XB; (void)XF; (void)PROJB; \
    bf16_t* GOB = (bf16_t*)(ws + WS_GO); bf16_t* LOB = (bf16_t*)(ws + WS_LO); bf16_t* SOB = (bf16_t*)(ws + WS_SO); (void)GOB; (void)LOB; (void)SOB; \
    unsigned char* RM = ws + WS_M; (void)RM; \
    float* AB = (float*)(ws + WS_AB); float* GG = (float*)(ws + WS_GG); float* BT = (float*)(ws + WS_BT); (void)AB; (void)GG; (void)BT; \
    float* GATES = (float*)(ws + WS_GATES); int* ES = (int*)(ws + WS_ES); int* LIST = (int*)(ws + WS_LIST); (void)GATES; (void)ES; (void)LIST; \
    unsigned char* wl = ws + WS_W + (size_t)L * WL_STRIDE; (void)wl; \
    unsigned* cnt = ctl + CW_CNT + 2048 * L; (void)cnt;
    const int lo = a_raw.ph_lo, hi = a_raw.ph_hi;
#if !N_LAUNCH_PER_PHASE
    if (threadIdx.x < 4) MISC[threadIdx.x] = 0u;
    __syncthreads();
    XcdBarrier bar = xcd_barrier_post((unsigned*)(a_raw.ws + WS_CTL) + CW_BAR, MISC);
#ifndef BARDUP
#define BARDUP 1
#endif
#define GRID_BAR(ph) do { if ((ph) + 1 < hi) { for (int bi_ = 0; bi_ < BARDUP; ++bi_) xcd_barrier(bar); } } while (0)
#else
#define GRID_BAR(ph) do { } while (0)
#endif
#define IN(ph) (launder_s(lo) <= (ph) && (ph) < launder_s(hi))
#define STAMP(ph) do { if (PROBE_ON && blockIdx.x == 0 && threadIdx.x == 0) ((unsigned*)(a_raw.ws + WS_CTL))[CW_TS + (ph)] = (unsigned)__builtin_amdgcn_s_memrealtime(); } while (0)

    if (IN(0)) {
        STAMP(0);
        for (int rep_ = 0; rep_ < ((DUPMASK >> 30) & 1) + 1; ++rep_) {
        PH_PTRS(0)
        LAS float* scr = (LAS float*)(lds + wave * 17408);
        for (int Lc = 0; Lc < DEPTH; ++Lc) {
            L = Lc; wl = ws + WS_W + (size_t)L * WL_STRIDE;
            transpose_seg<1>(as_global(a.in[I_WIN]) + (size_t)L * DM * IN_COLS, DM, IN_COLS, PROJ_COLS, (bf16_t*)(wl + W_IN), scr, gw, NGW, lane);
            transpose_seg<0>(as_global(a.in[I_WOG]) + (size_t)L * DM * DM, DM, DM, DM, (bf16_t*)(wl + W_O3), scr, gw, NGW, lane);
            transpose_seg<0>(as_global(a.in[I_WOL]) + (size_t)L * DM * DM, DM, DM, DM, (bf16_t*)(wl + W_O3) + (size_t)DM * DM, scr, gw, NGW, lane);
            transpose_seg<0>(as_global(a.in[I_WOS]) + (size_t)L * DM * DM, DM, DM, DM, (bf16_t*)(wl + W_O3) + (size_t)2 * DM * DM, scr, gw, NGW, lane);
            transpose_seg<0>(as_global(a.in[I_WOUT]) + (size_t)L * DM * DM, DM, DM, DM, (bf16_t*)(wl + W_OUT), scr, gw, NGW, lane);
            transpose_seg<0>(as_global(a.in[I_PLEG]) + (size_t)L * DM * DM, DM, DM, DM, (bf16_t*)(wl + W_PG), scr, gw, NGW, lane);
            transpose_seg<0>(as_global(a.in[I_PLEP]) + (size_t)L * PLE_DIM * DM, PLE_DIM, DM, DM, (bf16_t*)(wl + W_PP), scr, gw, NGW, lane);
            for (int it = gw; it < NEXP * 512; it += NGW) { const int e = it >> 9;
                transpose_item_gu(as_global(a.in[I_WGU]) + ((size_t)L * NEXP + e) * DM * 2048, (bf16_t*)(wl + W_GU) + (size_t)e * 2048 * DM, scr, it & 511, lane); }
            for (int it = gw; it < NEXP * 512; it += NGW) { const int e = it >> 9;
                transpose_item<0>(as_global(a.in[I_WDN]) + ((size_t)L * NEXP + e) * DM * DM, DM, DM, DM, (bf16_t*)(wl + W_DN) + (size_t)e * DM * DM, scr, it & 511, lane); }
            for (int blk = 0; blk < 8; ++blk) {
                transpose_seg<0>(as_global(a.in[I_RGWA]) + ((size_t)L * 8 + blk) * 128 * 128, 128, 128, 128, (bf16_t*)(wl + W_LRU) + (size_t)blk * 256 * 128, scr, gw, NGW, lane);
                transpose_seg<0>(as_global(a.in[I_RGWX]) + ((size_t)L * 8 + blk) * 128 * 128, 128, 128, 128, (bf16_t*)(wl + W_LRU) + (size_t)blk * 256 * 128 + 128 * 128, scr, gw, NGW, lane);
            }
        }
        cvt_rows(as_global(a.in[I_P]), (bf16_t*)(ws + WS_PB), (size_t)DEPTH * NTOK * PLE_DIM, G);
        __syncthreads();
        stage_smallw<4>(as_global(a.in[I_WIN]), IN_COLS, OFF_A, lds, tid);
        __syncthreads();
        unsigned abdep = 0u;
        for (int t0 = gw * 4; t0 < NTOK; t0 += NGW * 4) {
            f32x4 vv[4][4];
#pragma unroll
            for (int u = 0; u < 4; ++u)
#pragma unroll
                for (int j = 0; j < 4; ++j) vv[u][j] = *(const f32x4*)(as_global(a.in[I_X]) + (size_t)(t0 + u) * DM + 256 * j + 4 * lane);
#pragma unroll
            for (int u = 0; u < 4; ++u) store_row(vv[u], nullptr, XB + (size_t)(t0 + u) * DM, lane);
            ab_project4(vv, lds, AB + (size_t)t0 * 16, lane, abdep);
        }
        }
        GRID_BAR(0);
    }

    for (int Lloop = 0; Lloop < DEPTH; ++Lloop) {
        const int pb = 1 + Lloop * NPL;

        if (IN(pb + K_INPROJ)) {
            STAMP(pb + K_INPROJ);
            for (int rep_ = 0; rep_ < NREP(K_INPROJ); ++rep_) {
            PH_PTRS(Lloop)
            pg8::DenseSched S{(const char*)XB, (const char*)(wl + W_IN), NTOK / 256, PROJ_COLS / 256, G, bid, DM};
            pg8::EpiBf16 E{PROJB, PROJ_COLS, nullptr, 0};
            pg8::gemm_phase<pg8::EpiBf16, pg8::DenseSched, true>(lds, DM, S, E, tid);
            }
            GRID_BAR(pb + K_INPROJ);
        }
        if (IN(pb + K_GDNPREP)) {
            STAMP(pb + K_GDNPREP);
            for (int rep_ = 0; rep_ < NREP(K_GDNPREP); ++rep_) {
            PH_PTRS(Lloop)
            LAS unsigned char* wlds = lds + wave * GA_LDS;
#pragma unroll 1
            for (int it = gw; it < NBATCH * 8 * 64; it += NGW) {
                int ln = lane; unsigned char* wsi = ws; unsigned wli = (unsigned)(size_t)wlds; asm volatile("" : "+s"(wli)); asm volatile("" : "+v"(ln)); wsi = as_global(wsi);
                gdn_a_item(a, wsi, L, (LAS unsigned char*)(size_t)wli, it, ln, gw);
            }
            }
            GRID_BAR(pb + K_GDNPREP);
        }
        if (IN(pb + K_GDNREC)) {
            STAMP(pb + K_GDNREC);
            for (int rep_ = 0; rep_ < NREP(K_GDNREC); ++rep_) {
            PH_PTRS(Lloop)
            if (G > NBATCH * 8 + 8) {
                if (bid < NBATCH * 8) gdn_b_scan(ws, lds, bid, tid);
                else { swa_phase(a, ws, L, lds, tid, bid - NBATCH * 8, G - NBATCH * 8); __syncthreads(); lru_l1(a, ws, L, lds, tid, bid - NBATCH * 8, G - NBATCH * 8); }
            } else {
                for (int bh = bid; bh < NBATCH * 8; bh += G) { gdn_b_scan(ws, lds, bh, tid); __syncthreads(); }
                swa_phase(a, ws, L, lds, tid, bid, G); __syncthreads(); lru_l1(a, ws, L, lds, tid, bid, G);
            }
            }
            GRID_BAR(pb + K_GDNREC);
        }
        if (IN(pb + K_GDNPOST)) {
            STAMP(pb + K_GDNPOST);
            for (int rep_ = 0; rep_ < NREP(K_GDNPOST); ++rep_) {
            PH_PTRS(Lloop)
            const bf16_t* OO = (const bf16_t*)(RM + G_OO);
            float nw[16];
            { const float* nwp = as_global(a.in[I_GNW]) + L * 128 + (lane & 7) * 16;
#pragma unroll
              for (int q = 0; q < 4; ++q) { const f32x4 w4 = *(const f32x4*)(nwp + 4 * q); nw[4 * q] = w4[0]; nw[4 * q + 1] = w4[1]; nw[4 * q + 2] = w4[2]; nw[4 * q + 3] = w4[3]; } }
            for (int t0 = gw * 4; t0 < NTOK; t0 += NGW * 4) {
                u32x4 ov[4][2], zv[4][2];
#pragma unroll
                for (int u = 0; u < 4; ++u) { const size_t t = (size_t)(t0 + u);
                    ov[u][0] = *(const u32x4*)(OO + t * DM + 16 * lane); ov[u][1] = *(const u32x4*)(OO + t * DM + 16 * lane + 8);
                    zv[u][0] = *(const u32x4*)(PROJB + t * PROJ_COLS + PJ_Z + 16 * lane); zv[u][1] = *(const u32x4*)(PROJB + t * PROJ_COLS + PJ_Z + 16 * lane + 8); }
#pragma unroll
                for (int u = 0; u < 4; ++u) {
                    const unsigned ow[8] = {ov[u][0].x, ov[u][0].y, ov[u][0].z, ov[u][0].w, ov[u][1].x, ov[u][1].y, ov[u][1].z, ov[u][1].w};
                    const unsigned zw[8] = {zv[u][0].x, zv[u][0].y, zv[u][0].z, zv[u][0].w, zv[u][1].x, zv[u][1].y, zv[u][1].z, zv[u][1].w};
                    float ss = 0.f;
#pragma unroll
                    for (int q = 0; q < 8; ++q) { ss = fmaf(bflo(ow[q]), bflo(ow[q]), ss); ss = fmaf(bfhi(ow[q]), bfhi(ow[q]), ss); }
                    ss += __shfl_xor(ss, 1); ss += __shfl_xor(ss, 2); ss += __shfl_xor(ss, 4);
                    const float rr = rsqrtf(ss * (1.0f / 128.0f) + 1e-6f);
                    unsigned res[8];
#pragma unroll
                    for (int q = 0; q < 8; ++q) res[q] = pk2(bflo(ow[q]) * rr * nw[2 * q] * siluf_(bflo(zw[q])), bfhi(ow[q]) * rr * nw[2 * q + 1] * siluf_(bfhi(zw[q])));
                    bf16_t* gp = GOB + (size_t)(t0 + u) * DM + 16 * lane;
                    *(u32x4*)gp = (u32x4){res[0], res[1], res[2], res[3]}; *(u32x4*)(gp + 8) = (u32x4){res[4], res[5], res[6], res[7]};
                }
            }
            {
                const bf16_t* HL = (const bf16_t*)(ws + WS_XF); const float* AGG = (const float*)(RM + LRM_AGG);
                LAS float* cl = (LAS float*)lds;
                for (int it = bid; it < NBATCH * 32; it += G) {
                    const int b = it >> 5, chunk = it & 31;
                    float c0 = 0.f, c1 = 0.f;
                    const float* ap = AGG + ((size_t)(b * 32) * 1024 + 2 * tid) * 2;
#pragma unroll 8
                    for (int cp = 0; cp < chunk; ++cp) { const f32x4 ag = *(const f32x4*)(ap + (size_t)cp * 2048); c0 = fmaf(ag[0], c0, ag[1]); c1 = fmaf(ag[2], c1, ag[3]); }
                    *(LAS f32x2*)(cl + 2 * tid) = (f32x2){c0, c1};
                    __syncthreads();
                    for (int i = tid; i < 128 * 128; i += 512) {
                        const size_t t = (size_t)b * SEQ + (size_t)chunk * 128 + (i >> 7); const int c8 = (i & 127) * 8;
                        const u32x4 h4 = *(const u32x4*)(HL + t * DM + c8), p4 = *(const u32x4*)(LOB + t * DM + c8), g4 = *(const u32x4*)(PROJB + t * PROJ_COLS + PJ_GL + c8);
                        const f32x4 ca = *(const LAS f32x4*)(cl + c8), cb = *(const LAS f32x4*)(cl + c8 + 4);
                        const unsigned hw[4] = {h4.x, h4.y, h4.z, h4.w}, pw[4] = {p4.x, p4.y, p4.z, p4.w}, gw4[4] = {g4.x, g4.y, g4.z, g4.w};
                        const float cc[8] = {ca[0], ca[1], ca[2], ca[3], cb[0], cb[1], cb[2], cb[3]};
                        unsigned ow[4];
#pragma unroll
                        for (int q = 0; q < 4; ++q) {
                            const float v0 = fmaf(bflo(pw[q]), cc[2 * q], bflo(hw[q])) * gelu_tanhf_(bflo(gw4[q]));
                            const float v1 = fmaf(bfhi(pw[q]), cc[2 * q + 1], bfhi(hw[q])) * gelu_tanhf_(bfhi(gw4[q]));
                            ow[q] = pk2(v0, v1);
                        }
                        *(u32x4*)(LOB + t * DM + c8) = (u32x4){ow[0], ow[1], ow[2], ow[3]};
                    }
                    __syncthreads();
                }
            }
            }
            GRID_BAR(pb + K_GDNPOST);
        }
        if (IN(pb + K_BRANCH)) {
            STAMP(pb + K_BRANCH);
            for (int rep_ = 0; rep_ < NREP(K_BRANCH); ++rep_) {
            PH_PTRS(Lloop)
            pg8::BranchSched S{(const char*)GOB, (const char*)LOB, (const char*)SOB, (const char*)(wl + W_O3), G, bid};
            pg8::EpiBranch E{(bf16_t*)(RM + M_MRG), (bf16_t*)(RM + M_MRG + 64 * MiB), (bf16_t*)(RM + M_MRGB), PROJB};
            pg8::gemm_phase<pg8::EpiBranch, pg8::BranchSched, true>(lds, DM, S, E, tid);
            }
            GRID_BAR(pb + K_BRANCH);
        }
        if (IN(pb + K_WOUT)) {
            STAMP(pb + K_WOUT);
            for (int rep_ = 0; rep_ < NREP(K_WOUT); ++rep_) {
            PH_PTRS(Lloop)
            pg8::DenseSched S{(const char*)(RM + M_MRGB), (const char*)(wl + W_OUT), NTOK / 256, DM / 256, G, bid, DM};
            pg8::EpiBf16 E{(bf16_t*)(RM + M_YY), DM, nullptr, 0};
            pg8::gemm_phase<pg8::EpiBf16, pg8::DenseSched, true>(lds, DM, S, E, tid);
            }
            GRID_BAR(pb + K_WOUT);
        }
        if (IN(pb + K_LN1)) {
            STAMP(pb + K_LN1);
            for (int rep_ = 0; rep_ < NREP(K_LN1); ++rep_) {
            PH_PTRS(Lloop)
            const bf16_t* YY = (const bf16_t*)(RM + M_YY);
            stage_smallw<8>(as_global(a.in[I_RW]) + (size_t)L * DM * NEXP, NEXP, 0, lds, tid);
            const float rbv = as_global(a.in[I_RB])[L * NEXP + (lane >> 1)];
            LAS unsigned* rt_lcnt = (LAS unsigned*)(lds + 131072); LAS unsigned* rt_base = rt_lcnt + 32; LAS int* rt_n = (LAS int*)(rt_lcnt + 64);
            LAS int* rt_tokall = (LAS int*)(rt_lcnt + 128); LAS int* rt_esall = rt_tokall + 512;
            LAS int* rt_tok = rt_tokall + wave * 64; LAS int* rt_es = rt_esall + wave * 64;
            if (tid < 64) rt_lcnt[tid] = 0u;
            int nloc = 0;
            __syncthreads();
            for (int t0 = gw * 4; t0 < NTOK; t0 += NGW * 4) {
                f32x4 vv[4][4];
#pragma unroll
                for (int u = 0; u < 4; ++u)
#pragma unroll
                    for (int j = 0; j < 4; ++j) vv[u][j] = ld_bf4(XB + (size_t)(t0 + u) * DM + 256 * j + 4 * lane) * ALPHA + ld_bf4(YY + (size_t)(t0 + u) * DM + 256 * j + 4 * lane);
#pragma unroll
                for (int up = 0; up < 2; ++up) {
                float mine2[2];
                {
                    f32x4 (&v0)[4] = vv[2 * up]; f32x4 (&v1)[4] = vv[2 * up + 1];
                    ln_inplace(v0, as_global(a.in[I_LN1G]) + L * DM, as_global(a.in[I_LN1B]) + L * DM, lane);
                    store_row(v0, nullptr, XB + (size_t)(t0 + 2 * up) * DM, lane);
                    ln_inplace(v1, as_global(a.in[I_LN1G]) + L * DM, as_global(a.in[I_LN1B]) + L * DM, lane);
                    store_row(v1, nullptr, XB + (size_t)(t0 + 2 * up + 1) * DM, lane);
                    float acc0[NEXP], acc1[NEXP];
                    small_project2<8>(v0, v1, lds, acc0, acc1, lane);
                    mine2[0] = reduce_scatter32(acc0, lane);
                    mine2[1] = reduce_scatter32(acc1, lane);
                }
#pragma unroll
                for (int uu = 0; uu < 2; ++uu) {
                const int t = t0 + 2 * up + uu;
                float mine = (lane & 1) ? -INFINITY : mine2[uu] + rbv;
                float tv[4]; int ti[4];
#pragma unroll
                for (int k = 0; k < 4; ++k) {
                    const float mx = wave_max(mine);
                    const unsigned long long bal = __ballot(mine == mx);
                    const int idx = __ffsll((long long)bal) - 1;
                    tv[k] = mx; ti[k] = idx >> 1;
                    if (lane == idx) mine = -INFINITY;
                }
                if (lane == 0 && rep_ == 0) {
                    const float e1 = expf(tv[1] - tv[0]), e2 = expf(tv[2] - tv[0]), e3 = expf(tv[3] - tv[0]);
                    const float inv = 1.0f / (1.0f + e1 + e2 + e3);
                    *(f32x4*)(GATES + (size_t)t * 4) = (f32x4){inv, e1 * inv, e2 * inv, e3 * inv};
#pragma unroll
                    for (int k = 0; k < 4; ++k) {
                        const int ls = (int)__hip_atomic_fetch_add((LAS unsigned*)(rt_lcnt + ti[k]), 1u, __ATOMIC_RELAXED, __HIP_MEMORY_SCOPE_WORKGROUP);
                        rt_tok[nloc * 4 + k] = t; rt_es[nloc * 4 + k] = ti[k] | (ls << 5);
                    }
                }
                ++nloc;
                }
                }
            }
            if (lane == 0) rt_n[wave] = nloc;
            __syncthreads();
            if (rep_ == 0) {
                if (tid < NEXP) { const unsigned c = rt_lcnt[tid]; rt_base[tid] = c ? atomicAdd(&cnt[64 * tid], c) : 0u; }
                __syncthreads();
                for (int i = tid; i < 8 * 16 * 4; i += 512) {
                    const int w = i >> 6, j = (i >> 2) & 15;
                    if (j < rt_n[w]) { const int es = rt_esall[i], e = es & 31, slot = (int)rt_base[e] + (es >> 5), t = rt_tokall[i];
                        ES[t * 4 + (i & 3)] = e | (slot << 5); LIST[(size_t)e * NTOK + slot] = t; }
                }
            }
            }
            GRID_BAR(pb + K_LN1);
        }
        if (IN(pb + K_MOE1) || IN(pb + K_MOE2) || IN(pb + K_LN2)) {
            PH_PTRS(Lloop)
            __syncthreads();
            if (tid == 0) { int accu = 0; for (int e = 0; e < NEXP; ++e) { const int ce = (int)__hip_atomic_load(&cnt[64 * e], __ATOMIC_RELAXED, __HIP_MEMORY_SCOPE_AGENT); tstart[e] = accu; tstart[64 + e] = ce; accu += (ce + 255) >> 8; } tstart[NEXP] = accu; }
            __syncthreads();
        }
        if (IN(pb + K_MOE1)) {
            STAMP(pb + K_MOE1);
            for (int rep_ = 0; rep_ < NREP(K_MOE1); ++rep_) {
            PH_PTRS(Lloop)
            pg8::MoeGatherSched S{(const char*)XB, (const char*)(wl + W_GU), tstart, (size_t)2048 * DM * 2, 8, G, bid, (const char*)XB, LIST, tstart + 128, tstart + 64};
            pg8::EpiSwiglu E{(bf16_t*)(ws + WS_PROJ + PJ_H), as_global(a.in[I_BGU]) + (size_t)L * NEXP * 2048};
            pg8::gemm_phase<pg8::EpiSwiglu, pg8::MoeGatherSched, true>(lds, DM, S, E, tid);
            }
            GRID_BAR(pb + K_MOE1);
        }
        if (IN(pb + K_MOE2)) {
            STAMP(pb + K_MOE2);
            for (int rep_ = 0; rep_ < NREP(K_MOE2); ++rep_) {
            PH_PTRS(Lloop)
            pg8::MoeSched S{(const char*)(ws + WS_PROJ + PJ_H), (const char*)(wl + W_DN), tstart, (size_t)DM * DM * 2, 4, G, bid, nullptr, nullptr, nullptr, nullptr};
            pg8::EpiBf16 E{(bf16_t*)(ws + WS_PROJ + PJ_OB), DM, as_global(a.in[I_BDN]) + (size_t)L * NEXP * DM, DM};
            pg8::gemm_phase<pg8::EpiBf16, pg8::MoeSched, true>(lds, DM, S, E, tid);
            {
                PH_PTRS(Lloop)
                pg8::DenseSched S2{(const char*)(ws + WS_PB) + (size_t)L * NTOK * PLE_DIM * 2, (const char*)(wl + W_PP), NTOK / 256, DM / 256, G, bid, PLE_DIM};
                pg8::EpiBf16 E2{(bf16_t*)(RM + M_PP), DM, nullptr, 0};
                pg8::gemm_phase<pg8::EpiBf16, pg8::DenseSched, true>(lds, PLE_DIM, S2, E2, tid);
            }
            }
            GRID_BAR(pb + K_MOE2);
        }
        if (IN(pb + K_LN2)) {
            STAMP(pb + K_LN2);
            for (int rep_ = 0; rep_ < NREP(K_LN2); ++rep_) {
            PH_PTRS(Lloop)
            const bf16_t* OB = (const bf16_t*)(ws + WS_PROJ + PJ_OB);
            for (int t0 = gw * 2; t0 < NTOK; t0 += NGW * 2) {
                f32x4 vv[2][4]; u32x2 yy[2][4][4]; f32x4 gk4[2];
#pragma unroll
                for (int u = 0; u < 2; ++u) {
                    const int t = t0 + u;
                    gk4[u] = *(const f32x4*)(GATES + (size_t)t * 4);
#pragma unroll
                    for (int k = 0; k < 4; ++k) { const int es = ES[t * 4 + k]; const size_t row = (size_t)tstart[es & 31] * 256 + (es >> 5);
#pragma unroll
                        for (int j = 0; j < 4; ++j) yy[u][k][j] = *(const u32x2*)(OB + row * DM + 256 * j + 4 * lane); }
#pragma unroll
                    for (int j = 0; j < 4; ++j) vv[u][j] = ld_bf4(XB + (size_t)t * DM + 256 * j + 4 * lane) * ALPHA;
                }
#pragma unroll
                for (int u = 0; u < 2; ++u) {
                    const int t = t0 + u; f32x4 (&v)[4] = vv[u];
#pragma unroll
                    for (int k = 0; k < 4; ++k)
#pragma unroll
                        for (int j = 0; j < 4; ++j) { const u32x2 y2 = yy[u][k][j]; v[j] += (f32x4){bflo(y2.x), bfhi(y2.x), bflo(y2.y), bfhi(y2.y)} * gk4[u][k]; }
                    ln_inplace(v, as_global(a.in[I_LN2G]) + L * DM, as_global(a.in[I_LN2B]) + L * DM, lane);
                    store_row(v, nullptr, XB + (size_t)t * DM, lane);
                }
            }
            }
            GRID_BAR(pb + K_LN2);
        }
        if (IN(pb + K_PLEG)) {
            STAMP(pb + K_PLEG);
            for (int rep_ = 0; rep_ < NREP(K_PLEG); ++rep_) {
            PH_PTRS(Lloop)
            pg8::DenseSched S{(const char*)XB, (const char*)(wl + W_PG), NTOK / 256, DM / 256, G, bid, DM};
            pg8::EpiPle E{(bf16_t*)(RM + M_PLEO), (const bf16_t*)(RM + M_PP)};
            pg8::gemm_phase<pg8::EpiPle, pg8::DenseSched, true>(lds, DM, S, E, tid);
            }
            GRID_BAR(pb + K_PLEG);
        }
        if (IN(pb + K_LN3)) {
            STAMP(pb + K_LN3);
            for (int rep_ = 0; rep_ < NREP(K_LN3); ++rep_) {
            PH_PTRS(Lloop)
            const bf16_t* PLEO = (const bf16_t*)(RM + M_PLEO);
            float probe_scale = 1.0f;
            if (PROBE_ON && L + 1 == DEPTH) {
                const unsigned* ts = ctl + CW_TS; unsigned dt = 0u;
                if (PROBE_A < 0) dt = ts[1] - ts[0];
                else if (PROBE_B >= NPL) dt = 2u * (ts[1 + NPL] - ts[1 + PROBE_A]);
                else dt = (ts[1 + PROBE_B] - ts[1 + PROBE_A]) + (ts[1 + NPL + PROBE_B] - ts[1 + NPL + PROBE_A]);
                const unsigned us = dt / 100u, q = (us / 4u) * 4u;
                probe_scale = 1.0f + sqrtf(1.0e-6f * (float)q);
            }
            if (L + 1 < DEPTH) { stage_smallw<4>(as_global(a.in[I_WIN]) + (size_t)(L + 1) * DM * IN_COLS, IN_COLS, OFF_A, lds, tid); __syncthreads(); }
            unsigned abdep = 0u;
            for (int t0 = gw * 4; t0 < NTOK; t0 += NGW * 4) {
                f32x4 vv[4][4];
#pragma unroll
                for (int u = 0; u < 4; ++u)
#pragma unroll
                    for (int j = 0; j < 4; ++j) vv[u][j] = ld_bf4(XB + (size_t)(t0 + u) * DM + 256 * j + 4 * lane) * ALPHA + ld_bf4(PLEO + (size_t)(t0 + u) * DM + 256 * j + 4 * lane);
#pragma unroll
                for (int u = 0; u < 4; ++u) {
                    const int t = t0 + u; f32x4 (&v)[4] = vv[u];
                    ln_inplace(v, as_global(a.in[I_LN3G]) + L * DM, as_global(a.in[I_LN3B]) + L * DM, lane);
                    if (PROBE_ON && L + 1 == DEPTH) {
#pragma unroll
                        for (int j = 0; j < 4; ++j) v[j] = v[j] * probe_scale;
                    }
                    store_row(v, (L + 1 < DEPTH) ? nullptr : as_global(a.out) + (size_t)t * DM, XB + (size_t)t * DM, lane);
                }
                if (L + 1 < DEPTH) ab_project4(vv, lds, AB + (size_t)t0 * 16, lane, abdep);
            }
            }
            GRID_BAR(pb + K_LN3);
        }
    }
#undef IN
#undef GRID_BAR
}

extern "C" void kernel_launch(void* const* d_in, const int* in_sizes, int n_in, void* d_out, int out_size, void* d_ws, size_t ws_size, hipStream_t stream) {
    static int grid = 0;
    if (grid == 0) {
        int dev = 0, cus = 0;
        if (hipGetDevice(&dev) != hipSuccess || hipDeviceGetAttribute(&cus, hipDeviceAttributeMultiprocessorCount, dev) != hipSuccess) cus = 256;
        (void)hipFuncSetAttribute((const void*)mega, hipFuncAttributeMaxDynamicSharedMemorySize, LDS_BYTES);
        grid = cus > 0 ? cus : 256;
    }
    if (n_in < 34 || ws_size < WS_END) return;
    (void)in_sizes; (void)out_size;
    (void)hipMemsetAsync((char*)d_ws + WS_CTL, 0, 1 * MiB, stream);
    MArgs a; memset(&a, 0, sizeof a);
    for (int i = 0; i < 34; ++i) a.in[i] = (const float*)d_in[i];
    a.out = (float*)d_out; a.ws = (unsigned char*)d_ws;
#if N_LAUNCH_PER_PHASE
    unsigned char* ws = (unsigned char*)d_ws;
    for (int ph = 0; ph < NPHASES; ++ph) {
        const int L = (ph - 1) / NPL, k = (ph - 1) % NPL;
        a.ph_lo = ph; a.ph_hi = ph + 1; hipLaunchKernelGGL(mega, dim3(grid), dim3(NWAVES * 64), LDS_BYTES, stream, a);
    }
#else
    a.ph_lo = 0; a.ph_hi = NPHASES; hipLaunchKernelGGL(mega, dim3(grid), dim3(NWAVES * 64), LDS_BYTES, stream, a);
#endif
}
```
